# Optimizing an MI355X kernel written in HIP

```python
import math
import jax
import jax.numpy as jnp
from jax import lax
import numpy as np

D_MODEL = 2048
BATCH = 4
SEQ = 2048
DEPTH = 4
DEC_BATCH = 128
DEC_SEQ = 1
PAST_LEN = 16384
PAGE_SIZE = 128

N_EVEN = (DEPTH + 1) // 2
N_ODD = DEPTH // 2
POOL_CH = D_MODEL // 2
POOL_WINDOWS = (2, 4, 8, 16)
POOL_GROUPS = len(POOL_WINDOWS)
POOL_GROUP_CH = POOL_CH // POOL_GROUPS
POOL_HIST = max(POOL_WINDOWS) - 1
SGU_CH = D_MODEL // 2
SGU_HEADS = 4
SGU_HEAD_CH = SGU_CH // SGU_HEADS
SGU_CHUNK = 128
EVEN_IN = POOL_CH + 2 * SGU_CH
EVEN_OUT = POOL_CH + SGU_CH
CONV_CH = D_MODEL // 2
CONV_WIDTH = 31
DN_HEADS = 8
DN_DK = 128
DN_DV = 128
DN_QK = DN_HEADS * DN_DK
DN_V = DN_HEADS * DN_DV
DN_CONV_CH = 2 * DN_QK + DN_V
DN_CONV = 4
DN_CHUNK = 64
ODD_IN = 2 * CONV_CH + DN_CONV_CH + DN_V + 2 * DN_HEADS
ODD_OUT = CONV_CH + DN_V
D_FF = -(-8 * D_MODEL // (3 * 256)) * 256
EPS = 1e-6

kernel_name = 'hybrid_pool_sgu_conformer_gdn_decode_step'


def _rmsnorm(x, g):
    xf = x.astype(jnp.float32)
    y = xf * lax.rsqrt(jnp.mean(xf * xf, -1, keepdims=True) + EPS)
    return (y * g.astype(jnp.float32)).astype(x.dtype)


def _layernorm(x, g, b):
    xf = x.astype(jnp.float32)
    mu = jnp.mean(xf, -1, keepdims=True)
    var = jnp.mean(jnp.square(xf - mu), -1, keepdims=True)
    y = (xf - mu) * lax.rsqrt(var + EPS) * g.astype(jnp.float32) + b.astype(jnp.float32)
    return y.astype(x.dtype)


def _l2norm(x):
    return x * lax.rsqrt(jnp.sum(x * x, -1, keepdims=True) + EPS)


def _causal_dwconv(xh, w):
    ch = w.shape[1]
    return lax.conv_general_dilated(xh, w[:, None, :].astype(xh.dtype), window_strides=(1,), padding='VALID',
                                    dimension_numbers=('NWC', 'WIO', 'NWC'), feature_group_count=ch)


def _pool_mixer(a, hist, pos0, w_grp, scale):
    bsz, t_len, ch = a.shape
    xh = jnp.concatenate([hist.astype(a.dtype), a], 1)
    ah = xh.astype(jnp.float32)
    cs = jnp.concatenate([jnp.zeros((bsz, 1, ch), jnp.float32), jnp.cumsum(ah, axis=1)], 1)
    pos = pos0 + jnp.arange(t_len)
    off = POOL_HIST + 1
    outs = []
    for gi, w in enumerate(POOL_WINDOWS):
        sl = slice(gi * POOL_GROUP_CH, (gi + 1) * POOL_GROUP_CH)
        s = cs[:, off:off + t_len, sl] - cs[:, off - w:off - w + t_len, sl]
        cnt = jnp.minimum(w, pos + 1).astype(jnp.float32)[None, :, None]
        outs.append(s / cnt)
    pooled = (jnp.concatenate(outs, -1) - a.astype(jnp.float32)).astype(a.dtype)
    pooled = pooled.reshape(bsz, t_len, POOL_GROUPS, POOL_GROUP_CH)
    mixed = jnp.einsum('btgc,gcd->btgd', pooled, w_grp).reshape(bsz, t_len, ch)
    return mixed * scale, xh[:, -POOL_HIST:]


def _sgu_mixer(u, v, ln_g, ln_b, ws, bs):
    bsz, t_len, _ = u.shape
    vn = _layernorm(v, ln_g, ln_b)
    n = -(-t_len // SGU_CHUNK)
    tp = n * SGU_CHUNK
    vp = jnp.pad(vn, ((0, 0), (0, tp - t_len), (0, 0))).reshape(bsz, n, SGU_CHUNK, SGU_HEADS, SGU_HEAD_CH)
    causal = jnp.tril(jnp.ones((SGU_CHUNK, SGU_CHUNK), bool))
    wm = jnp.where(causal[None], ws, jnp.zeros_like(ws))
    mixed = jnp.einsum('hij,bnjhc->bnihc', wm, vp) + bs.T[None, None, :, :, None]
    mixed = mixed.reshape(bsz, tp, SGU_CH)[:, :t_len]
    return u * mixed, vn


def _conv_module(zc, hist, dw, db, ln_g, ln_b):
    glu = zc[..., :CONV_CH] * jax.nn.sigmoid(zc[..., CONV_CH:])
    xh = jnp.concatenate([hist.astype(glu.dtype), glu], 1)
    y = _causal_dwconv(xh, dw) + db
    y = jax.nn.silu(_layernorm(y, ln_g, ln_b))
    return y, xh[:, -(CONV_WIDTH - 1):]


def _to_chunks(t, n, c):
    bsz = t.shape[0]
    t = t.reshape((bsz, n, c) + t.shape[2:])
    return t.transpose((1, 0, 3, 2) + tuple(range(4, t.ndim)))


def _gated_delta(q, k, v, g, beta, s0):
    bsz, t_len, nh, _ = q.shape
    c = min(DN_CHUNK, t_len)
    n = -(-t_len // c)
    tp = n * c

    def padt(t):
        return jnp.pad(t, [(0, 0), (0, tp - t_len)] + [(0, 0)] * (t.ndim - 2))

    q, k, v, g, beta = [_to_chunks(padt(t), n, c) for t in (q, k, v, g, beta)]
    gc = jnp.cumsum(g, axis=-1)
    lower = jnp.tril(jnp.ones((c, c), bool))
    strict = jnp.tril(jnp.ones((c, c), bool), -1)
    decay = jnp.exp(jnp.where(lower, gc[..., :, None] - gc[..., None, :], -jnp.inf))
    kb = k * beta[..., None]
    vb = v * beta[..., None]
    lmat = jnp.where(strict, jnp.einsum('nbhid,nbhjd->nbhij', kb, k) * decay, 0.0)
    amat = lmat + jnp.eye(c, dtype=jnp.float32)
    rhs = jnp.concatenate([vb, kb * jnp.exp(gc)[..., None]], -1)
    sol = lax.linalg.triangular_solve(amat, rhs, left_side=True, lower=True, unit_diagonal=True)
    u_c, w_c = sol[..., :DN_DV], sol[..., DN_DV:]
    qk = jnp.einsum('nbhid,nbhjd->nbhij', q, k) * decay
    q_dec = q * jnp.exp(gc)[..., None]
    k_dec = k * jnp.exp(gc[..., -1:] - gc)[..., None]
    g_last = jnp.exp(gc[..., -1])

    def step(s, xs):
        u_i, w_i, qk_i, qd_i, kd_i, gl_i = xs
        v_new = u_i - jnp.einsum('bhcd,bhde->bhce', w_i, s)
        o = jnp.einsum('bhcd,bhde->bhce', qd_i, s) + jnp.einsum('bhij,bhje->bhie', qk_i, v_new)
        s = s * gl_i[..., None, None] + jnp.einsum('bhcd,bhce->bhde', kd_i, v_new)
        return s, o

    s_fin, o = lax.scan(step, s0, (u_c, w_c, qk, q_dec, k_dec, g_last))
    o = o.transpose(1, 0, 3, 2, 4).reshape(bsz, tp, nh, DN_DV)[:, :t_len]
    return o, s_fin


def _gated_deltanet(qkv, zg, a, b, hist, s0, conv_w, a_log, dt_bias, norm_g):
    bsz, t_len, _ = qkv.shape
    xh = jnp.concatenate([hist.astype(qkv.dtype), qkv], 1)
    qkv_c = jax.nn.silu(_causal_dwconv(xh, conv_w)).astype(jnp.float32)
    q = qkv_c[..., :DN_QK].reshape(bsz, t_len, DN_HEADS, DN_DK)
    k = qkv_c[..., DN_QK:2 * DN_QK].reshape(bsz, t_len, DN_HEADS, DN_DK)
    v = qkv_c[..., 2 * DN_QK:].reshape(bsz, t_len, DN_HEADS, DN_DV)
    q = _l2norm(q) * (DN_DK ** -0.5)
    k = _l2norm(k)
    g = -jnp.exp(a_log.astype(jnp.float32)) * jax.nn.softplus(a.astype(jnp.float32) + dt_bias.astype(jnp.float32))
    beta = jax.nn.sigmoid(b.astype(jnp.float32))
    o, s_fin = _gated_delta(q, k, v, g, beta, s0.astype(jnp.float32))
    o = _rmsnorm(o, norm_g) * jax.nn.silu(zg.astype(jnp.float32).reshape(bsz, t_len, DN_HEADS, DN_DV))
    return o.reshape(bsz, t_len, DN_V).astype(qkv.dtype), xh[:, -(DN_CONV - 1):], s_fin.astype(s0.dtype)


def _trunk(x, pool_st, convc_st, dnconv_st, dns_st, pos0, p):
    new_pool, new_v, new_cc, new_dc, new_s = [], [], [], [], []
    for l in range(DEPTH):
        h = _rmsnorm(x, p['norm_mix'][l])
        if l % 2 == 0:
            e = l // 2
            z = h @ p['ev_w_in'][e]
            a_out, pool_hist = _pool_mixer(z[..., :POOL_CH], pool_st[e], pos0, p['pool_w'][e], p['pool_scale'][e])
            uv = jax.nn.gelu(z[..., POOL_CH:], approximate=False)
            b_out, v_rows = _sgu_mixer(uv[..., :SGU_CH], uv[..., SGU_CH:], p['sgu_ln_g'][e], p['sgu_ln_b'][e],
                                       p['sgu_ws'][e], p['sgu_b'][e])
            mix = jnp.concatenate([a_out, b_out], -1) @ p['ev_w_out'][e]
            new_pool.append(pool_hist)
            new_v.append(v_rows)
        else:
            o = l // 2
            z = h @ p['od_w_in'][o]
            c0 = 2 * CONV_CH
            c1 = c0 + DN_CONV_CH
            c2 = c1 + DN_V
            c3 = c2 + DN_HEADS
            c_out, cc = _conv_module(z[..., :c0], convc_st[o], p['cv_dw'][o], p['cv_db'][o], p['cv_ln_g'][o], p['cv_ln_b'][o])
            d_out, dc, s = _gated_deltanet(z[..., c0:c1], z[..., c1:c2], z[..., c2:c3], z[..., c3:], dnconv_st[o], dns_st[o],
                                           p['dn_conv_w'][o], p['dn_a_log'][o], p['dn_dt_bias'][o], p['dn_norm_g'][o])
            mix = jnp.concatenate([c_out, d_out], -1) @ p['od_w_out'][o]
            new_cc.append(cc)
            new_dc.append(dc)
            new_s.append(s)
        x = x + mix
        h = _rmsnorm(x, p['norm_ffn'][l])
        gu = h @ p['ffn_w_up'][l]
        x = x + (jax.nn.silu(gu[..., :D_FF]) * gu[..., D_FF:]) @ p['ffn_w_down'][l]
    y = _rmsnorm(x, p['norm_final'])
    return y, jnp.stack(new_pool), jnp.stack(new_v), jnp.stack(new_cc), jnp.stack(new_dc), jnp.stack(new_s)


def setup_inputs(seed: int = 0) -> dict:
    key = jax.random.key(seed)
    ks = iter(jax.random.split(key, 64))

    def nrm(shape, scale):
        return jax.random.normal(next(ks), shape, jnp.float32) * scale

    def gain(shape):
        return 1.0 + nrm(shape, 0.05)

    dt = jnp.exp(jax.random.uniform(next(ks), (N_ODD, DN_HEADS), jnp.float32, math.log(1e-3), math.log(1e-1)))
    return {
        'x_prompt': nrm((BATCH, SEQ, D_MODEL), 1.0),
        'x_sample': nrm((DEC_BATCH, DEC_SEQ, D_MODEL), 1.0),
        'state_pool': nrm((N_EVEN, DEC_BATCH, POOL_HIST, POOL_CH), 1.0),
        'state_conv_c': nrm((N_ODD, DEC_BATCH, CONV_WIDTH - 1, CONV_CH), 0.5),
        'state_dn_conv': nrm((N_ODD, DEC_BATCH, DN_CONV - 1, DN_CONV_CH), 1.0),
        'state_dn_S': nrm((N_ODD, DEC_BATCH, DN_HEADS, DN_DK, DN_DV), 0.5),
        'norm_mix': gain((DEPTH, D_MODEL)),
        'norm_ffn': gain((DEPTH, D_MODEL)),
        'norm_final': gain((D_MODEL,)),
        'ev_w_in': nrm((N_EVEN, D_MODEL, EVEN_IN), D_MODEL ** -0.5),
        'pool_w': nrm((N_EVEN, POOL_GROUPS, POOL_GROUP_CH, POOL_GROUP_CH), POOL_GROUP_CH ** -0.5),
        'pool_scale': gain((N_EVEN, POOL_CH)),
        'sgu_ln_g': gain((N_EVEN, SGU_CH)),
        'sgu_ln_b': nrm((N_EVEN, SGU_CH), 0.02),
        'sgu_ws': nrm((N_EVEN, SGU_HEADS, SGU_CHUNK, SGU_CHUNK), SGU_CHUNK ** -0.5),
        'sgu_b': 1.0 + nrm((N_EVEN, SGU_HEADS, SGU_CHUNK), 0.02),
        'ev_w_out': nrm((N_EVEN, EVEN_OUT, D_MODEL), EVEN_OUT ** -0.5),
        'od_w_in': nrm((N_ODD, D_MODEL, ODD_IN), D_MODEL ** -0.5),
        'cv_dw': nrm((N_ODD, CONV_WIDTH, CONV_CH), CONV_WIDTH ** -0.5),
        'cv_db': nrm((N_ODD, CONV_CH), 0.02),
        'cv_ln_g': gain((N_ODD, CONV_CH)),
        'cv_ln_b': nrm((N_ODD, CONV_CH), 0.02),
        'dn_conv_w': nrm((N_ODD, DN_CONV, DN_CONV_CH), DN_CONV ** -0.5),
        'dn_a_log': jnp.log(jax.random.uniform(next(ks), (N_ODD, DN_HEADS), jnp.float32, 1.0, 16.0)),
        'dn_dt_bias': dt + jnp.log(-jnp.expm1(-dt)),
        'dn_norm_g': gain((N_ODD, DN_DV)),
        'od_w_out': nrm((N_ODD, ODD_OUT, D_MODEL), ODD_OUT ** -0.5),
        'ffn_w_up': nrm((DEPTH, D_MODEL, 2 * D_FF), D_MODEL ** -0.5),
        'ffn_w_down': nrm((DEPTH, D_FF, D_MODEL), D_FF ** -0.5),
    }


def reference(x_prompt, x_sample, state_pool, state_conv_c, state_dn_conv, state_dn_S,
              norm_mix, norm_ffn, norm_final, ev_w_in, pool_w, pool_scale, sgu_ln_g, sgu_ln_b, sgu_ws, sgu_b,
              ev_w_out, od_w_in, cv_dw, cv_db, cv_ln_g, cv_ln_b, dn_conv_w, dn_a_log, dn_dt_bias, dn_norm_g,
              od_w_out, ffn_w_up, ffn_w_down):
    p = dict(norm_mix=norm_mix, norm_ffn=norm_ffn, norm_final=norm_final, ev_w_in=ev_w_in, pool_w=pool_w,
             pool_scale=pool_scale, sgu_ln_g=sgu_ln_g, sgu_ln_b=sgu_ln_b, sgu_ws=sgu_ws, sgu_b=sgu_b,
             ev_w_out=ev_w_out, od_w_in=od_w_in, cv_dw=cv_dw, cv_db=cv_db, cv_ln_g=cv_ln_g, cv_ln_b=cv_ln_b,
             dn_conv_w=dn_conv_w, dn_a_log=dn_a_log, dn_dt_bias=dn_dt_bias, dn_norm_g=dn_norm_g,
             od_w_out=od_w_out, ffn_w_up=ffn_w_up, ffn_w_down=ffn_w_down)
    bp = x_prompt.shape[0]
    dt = x_prompt.dtype
    pool0 = jnp.zeros((N_EVEN, bp, POOL_HIST, POOL_CH), dt)
    cc0 = jnp.zeros((N_ODD, bp, CONV_WIDTH - 1, CONV_CH), dt)
    dc0 = jnp.zeros((N_ODD, bp, DN_CONV - 1, DN_CONV_CH), dt)
    s0 = jnp.zeros((N_ODD, bp, DN_HEADS, DN_DK, DN_DV), state_dn_S.dtype)
    y_prompt, pool_p, _, cc_p, dc_p, s_p = _trunk(x_prompt, pool0, cc0, dc0, s0, 0, p)
    y_sample, pool_s, v_s, cc_s, dc_s, s_s = _trunk(x_sample, state_pool, state_conv_c, state_dn_conv, state_dn_S,
                                                    PAST_LEN, p)
    return (y_prompt, y_sample, pool_p, pool_s, v_s, cc_p, cc_s, dc_p, dc_s, s_p, s_s)
```

```cpp
#include <hip/hip_runtime.h>
#include <hip/hip_cooperative_groups.h>
#include <cstdio>
namespace cg = cooperative_groups;

#define LAS __attribute__((address_space(3)))
typedef unsigned short bf16_t;
typedef short bf16x8 __attribute__((ext_vector_type(8)));
typedef float f32x4 __attribute__((ext_vector_type(4)));
typedef float f32x2 __attribute__((ext_vector_type(2)));
typedef unsigned u32x4 __attribute__((ext_vector_type(4)));
typedef unsigned u32x2 __attribute__((ext_vector_type(2)));

constexpr int D = 2048, SEQ = 2048, BP = 4, MPR = BP * SEQ, BS = 128, MT = MPR + BS, MPAD = 8448;
constexpr int DFF = 5632, EV_IN = 3072, OD_IN = 6160, OD_INM = 6144;
constexpr float EPS = 1e-6f;
constexpr int NTHR = 512, NWAVES = 8;
constexpr int LDS_BYTES = 131072 + 1024;

constexpr size_t O_YP = 0;
constexpr size_t O_YS = O_YP + (size_t)MPR * D;
constexpr size_t O_PP = O_YS + (size_t)BS * D;
constexpr size_t O_PS = O_PP + (size_t)2 * BP * 15 * 1024;
constexpr size_t O_SV = O_PS + (size_t)2 * BS * 15 * 1024;
constexpr size_t O_CP = O_SV + (size_t)2 * BS * 1024;
constexpr size_t O_CS = O_CP + (size_t)2 * BP * 30 * 1024;
constexpr size_t O_DCP = O_CS + (size_t)2 * BS * 30 * 1024;
constexpr size_t O_DCS = O_DCP + (size_t)2 * BP * 3 * 3072;
constexpr size_t O_SP = O_DCS + (size_t)2 * BS * 3 * 3072;
constexpr size_t O_SS = O_SP + (size_t)2 * BP * 8 * 128 * 128;
constexpr size_t O_END = O_SS + (size_t)2 * BS * 8 * 128 * 128;

constexpr size_t al(size_t x) { return (x + 4095) & ~(size_t)4095; }
constexpr size_t WS_X = 0;
constexpr size_t WS_H = WS_X + al((size_t)MPAD * D * 4);
constexpr size_t WS_ACT = WS_H + al((size_t)MPAD * D * 2);
constexpr size_t WS_CAT = WS_ACT + al((size_t)MPAD * DFF * 2);
constexpr size_t WS_ABUF = WS_CAT + al((size_t)MPAD * D * 2);
constexpr size_t WS_UV = WS_ABUF + al((size_t)MPAD * 1024 * 2);
constexpr size_t WS_ZG = WS_UV + al((size_t)MPAD * 3072 * 2);
constexpr size_t WS_MIX = WS_ZG + al((size_t)MPAD * 1024 * 2);
constexpr size_t WS_VN = WS_MIX + al((size_t)MPAD * 3072 * 2);
constexpr size_t WS_AB = WS_VN + al((size_t)MPAD * 1024 * 2);
constexpr size_t WS_G = WS_AB + al((size_t)MPAD * 16 * 4);
constexpr size_t WS_BETA = WS_G + al((size_t)MPAD * 8 * 4);
constexpr size_t WS_O = WS_BETA + al((size_t)MPAD * 8 * 4);
constexpr size_t WS_CU = WS_O + al((size_t)MPAD * 1024 * 4);
constexpr size_t WS_CW = WS_CU + al((size_t)1024 * 8192 * 4);
constexpr size_t WS_CQD = WS_CW + al((size_t)1024 * 8192 * 2);
constexpr size_t WS_CKDT = WS_CQD + al((size_t)1024 * 8192 * 2);
constexpr size_t WS_CQK = WS_CKDT + al((size_t)1024 * 8192 * 2);
constexpr size_t WS_CGL = WS_CQK + al((size_t)1024 * 4096 * 2);
constexpr size_t WS_WEVIN = WS_CGL + al(4096);
constexpr size_t WS_WEVOUT = WS_WEVIN + al((size_t)2 * 3072 * 2048 * 2);
constexpr size_t WS_WODIN = WS_WEVOUT + al((size_t)2 * 2048 * 2048 * 2);
constexpr size_t WS_WODOUT = WS_WODIN + al((size_t)2 * 6144 * 2048 * 2);
constexpr size_t WS_WUP = WS_WODOUT + al((size_t)2 * 2048 * 2048 * 2);
constexpr size_t WS_WDOWN = WS_WUP + al((size_t)4 * 11264 * 2048 * 2);
constexpr size_t WS_WPOOL = WS_WDOWN + al((size_t)4 * 2048 * 5632 * 2);
constexpr size_t WS_PARTX = WS_WPOOL + al((size_t)2 * 1024 * 256 * 2);
constexpr size_t WS_WAB = WS_PARTX + al((size_t)256 * 32768 * 4);
constexpr size_t WS_BAR = WS_WAB + al((size_t)2 * 16 * 2048 * 2);
constexpr size_t WS_BAR_BYTES = 16384;
constexpr size_t WS_END = WS_BAR + WS_BAR_BYTES;

struct Params { const float* in[29]; float* out; unsigned char* ws; int ph_lo, ph_hi, coop, pad; };
typedef const __attribute__((address_space(4))) Params* PP;
struct Ctx { int tid, bid, G; };

__device__ __forceinline__ unsigned cvt_pk_bf16(float lo, float hi) { unsigned r; asm volatile("v_cvt_pk_bf16_f32 %0, %1, %2" : "=v"(r) : "v"(lo), "v"(hi)); return r; }
__device__ __forceinline__ float bf_lo(unsigned w) { return __uint_as_float(w << 16); }
__device__ __forceinline__ float bf_hi(unsigned w) { return __uint_as_float(w & 0xffff0000u); }
__device__ __forceinline__ float bf1(bf16_t h) { return __uint_as_float(((unsigned)h) << 16); }
__device__ __forceinline__ void unpack8(const u32x4 w, float (&f)[8]) { f[0] = bf_lo(w.x); f[1] = bf_hi(w.x); f[2] = bf_lo(w.y); f[3] = bf_hi(w.y); f[4] = bf_lo(w.z); f[5] = bf_hi(w.z); f[6] = bf_lo(w.w); f[7] = bf_hi(w.w); }
__device__ __forceinline__ u32x4 pack8(const float (&f)[8]) { u32x4 w; w.x = cvt_pk_bf16(f[0], f[1]); w.y = cvt_pk_bf16(f[2], f[3]); w.z = cvt_pk_bf16(f[4], f[5]); w.w = cvt_pk_bf16(f[6], f[7]); return w; }
__device__ __forceinline__ float sigmoidf_(float x) { return __builtin_amdgcn_rcpf(1.0f + __expf(-x)); }
__device__ __forceinline__ float siluf_(float x) { return x * sigmoidf_(x); }
__device__ __forceinline__ float wave_sum(float v) {
#pragma unroll
    for (int o = 1; o < 64; o <<= 1) v += __shfl_xor(v, o);
    return v;
}
__device__ __forceinline__ float grp16_sum(float v) {
#pragma unroll
    for (int o = 1; o < 16; o <<= 1) v += __shfl_xor(v, o);
    return v;
}
__device__ __forceinline__ f32x2 gelu_pk(f32x2 v) {
    const f32x2 av = __builtin_elementwise_abs(v), d = av * 0.2316418882f + 1.0f;
    f32x2 t; t.x = __builtin_amdgcn_rcpf(d.x); t.y = __builtin_amdgcn_rcpf(d.y);
    f32x2 q = t * 0.5307027145f + (-0.7265760135f); q = q * t + 0.7107068705f; q = q * t + (-0.142248368f); q = q * t + 0.127414796f; q = q * t;
    const f32x2 s = (v * v) * (-0.72134752044f);
    f32x2 e; e.x = __builtin_amdgcn_exp2f(s.x); e.y = __builtin_amdgcn_exp2f(s.y);
    const f32x2 m = v * (q * e), r = v - m;
    f32x2 o; o.x = v.x < 0.f ? m.x : r.x; o.y = v.y < 0.f ? m.y : r.y; return o;
}

namespace pg8 {
constexpr int BM = 256, BK = 64, HALF = 128, HTB = HALF * BK * 2, STAGE_BYTES = 8 * HTB, NXCD = 8, WGM = 8;
__device__ __forceinline__ int lds_byte(int r, int c) { const int st = (r >> 4) * 2 + (c >> 5), rr = r & 15, cc = c & 31, ob = rr * 64 + cc * 2; return st * 1024 + (ob ^ (((ob >> 9) & 1) << 5)); }
__device__ __forceinline__ void stage_rc(int b, int& R, int& C) { const int st = b / 1024, sb = b % 1024, swz = sb ^ (((sb >> 9) & 1) << 5); R = (st >> 1) * 16 + swz / 64; C = (st & 1) * 32 + (swz % 64) / 2; }
__device__ __forceinline__ int perm32(int rho) { const int n = rho >> 4, i = rho & 15; return 8 * (i >> 2) + 4 * n + (i & 3); }

struct Unit { int pm, pn, nt, pad; const char* A; const char* B; };

__device__ __forceinline__ void unit_pmpn(int wgid, int nM, int nN, int& pm, int& pn) {
    const int nig = WGM * nN, gid = wgid / nig, fm = gid * WGM, gsz = (nM - fm) < WGM ? (nM - fm) : WGM;
    pm = fm + ((wgid % nig) % gsz); pn = (wgid % nig) / gsz;
}
struct StaticSched {
    const char* A; const char* B; int lda, ldb, nM, nN, nwg, G, c, nt; size_t a_pn_stride;
    __device__ __forceinline__ void init(const Ctx& cx, const void* A_, const void* B_, int lda_, int ldb_, int nM_, int nN_, int K, size_t apn) {
        A = (const char*)A_; B = (const char*)B_; lda = lda_; ldb = ldb_; nM = nM_; nN = nN_; nwg = nM * nN; G = cx.G; c = cx.bid; nt = K / BK; a_pn_stride = apn; }
    __device__ __forceinline__ bool next(int i, Unit& u) const {
        const long L = (long)i * G + c; if (L >= nwg) return false;
        int wgid = (int)L; { const int q = nwg / NXCD, r = nwg % NXCD, xcd = wgid % NXCD, off = wgid / NXCD; wgid = (xcd < r ? xcd * (q + 1) : r * (q + 1) + (xcd - r) * q) + off; }
        unit_pmpn(wgid, nM, nN, u.pm, u.pn); u.nt = nt; u.pad = 0;
        u.A = A + (size_t)u.pm * BM * lda * 2 + (size_t)u.pn * a_pn_stride; u.B = B + (size_t)u.pn * BM * ldb * 2; return true;
    }
};
struct StreamKSched {
    const char* A; const char* B; int lda, ldb, pm_base, nN, ppu, p0, p1, u0, vc;
    __device__ __forceinline__ void init(const Ctx& cx, const void* A_, const void* B_, int lda_, int ldb_, int pm_base_, int nN_, int K) {
        A = (const char*)A_; B = (const char*)B_; lda = lda_; ldb = ldb_; pm_base = pm_base_; nN = nN_; ppu = K / (2 * BK);
        const int G = cx.G, bx = cx.bid; vc = (G % 8 == 0) ? (bx % 8) * (G / 8) + bx / 8 : bx;
        const long P = (long)nN * ppu; p0 = (int)((vc * P) / G); p1 = (int)(((vc + 1) * P) / G); u0 = p0 / ppu; }
    __device__ __forceinline__ bool next(int i, Unit& u) const {
        const int ui = u0 + i; const long lo = (long)ui * ppu; if (lo >= p1) return false;
        const int s = (int)(lo > p0 ? lo : p0), e = (int)((lo + ppu) < p1 ? (lo + ppu) : p1);
        u.pm = pm_base; u.pn = ui; u.nt = 2 * (e - s); u.pad = vc;
        const size_t koff = (size_t)(s - (int)lo) * 2 * BK * 2;
        u.A = A + (size_t)u.pm * BM * lda * 2 + koff; u.B = B + (size_t)u.pn * BM * ldb * 2 + koff; return true;
    }
};

struct ResidSched {
    StaticSched a; StreamKSched b; int na, lda, ldb;
    __device__ __forceinline__ void init(const Ctx& cx, const void* A_, const void* B_, int ld, int K) {
        a.init(cx, A_, B_, ld, ld, MPR / 256, 8, K, 0); b.init(cx, A_, B_, ld, ld, MPR / 256, 8, K); lda = ld; ldb = ld;
        na = (a.nwg - a.c + a.G - 1) / a.G; if (na < 0) na = 0; }
    __device__ __forceinline__ bool next(int i, Unit& u) const { if (i < na) return a.next(i, u); return b.next(i - na, u); }
};
template <class Epi, class Sched>
__device__ __forceinline__ void gemm_phase(const Ctx& cx, LAS unsigned char* lds, const Sched& S, const Epi& E) {
    const int tid = cx.tid, wid = __builtin_amdgcn_readfirstlane(tid >> 6), lane = tid & 63, wr = wid >> 2, wc = wid & 3, fr = lane & 15, fq = lane >> 4;
    const int lda = S.lda, ldb = S.ldb;
    unsigned voffA[2], voffB[2];
#pragma unroll
    for (int i = 0; i < 2; ++i) { int R, C; stage_rc(tid * 16 + i * 8192, R, C); const int Rb = Epi::PERM ? ((R & ~31) + perm32(R & 31)) : R;
        voffA[i] = (unsigned)(R * lda + C) * 2u; voffB[i] = (unsigned)(Rb * ldb + C) * 2u; }
    const size_t kstep = (size_t)(BK * 2);
    const size_t hstepA = (size_t)HALF * lda * 2, hstepB = (size_t)HALF * ldb * 2;
    const unsigned ldsw = (unsigned)wid * 1024u;
    const int aoff = lds_byte(wr * 64 + fr, fq * 8), boff = lds_byte(wc * 32 + fr, fq * 8);
#define PG8_SA(b, h) (((b) * 2 + (h)) * HTB)
#define PG8_SB(b, h) ((4 + (b) * 2 + (h)) * HTB)
#define PG8_STAGE(bufoff, gbase, voff) do { _Pragma("unroll") for (int _i = 0; _i < 2; ++_i) \
        __builtin_amdgcn_global_load_lds((const unsigned*)((const char*)(gbase) + (voff)[_i]), (LAS unsigned*)(lds + (bufoff) + ldsw + _i * 8192), 16, 0, 0); } while (0)
#define PG8_LDA(dst, b, h) do { _Pragma("unroll") for (int m = 0; m < 4; ++m) _Pragma("unroll") for (int k = 0; k < 2; ++k) dst[m][k] = *(const LAS bf16x8*)(lds + PG8_SA(b, h) + aoff + m * 2048 + k * 1024); } while (0)
#define PG8_LDB(dst, b, h) do { _Pragma("unroll") for (int n = 0; n < 2; ++n) _Pragma("unroll") for (int k = 0; k < 2; ++k) dst[n][k] = *(const LAS bf16x8*)(lds + PG8_SB(b, h) + boff + n * 2048 + k * 1024); } while (0)
#define PG8_MMA(ai, bj, At, Bt) do { __builtin_amdgcn_s_setprio(1); _Pragma("unroll") for (int m = 0; m < 4; ++m) _Pragma("unroll") for (int n = 0; n < 2; ++n) _Pragma("unroll") for (int k = 0; k < 2; ++k) \
        acc[ai][bj][m][n] = __builtin_amdgcn_mfma_f32_16x16x32_bf16(Bt[n][k], At[m][k], acc[ai][bj][m][n], 0, 0, 0); __builtin_amdgcn_s_setprio(0); } while (0)
#define PG8_WAIT_V(n) asm volatile("s_waitcnt vmcnt(" #n ")" ::: "memory")
#define PG8_WAIT_L(n) asm volatile("s_waitcnt lgkmcnt(" #n ")" ::: "memory")
#define PG8_BAR __builtin_amdgcn_s_barrier()
#define PG8_SCHED __builtin_amdgcn_sched_barrier(0)
    Unit cur, nxt; int ui = 0;
    if (!S.next(0, cur)) return;
    f32x4 acc[2][2][4][2];
#pragma unroll
    for (int a = 0; a < 2; ++a)
#pragma unroll
        for (int b = 0; b < 2; ++b)
#pragma unroll
            for (int m = 0; m < 4; ++m)
#pragma unroll
                for (int n = 0; n < 2; ++n) acc[a][b][m][n] = (f32x4){0.f, 0.f, 0.f, 0.f};
    bf16x8 At[4][2], B0[2][2], B1[2][2];
    const char* cA = cur.A; const char* cB = cur.B;
    PG8_STAGE(PG8_SB(0, 0), cB, voffB); PG8_STAGE(PG8_SA(0, 0), cA, voffA); PG8_STAGE(PG8_SB(0, 1), cB + hstepB, voffB); PG8_STAGE(PG8_SA(0, 1), cA + hstepA, voffA);
    if (wr == 1) PG8_BAR;
    PG8_WAIT_V(4); PG8_BAR;
    PG8_STAGE(PG8_SB(1, 0), cB + kstep, voffB); PG8_STAGE(PG8_SA(1, 0), cA + kstep, voffA); PG8_STAGE(PG8_SB(1, 1), cB + hstepB + kstep, voffB);
    PG8_WAIT_V(6); PG8_BAR;
    for (;;) {
        const bool has_next = S.next(ui + 1, nxt);
        const char* nA = has_next ? nxt.A : cA; const char* nB = has_next ? nxt.B : cB;
        const int nt = cur.nt;
        for (int t = 0; t < nt; t += 2) {
            const bool last = (t == nt - 2);
            const char* a1 = cA + (size_t)(t + 1) * kstep;
            const char* a2 = last ? nA : cA + (size_t)(t + 2) * kstep; const char* b2 = last ? nB : cB + (size_t)(t + 2) * kstep;
            const char* a3 = a2 + kstep; const char* b3 = b2 + kstep;
            PG8_LDB(B0, 0, 0); PG8_SCHED; PG8_LDA(At, 0, 0); PG8_STAGE(PG8_SA(1, 1), a1 + hstepA, voffA);
            PG8_WAIT_L(8); PG8_BAR; PG8_WAIT_L(0); PG8_MMA(0, 0, At, B0); PG8_BAR; PG8_SCHED;
            PG8_LDB(B1, 0, 1); PG8_STAGE(PG8_SB(0, 0), b2, voffB);
            PG8_BAR; PG8_WAIT_L(0); PG8_MMA(0, 1, At, B1); PG8_BAR;
            PG8_LDA(At, 0, 1); PG8_STAGE(PG8_SA(0, 0), a2, voffA);
            PG8_BAR; PG8_WAIT_L(0); PG8_MMA(1, 0, At, B0); PG8_BAR; PG8_SCHED;
            PG8_STAGE(PG8_SB(0, 1), b2 + hstepB, voffB);
            PG8_WAIT_V(6); PG8_BAR; PG8_MMA(1, 1, At, B1); PG8_BAR;
            PG8_LDB(B0, 1, 0); PG8_SCHED; PG8_LDA(At, 1, 0); PG8_STAGE(PG8_SA(0, 1), a2 + hstepA, voffA);
            PG8_WAIT_L(8); PG8_BAR; PG8_WAIT_L(0); PG8_MMA(0, 0, At, B0); PG8_BAR; PG8_SCHED;
            PG8_LDB(B1, 1, 1); PG8_STAGE(PG8_SB(1, 0), b3, voffB);
            PG8_BAR; PG8_WAIT_L(0); PG8_MMA(0, 1, At, B1); PG8_BAR;
            PG8_LDA(At, 1, 1); PG8_STAGE(PG8_SA(1, 0), a3, voffA);
            PG8_BAR; PG8_WAIT_L(0); PG8_MMA(1, 0, At, B0); PG8_BAR; PG8_SCHED;
            PG8_STAGE(PG8_SB(1, 1), b3 + hstepB, voffB);
            PG8_WAIT_V(6); PG8_BAR; PG8_MMA(1, 1, At, B1); PG8_BAR;
        }
        E(acc, cur, wr, wc, fr, fq);
        if (!has_next) break;
#pragma unroll
        for (int a = 0; a < 2; ++a)
#pragma unroll
            for (int b = 0; b < 2; ++b)
#pragma unroll
                for (int m = 0; m < 4; ++m)
#pragma unroll
                    for (int n = 0; n < 2; ++n) acc[a][b][m][n] = (f32x4){0.f, 0.f, 0.f, 0.f};
        cur = nxt; cA = nA; cB = nB; ++ui;
    }
    PG8_WAIT_V(0);
    if (wr == 0) PG8_BAR;
    PG8_BAR;
#undef PG8_SA
#undef PG8_SB
#undef PG8_STAGE
#undef PG8_LDA
#undef PG8_LDB
#undef PG8_MMA
#undef PG8_WAIT_V
#undef PG8_WAIT_L
#undef PG8_BAR
#undef PG8_SCHED
}
typedef f32x4 Acc[2][2][4][2];

__device__ __forceinline__ void store8(bf16_t* p, f32x4 v0, f32x4 v1) {
    u32x4 w; w.x = cvt_pk_bf16(v0[0], v0[1]); w.y = cvt_pk_bf16(v0[2], v0[3]); w.z = cvt_pk_bf16(v1[0], v1[1]); w.w = cvt_pk_bf16(v1[2], v1[3]); *(u32x4*)p = w; }
__device__ __forceinline__ f32x4 gelu4(f32x4 v) { f32x2 a = gelu_pk((f32x2){v[0], v[1]}), b = gelu_pk((f32x2){v[2], v[3]}); return (f32x4){a.x, a.y, b.x, b.y}; }
__device__ __forceinline__ f32x4 silu4(f32x4 v) { return (f32x4){siluf_(v[0]), siluf_(v[1]), siluf_(v[2]), siluf_(v[3])}; }
__device__ __forceinline__ f32x4 sigm4(f32x4 v) { return (f32x4){sigmoidf_(v[0]), sigmoidf_(v[1]), sigmoidf_(v[2]), sigmoidf_(v[3])}; }

struct EpiEvenIn {
    static constexpr bool PERM = true;
    bf16_t* abuf; bf16_t* uv;
    __device__ __forceinline__ void operator()(const Acc& acc, const Unit& u, int wr, int wc, int fr, int fq) const {
        const int row0 = u.pm * BM + wr * 64 + fr; const bool act = u.pn >= 4;
        bf16_t* base = act ? uv : abuf; const int ldc = act ? 2048 : 1024; const int col0 = (act ? (u.pn - 4) : u.pn) * BM + wc * 32 + 8 * fq;
#pragma unroll
        for (int ai = 0; ai < 2; ++ai)
#pragma unroll
            for (int m = 0; m < 4; ++m) { bf16_t* rowp = base + (size_t)(row0 + ai * HALF + m * 16) * ldc + col0;
#pragma unroll
                for (int bj = 0; bj < 2; ++bj) { f32x4 v0 = acc[ai][bj][m][0], v1 = acc[ai][bj][m][1];
                    if (act) { v0 = gelu4(v0); v1 = gelu4(v1); }
                    store8(rowp + bj * HALF, v0, v1); }
                asm volatile("" ::: "memory"); }
    }
};
struct EpiOddIn {
    static constexpr bool PERM = true;
    bf16_t* glu; bf16_t* qkv; bf16_t* zg;
    __device__ __forceinline__ void operator()(const Acc& acc, const Unit& u, int wr, int wc, int fr, int fq) const {
        const int row0 = u.pm * BM + wr * 64 + fr;
        if (u.pn < 8) {
            const int col0 = u.pn * 128 + wc * 32 + 8 * fq;
#pragma unroll
            for (int ai = 0; ai < 2; ++ai)
#pragma unroll
                for (int m = 0; m < 4; ++m) { bf16_t* rowp = glu + (size_t)(row0 + ai * HALF + m * 16) * 1024 + col0;
                    store8(rowp, acc[ai][0][m][0] * sigm4(acc[ai][1][m][0]), acc[ai][0][m][1] * sigm4(acc[ai][1][m][1])); asm volatile("" ::: "memory"); }
        } else {
            const bool isq = u.pn < 20; bf16_t* base = isq ? qkv : zg; const int ldc = isq ? 3072 : 1024; const int col0 = (isq ? (u.pn - 8) : (u.pn - 20)) * BM + wc * 32 + 8 * fq;
#pragma unroll
            for (int ai = 0; ai < 2; ++ai)
#pragma unroll
                for (int m = 0; m < 4; ++m) { bf16_t* rowp = base + (size_t)(row0 + ai * HALF + m * 16) * ldc + col0;
#pragma unroll
                    for (int bj = 0; bj < 2; ++bj) store8(rowp + bj * HALF, acc[ai][bj][m][0], acc[ai][bj][m][1]);
                    asm volatile("" ::: "memory"); }
        }
    }
};
struct EpiUp {
    static constexpr bool PERM = true;
    bf16_t* act;
    __device__ __forceinline__ void operator()(const Acc& acc, const Unit& u, int wr, int wc, int fr, int fq) const {
        const int row0 = u.pm * BM + wr * 64 + fr, col0 = u.pn * 128 + wc * 32 + 8 * fq;
#pragma unroll
        for (int ai = 0; ai < 2; ++ai)
#pragma unroll
            for (int m = 0; m < 4; ++m) { bf16_t* rowp = act + (size_t)(row0 + ai * HALF + m * 16) * DFF + col0;
                store8(rowp, silu4(acc[ai][0][m][0]) * acc[ai][1][m][0], silu4(acc[ai][0][m][1]) * acc[ai][1][m][1]); asm volatile("" ::: "memory"); }
    }
};
struct EpiPool {
    static constexpr bool PERM = true;
    bf16_t* cat; const float* scale;
    __device__ __forceinline__ void operator()(const Acc& acc, const Unit& u, int wr, int wc, int fr, int fq) const {
        const int row0 = u.pm * BM + wr * 64 + fr, col0 = u.pn * BM + wc * 32 + 8 * fq;
#pragma unroll
        for (int ai = 0; ai < 2; ++ai)
#pragma unroll
            for (int m = 0; m < 4; ++m) { bf16_t* rowp = cat + (size_t)(row0 + ai * HALF + m * 16) * 2048 + col0;
#pragma unroll
                for (int bj = 0; bj < 2; ++bj) { const f32x4 s0 = *(const f32x4*)(scale + col0 + bj * HALF), s1 = *(const f32x4*)(scale + col0 + bj * HALF + 4);
                    store8(rowp + bj * HALF, acc[ai][bj][m][0] * s0, acc[ai][bj][m][1] * s1); }
                asm volatile("" ::: "memory"); }
    }
};
struct EpiResid {
    static constexpr bool PERM = false;
    float* x; bool dry;
    __device__ __forceinline__ void operator()(const Acc& acc, const Unit& u, int wr, int wc, int fr, int fq) const {
        if (dry) return;
        const int row0 = u.pm * BM + wr * 64 + fr, col0 = u.pn * BM + wc * 32 + 4 * fq;
#pragma unroll
        for (int ai = 0; ai < 2; ++ai) {
            f32x4 t[4][2][2];
#pragma unroll
            for (int m = 0; m < 4; ++m) { const float* rowp = x + (size_t)(row0 + ai * HALF + m * 16) * 2048 + col0;
#pragma unroll
                for (int bj = 0; bj < 2; ++bj)
#pragma unroll
                    for (int n = 0; n < 2; ++n) t[m][bj][n] = *(const f32x4*)(rowp + bj * HALF + n * 16); }
#pragma unroll
            for (int m = 0; m < 4; ++m) { float* rowp = x + (size_t)(row0 + ai * HALF + m * 16) * 2048 + col0;
#pragma unroll
                for (int bj = 0; bj < 2; ++bj)
#pragma unroll
                    for (int n = 0; n < 2; ++n) *(f32x4*)(rowp + bj * HALF + n * 16) = t[m][bj][n] + acc[ai][bj][m][n]; }
            asm volatile("" ::: "memory"); }
    }
};
struct EpiPartX {
    static constexpr bool PERM = false;
    float* px; bool dry;
    __device__ __forceinline__ void operator()(const Acc& acc, const Unit& u, int wr, int wc, int fr, int fq) const {
        if (dry) return;
        float* base = px + (size_t)u.pad * 32768 + (size_t)(wr * 64 + fr) * 256 + wc * 32 + 4 * fq;
#pragma unroll
        for (int m = 0; m < 4; ++m)
#pragma unroll
            for (int bj = 0; bj < 2; ++bj)
#pragma unroll
                for (int n = 0; n < 2; ++n) *(f32x4*)(base + (size_t)(m * 16) * 256 + bj * HALF + n * 16) = acc[0][bj][m][n];
    }
};
struct EpiResidX {
    static constexpr bool PERM = false;
    EpiResid r; EpiPartX p;
    __device__ __forceinline__ void operator()(const Acc& acc, const Unit& u, int wr, int wc, int fr, int fq) const { if (u.pm < MPR / 256) r(acc, u, wr, wc, fr, fq); else p(acc, u, wr, wc, fr, fq); }
};
}

struct TItem { const float* src; bf16_t* dst; int ldw, K; };
__device__ __forceinline__ TItem titem_locate(PP P, unsigned char* ws, int it) {
    const float* W; bf16_t* WT; int ldw, K, Nd, pairLimit = 0, Hh = 0, r = it;
    if (r < 6144) { const int j = r / 3072; r -= j * 3072; W = P->in[9] + (size_t)j * 2048 * 3072; WT = (bf16_t*)(ws + WS_WEVIN) + (size_t)j * 3072 * 2048; ldw = 3072; K = 2048; Nd = 3072; }
    else if ((r -= 6144) < 4096) { const int e = r / 2048; r -= e * 2048; W = P->in[16] + (size_t)e * 2048 * 2048; WT = (bf16_t*)(ws + WS_WEVOUT) + (size_t)e * 2048 * 2048; ldw = 2048; K = 2048; Nd = 2048; }
    else if ((r -= 4096) < 12288) { const int o = r / 6144; r -= o * 6144; W = P->in[17] + (size_t)o * 2048 * OD_IN; WT = (bf16_t*)(ws + WS_WODIN) + (size_t)o * OD_INM * 2048; ldw = OD_IN; K = 2048; Nd = OD_INM; pairLimit = 2048; Hh = 1024; }
    else if ((r -= 12288) < 4096) { const int o = r / 2048; r -= o * 2048; W = P->in[26] + (size_t)o * 2048 * 2048; WT = (bf16_t*)(ws + WS_WODOUT) + (size_t)o * 2048 * 2048; ldw = 2048; K = 2048; Nd = 2048; }
    else if ((r -= 4096) < 45056) { const int l = r / 11264; r -= l * 11264; W = P->in[27] + (size_t)l * 2048 * 2 * DFF; WT = (bf16_t*)(ws + WS_WUP) + (size_t)l * 2 * DFF * 2048; ldw = 2 * DFF; K = 2048; Nd = 2 * DFF; pairLimit = 2 * DFF; Hh = DFF; }
    else if ((r -= 45056) < 22528) { const int l = r / 5632; r -= l * 5632; W = P->in[28] + (size_t)l * DFF * 2048; WT = (bf16_t*)(ws + WS_WDOWN) + (size_t)l * 2048 * DFF; ldw = 2048; K = DFF; Nd = 2048; }
    else { r -= 22528; const int eg = r / 32; r -= eg * 32; W = P->in[10] + (size_t)eg * 65536; WT = (bf16_t*)(ws + WS_WPOOL) + (size_t)eg * 65536; ldw = 256; K = 256; Nd = 256; }
    const int nblk = Nd / 32, kb = r / nblk, nb = r - kb * nblk, n0 = nb * 32; int src = n0;
    if (n0 < pairLimit) { const int pn = n0 >> 8, c = n0 & 255; src = c < 128 ? pn * 128 + c : Hh + pn * 128 + (c - 128); }
    TItem t; t.src = W + (size_t)(kb * 64) * ldw + src; t.dst = WT + (size_t)n0 * K + kb * 64; t.ldw = ldw; t.K = K; return t;
}
constexpr int T_ITEMS = 6144 + 4096 + 12288 + 4096 + 45056 + 22528 + 256;
__device__ __forceinline__ void titem_load(const TItem& t, float (&r)[32], int lane) {
    const float* p = t.src + (size_t)(lane >> 5) * t.ldw + (lane & 31);
#pragma unroll
    for (int i = 0; i < 32; ++i) r[i] = p[(size_t)(2 * i) * t.ldw];
}
__device__ __forceinline__ void titem_store(const TItem& t, const float (&r)[32], LAS float* scr, int lane) {
#pragma unroll
    for (int i = 0; i < 32; ++i) scr[(2 * i + (lane >> 5)) * 33 + (lane & 31)] = r[i];
    asm volatile("s_waitcnt lgkmcnt(0)" ::: "memory");
    const int c = lane & 7;
#pragma unroll
    for (int j = 0; j < 4; ++j) { const int n = (lane >> 3) + 8 * j; const LAS float* s = scr + (8 * c) * 33 + n;
        u32x4 o; o.x = cvt_pk_bf16(s[0 * 33], s[1 * 33]); o.y = cvt_pk_bf16(s[2 * 33], s[3 * 33]); o.z = cvt_pk_bf16(s[4 * 33], s[5 * 33]); o.w = cvt_pk_bf16(s[6 * 33], s[7 * 33]);
        *(u32x4*)(t.dst + (size_t)n * t.K + 8 * c) = o; }
    asm volatile("s_waitcnt lgkmcnt(0)" ::: "memory");
}
__device__ __forceinline__ void phase_prep(const Ctx& cx, PP P, LAS unsigned char* lds) {
    const int tid = cx.tid, lane = tid & 63, wave = tid >> 6;
    const int G = cx.G, gw = cx.bid * NWAVES + wave, NGW = G * NWAVES;
    LAS float* scr = (LAS float*)(lds + wave * 8448);
    unsigned char* ws = P->ws;
    {
        int it = gw; TItem dA, dB; float ra[32], rb[32];
        if (it < T_ITEMS) { dA = titem_locate(P, ws, it); titem_load(dA, ra, lane); }
        while (it < T_ITEMS) {
            const int itB = it + NGW; const bool hb = itB < T_ITEMS;
            if (hb) { dB = titem_locate(P, ws, itB); titem_load(dB, rb, lane); }
            titem_store(dA, ra, scr, lane);
            if (!hb) break;
            const int itA = itB + NGW; const bool ha = itA < T_ITEMS;
            if (ha) { dA = titem_locate(P, ws, itA); titem_load(dA, ra, lane); }
            titem_store(dB, rb, scr, lane);
            if (!ha) break;
            it = itA;
        }
    }
    {
        bf16_t* wab = (bf16_t*)(ws + WS_WAB);
        for (int i = cx.bid * NTHR + tid; i < 2 * 16 * 2048; i += G * NTHR) { const int o = i >> 15, c = (i >> 11) & 15, k = i & 2047;
            wab[i] = (bf16_t)(cvt_pk_bf16(P->in[17][(size_t)o * 2048 * OD_IN + (size_t)k * OD_IN + OD_INM + c], 0.f) & 0xffff); }
    }
}

template <bool F32OUT>
__device__ __forceinline__ void phase_rmsnorm(const Ctx& cx, float* X, const float* g, bf16_t* Hout, float* Fout, const float* px, int ppu, bool dry, LAS unsigned char* lds) {
    const int tid = cx.tid, lane = tid & 63, wave = __builtin_amdgcn_readfirstlane(tid >> 6);
    const int gw = cx.bid * NWAVES + wave, NGW = cx.G * NWAVES;
    if (ppu > 0) {
        LAS float* red = (LAS float*)lds;
        for (int r = cx.bid; r < BS; r += cx.G) {
            const int m = MPR + r, col = 256 * wave + lane * 4, P8 = 8 * ppu;
            f32x4 a = *(const f32x4*)(X + (size_t)m * D + col);
            const float* pr = px + (size_t)r * 256 + lane * 4 + (size_t)(32 * wave) * 32768;
#pragma unroll
            for (int i = 0; i < 32; ++i) { const int vc = 32 * wave + i; if (((vc + 1) * P8) / 256 > (vc * P8) / 256) a = a + *(const f32x4*)(pr + (size_t)i * 32768); }
            if (!dry) *(f32x4*)(X + (size_t)m * D + col) = a;
            const float ss = wave_sum((a.x * a.x + a.y * a.y) + (a.z * a.z + a.w * a.w));
            if (lane == 0) red[wave] = ss;
            __syncthreads();
            float tot = 0.f;
#pragma unroll
            for (int i = 0; i < 8; ++i) tot += red[i];
            const float rs = rsqrtf(tot * (1.0f / D) + EPS);
            const f32x4 g4 = *(const f32x4*)(g + col); const f32x4 o = a * rs * g4;
            if (F32OUT) *(f32x4*)(Fout + (size_t)m * D + col) = o;
            else { u32x2 w; w.x = cvt_pk_bf16(o.x, o.y); w.y = cvt_pk_bf16(o.z, o.w); *(u32x2*)(Hout + (size_t)m * D + col) = w; }
            __syncthreads();
        }
    }
    const int mend = ppu > 0 ? MPR : MT;
    for (int m = gw; m < mend; m += 4 * NGW) {
        f32x4 v[4][8]; float ss[4]; int mr[4]; bool ok[4];
#pragma unroll
        for (int k = 0; k < 4; ++k) { const int mk = m + k * NGW; ok[k] = mk < mend; mr[k] = ok[k] ? mk : m; const f32x4* xr = (const f32x4*)(X + (size_t)mr[k] * D) + lane;
#pragma unroll
            for (int j = 0; j < 8; ++j) v[k][j] = xr[64 * j]; }
#pragma unroll
        for (int k = 0; k < 4; ++k) { float a = 0.f;
#pragma unroll
            for (int j = 0; j < 8; ++j) a += (v[k][j].x * v[k][j].x + v[k][j].y * v[k][j].y) + (v[k][j].z * v[k][j].z + v[k][j].w * v[k][j].w);
            ss[k] = a; }
#pragma unroll
        for (int o = 1; o < 64; o <<= 1) {
#pragma unroll
            for (int k = 0; k < 4; ++k) ss[k] += __shfl_xor(ss[k], o); }
#pragma unroll
        for (int j = 0; j < 8; ++j) { const f32x4 g4 = ((const f32x4*)g)[lane + 64 * j];
#pragma unroll
            for (int k = 0; k < 4; ++k) if (ok[k]) { const float rs = rsqrtf(ss[k] * (1.0f / D) + EPS); const f32x4 o = v[k][j] * rs * g4;
                if (F32OUT) ((f32x4*)(Fout + (size_t)mr[k] * D))[lane + 64 * j] = o;
                else { u32x2 w; w.x = cvt_pk_bf16(o.x, o.y); w.y = cvt_pk_bf16(o.z, o.w); ((u32x2*)(Hout + (size_t)mr[k] * D))[lane + 64 * j] = w; } } }
    }
}

__device__ __forceinline__ void phase_first_norm(const Ctx& cx, PP P, float* X, const float* g, bf16_t* Hout) {
    const int tid = cx.tid, lane = tid & 63, wave = __builtin_amdgcn_readfirstlane(tid >> 6);
    const int gw = cx.bid * NWAVES + wave, NGW = cx.G * NWAVES;
    for (int m = gw; m < MT; m += NGW) {
        const float* src = m < MPR ? P->in[0] + (size_t)m * D : P->in[1] + (size_t)(m - MPR) * D;
        const f32x4* xr = (const f32x4*)src + lane; f32x4 v[8]; float ss = 0.f;
#pragma unroll
        for (int j = 0; j < 8; ++j) { v[j] = xr[64 * j]; ss += (v[j].x * v[j].x + v[j].y * v[j].y) + (v[j].z * v[j].z + v[j].w * v[j].w); }
        const float rs = rsqrtf(wave_sum(ss) * (1.0f / D) + EPS);
#pragma unroll
        for (int j = 0; j < 8; ++j) { ((f32x4*)(X + (size_t)m * D))[lane + 64 * j] = v[j]; const f32x4 g4 = ((const f32x4*)g)[lane + 64 * j]; const f32x4 o = v[j] * rs * g4;
            u32x2 w; w.x = cvt_pk_bf16(o.x, o.y); w.y = cvt_pk_bf16(o.z, o.w); ((u32x2*)(Hout + (size_t)m * D))[lane + 64 * j] = w; }
    }
}

__device__ __forceinline__ void phase_even_prep(const Ctx& cx, PP P, int e) {
    const int tid = cx.tid, lane = tid & 63, wave = __builtin_amdgcn_readfirstlane(tid >> 6);
    const int gw = cx.bid * NWAVES + wave, NGW = cx.G * NWAVES;
    unsigned char* ws = P->ws;
    const bf16_t* abuf = (const bf16_t*)(ws + WS_ABUF); const bf16_t* uv = (const bf16_t*)(ws + WS_UV);
    bf16_t* pooled = (bf16_t*)(ws + WS_MIX); bf16_t* vn = (bf16_t*)(ws + WS_VN); bf16_t* cat = (bf16_t*)(ws + WS_CAT);
    const float* spool = P->in[2] + (size_t)e * BS * 15 * 1024;
    const float* lng = P->in[12] + e * 1024; const float* lnb = P->in[13] + e * 1024;
    const float* sws = P->in[14] + (size_t)e * 4 * 128 * 128; const float* sb = P->in[15] + e * 4 * 128;
    float* out = P->out;
    constexpr int GPS = (SEQ + 4) / 5;
    for (int task = gw; task < BP * GPS + BS; task += NGW) {
      if (task >= BP * GPS) {
        const int m = MPR + task - BP * GPS; const bool prompt = false; const int b = m - MPR, t = 0;
#pragma unroll
        for (int p = 0; p < 4; ++p) {
            const int w = 2 << p, ch0 = p * 256 + lane * 4;
            float cur[4], sacc[4];
            { const u32x2 r = *(const u32x2*)(abuf + (size_t)m * 1024 + ch0); cur[0] = bf_lo(r.x); cur[1] = bf_hi(r.x); cur[2] = bf_lo(r.y); cur[3] = bf_hi(r.y); }
#pragma unroll
            for (int i = 0; i < 4; ++i) sacc[i] = cur[i];
            float cnt;
            if (prompt) {
#pragma unroll
                for (int d = 1; d < w; ++d) if (t - d >= 0) { const u32x2 r = *(const u32x2*)(abuf + (size_t)(m - d) * 1024 + ch0);
                    sacc[0] += bf_lo(r.x); sacc[1] += bf_hi(r.x); sacc[2] += bf_lo(r.y); sacc[3] += bf_hi(r.y); }
                cnt = (float)(w < t + 1 ? w : t + 1);
            } else {
#pragma unroll
                for (int d = 1; d < w; ++d) { const f32x4 h0 = *(const f32x4*)(spool + ((size_t)b * 15 + (15 - d)) * 1024 + ch0);
                    sacc[0] += h0.x; sacc[1] += h0.y; sacc[2] += h0.z; sacc[3] += h0.w; }
                cnt = (float)w;
            }
            const float ic = 1.0f / cnt;
            u32x2 pw; pw.x = cvt_pk_bf16(sacc[0] * ic - cur[0], sacc[1] * ic - cur[1]); pw.y = cvt_pk_bf16(sacc[2] * ic - cur[2], sacc[3] * ic - cur[3]);
            *(u32x2*)(pooled + (size_t)m * 1024 + ch0) = pw;
            const f32x4 c4 = (f32x4){cur[0], cur[1], cur[2], cur[3]};
            if (prompt) { if (t >= SEQ - 15) *(f32x4*)(out + O_PP + (((size_t)e * BP + b) * 15 + (t - (SEQ - 15))) * 1024 + ch0) = c4; }
            else { float* ob = out + O_PS + ((size_t)e * BS + b) * 15 * 1024 + ch0;
                *(f32x4*)(ob + 14 * 1024) = c4; }
        }
        float v[2][8]; float sm = 0.f;
#pragma unroll
        for (int jj = 0; jj < 2; ++jj) { const int ch0 = (lane + 64 * jj) * 8; const u32x4 r = *(const u32x4*)(uv + (size_t)m * 2048 + 1024 + ch0); unpack8(r, v[jj]);
#pragma unroll
            for (int i = 0; i < 8; ++i) sm += v[jj][i]; }
        const float mu = wave_sum(sm) * (1.0f / 1024.f); float sq = 0.f;
#pragma unroll
        for (int jj = 0; jj < 2; ++jj)
#pragma unroll
            for (int i = 0; i < 8; ++i) { v[jj][i] -= mu; sq += v[jj][i] * v[jj][i]; }
        const float rstd = rsqrtf(wave_sum(sq) * (1.0f / 1024.f) + EPS);
#pragma unroll
        for (int jj = 0; jj < 2; ++jj) { const int ch0 = (lane + 64 * jj) * 8; float o[8];
#pragma unroll
            for (int i = 0; i < 8; ++i) o[i] = v[jj][i] * rstd * lng[ch0 + i] + lnb[ch0 + i];
            *(u32x4*)(vn + (size_t)m * 1024 + ch0) = pack8(o);
            if (!prompt) {
                float* op = out + O_SV + ((size_t)e * BS + b) * 1024 + ch0;
                *(f32x4*)op = (f32x4){o[0], o[1], o[2], o[3]}; *(f32x4*)(op + 4) = (f32x4){o[4], o[5], o[6], o[7]};
                const int h = ch0 >> 8; const float w00 = sws[(size_t)h * 128 * 128], b0 = sb[h * 128];
                float uu[8]; const u32x4 r = *(const u32x4*)(uv + (size_t)m * 2048 + ch0); unpack8(r, uu);
                float c[8];
#pragma unroll
                for (int i = 0; i < 8; ++i) c[i] = uu[i] * (w00 * o[i] + b0);
                *(u32x4*)(cat + (size_t)m * 2048 + 1024 + ch0) = pack8(c);
            } }
      }
      else {
        const int b = task / GPS, gi = task - b * GPS, t0 = gi * 5, R = (SEQ - t0) < 5 ? (SEQ - t0) : 5, mbase = b * SEQ + t0;
#pragma unroll
        for (int p = 0; p < 4; ++p) {
            constexpr int dummy = 0; (void)dummy;
            const int w = 2 << p, ch0 = p * 256 + lane * 4;
            float x[20][4];
#pragma unroll
            for (int i = 0; i < 20; ++i) if (i < w + 4) { const int ti = t0 - (w - 1) + i; const bool valid = (ti >= 0) && (i < w - 1 + R);
                const u32x2 r = *(const u32x2*)(abuf + (size_t)(valid ? mbase - (w - 1) + i : mbase) * 1024 + ch0);
                x[i][0] = valid ? bf_lo(r.x) : 0.f; x[i][1] = valid ? bf_hi(r.x) : 0.f; x[i][2] = valid ? bf_lo(r.y) : 0.f; x[i][3] = valid ? bf_hi(r.y) : 0.f; }
            float sacc[4] = {0.f, 0.f, 0.f, 0.f};
#pragma unroll
            for (int i = 0; i < 16; ++i) if (i < w) {
#pragma unroll
                for (int c = 0; c < 4; ++c) sacc[c] += x[i][c]; }
#pragma unroll
            for (int r = 0; r < 5; ++r) {
                if (r > 0) {
#pragma unroll
                    for (int c = 0; c < 4; ++c) sacc[c] += x[r + w - 1][c] - x[r - 1][c]; }
                const int t = t0 + r; const float ic = 1.0f / (float)(w < t + 1 ? w : t + 1);
                const float* cur = x[r + w - 1];
                if (r < R) { u32x2 pw; pw.x = cvt_pk_bf16(sacc[0] * ic - cur[0], sacc[1] * ic - cur[1]); pw.y = cvt_pk_bf16(sacc[2] * ic - cur[2], sacc[3] * ic - cur[3]);
                    *(u32x2*)(pooled + (size_t)(mbase + r) * 1024 + ch0) = pw;
                    if (t >= SEQ - 15) *(f32x4*)(out + O_PP + (((size_t)e * BP + b) * 15 + (t - (SEQ - 15))) * 1024 + ch0) = (f32x4){cur[0], cur[1], cur[2], cur[3]}; }
            }
        }
        float v[5][2][8]; float sm[5], sq[5];
#pragma unroll
        for (int r = 0; r < 5; ++r) { const int mr = mbase + (r < R ? r : 0); float a = 0.f;
#pragma unroll
            for (int jj = 0; jj < 2; ++jj) { const int ch0 = (lane + 64 * jj) * 8; const u32x4 q = *(const u32x4*)(uv + (size_t)mr * 2048 + 1024 + ch0); unpack8(q, v[r][jj]);
#pragma unroll
                for (int i = 0; i < 8; ++i) a += v[r][jj][i]; }
            sm[r] = a; }
#pragma unroll
        for (int of = 1; of < 64; of <<= 1) {
#pragma unroll
            for (int r = 0; r < 5; ++r) sm[r] += __shfl_xor(sm[r], of); }
#pragma unroll
        for (int r = 0; r < 5; ++r) { const float mu = sm[r] * (1.0f / 1024.f); float a = 0.f;
#pragma unroll
            for (int jj = 0; jj < 2; ++jj)
#pragma unroll
                for (int i = 0; i < 8; ++i) { v[r][jj][i] -= mu; a += v[r][jj][i] * v[r][jj][i]; }
            sq[r] = a; }
#pragma unroll
        for (int of = 1; of < 64; of <<= 1) {
#pragma unroll
            for (int r = 0; r < 5; ++r) sq[r] += __shfl_xor(sq[r], of); }
#pragma unroll
        for (int jj = 0; jj < 2; ++jj) { const int ch0 = (lane + 64 * jj) * 8;
            const f32x4 g0 = *(const f32x4*)(lng + ch0), g1 = *(const f32x4*)(lng + ch0 + 4), b0 = *(const f32x4*)(lnb + ch0), b1 = *(const f32x4*)(lnb + ch0 + 4);
            const float gg[8] = {g0.x, g0.y, g0.z, g0.w, g1.x, g1.y, g1.z, g1.w}, bb[8] = {b0.x, b0.y, b0.z, b0.w, b1.x, b1.y, b1.z, b1.w};
#pragma unroll
            for (int r = 0; r < 5; ++r) if (r < R) { const float rstd = rsqrtf(sq[r] * (1.0f / 1024.f) + EPS); float o8[8];
#pragma unroll
                for (int i = 0; i < 8; ++i) o8[i] = v[r][jj][i] * rstd * gg[i] + bb[i];
                *(u32x4*)(vn + (size_t)(mbase + r) * 1024 + ch0) = pack8(o8); } }
      }
    }
}

__device__ __forceinline__ void phase_sgu(const Ctx& cx, PP P, int e, LAS unsigned char* lds) {
    const int tid = cx.tid, lane = tid & 63, wave = __builtin_amdgcn_readfirstlane(tid >> 6), l15 = lane & 15, quad = lane >> 4;
    const int G = cx.G;
    unsigned char* ws = P->ws;
    const bf16_t* uv = (const bf16_t*)(ws + WS_UV); const bf16_t* vn = (const bf16_t*)(ws + WS_VN); bf16_t* cat = (bf16_t*)(ws + WS_CAT);
    const float* sws = P->in[14] + (size_t)e * 4 * 128 * 128; const float* sb = P->in[15] + e * 4 * 128;
    LAS bf16_t* VT = (LAS bf16_t*)lds;
    for (int task = (G - 1 - cx.bid); task < 256; task += G) {
        const int b = task >> 6, n = (task >> 2) & 15, h = task & 3; const int m0 = b * SEQ + n * 128;
        for (int idx = tid; idx < 128 * 32; idx += NTHR) { const int r = idx >> 5, cq = idx & 31;
            const u32x4 w = *(const u32x4*)(vn + (size_t)(m0 + r) * 1024 + h * 256 + cq * 8);
            LAS bf16_t* d = VT + (cq * 8) * 136 + (r ^ ((cq & 7) << 3));
            d[0 * 136] = (bf16_t)(w.x & 0xffff); d[1 * 136] = (bf16_t)(w.x >> 16); d[2 * 136] = (bf16_t)(w.y & 0xffff); d[3 * 136] = (bf16_t)(w.y >> 16);
            d[4 * 136] = (bf16_t)(w.z & 0xffff); d[5 * 136] = (bf16_t)(w.z >> 16); d[6 * 136] = (bf16_t)(w.w & 0xffff); d[7 * 136] = (bf16_t)(w.w >> 16); }
        __syncthreads();
        const int irow = 16 * wave + l15;
        bf16x8 af[4];
#pragma unroll
        for (int ks = 0; ks < 4; ++ks) { const int k0 = ks * 32 + quad * 8; const float* wp = sws + ((size_t)h * 128 + irow) * 128 + k0; const f32x4 a0 = *(const f32x4*)wp, a1 = *(const f32x4*)(wp + 4);
            float f[8] = {a0.x, a0.y, a0.z, a0.w, a1.x, a1.y, a1.z, a1.w};
#pragma unroll
            for (int i = 0; i < 8; ++i) if (k0 + i > irow) f[i] = 0.f;
            const u32x4 pw = pack8(f); af[ks] = __builtin_bit_cast(bf16x8, pw); }
        const float bias = sb[h * 128 + irow];
#pragma unroll 2
        for (int nt = 0; nt < 16; ++nt) {
            f32x4 acc = (f32x4){0.f, 0.f, 0.f, 0.f};
#pragma unroll
            for (int ks = 0; ks < 4; ++ks) { const bf16x8 bfr = *(const LAS bf16x8*)(VT + (nt * 16 + l15) * 136 + ((ks * 32 + quad * 8) ^ ((((nt * 16 + l15) >> 3) & 7) << 3)));
                acc = __builtin_amdgcn_mfma_f32_16x16x32_bf16(bfr, af[ks], acc, 0, 0, 0); }
            const int c0 = h * 256 + nt * 16 + quad * 4;
            const u32x2 uw = *(const u32x2*)(uv + (size_t)(m0 + irow) * 2048 + c0);
            u32x2 ow; ow.x = cvt_pk_bf16(bf_lo(uw.x) * (acc[0] + bias), bf_hi(uw.x) * (acc[1] + bias)); ow.y = cvt_pk_bf16(bf_lo(uw.y) * (acc[2] + bias), bf_hi(uw.y) * (acc[3] + bias));
            *(u32x2*)(cat + (size_t)(m0 + irow) * 2048 + 1024 + c0) = ow;
        }
        __syncthreads();
    }
}

__device__ __forceinline__ void phase_ab(const Ctx& cx, PP P, int o) {
    const int tid = cx.tid, lane = tid & 63, l15 = lane & 15, quad = lane >> 4, wave = __builtin_amdgcn_readfirstlane(tid >> 6);
    const int gw = cx.bid * NWAVES + wave, NGW = cx.G * NWAVES;
    const bf16_t* H = (const bf16_t*)(P->ws + WS_H); float* AB = (float*)(P->ws + WS_AB);
    const bf16_t* Wt = (const bf16_t*)(P->ws + WS_WAB) + (size_t)o * 16 * 2048;
    for (int tt = NGW - 1 - gw; tt < MT / 16; tt += NGW) {
        const bf16_t* ap = H + (size_t)(16 * tt + l15) * D + quad * 8; const bf16_t* bp = Wt + (size_t)l15 * 2048 + quad * 8;
        f32x4 acc = (f32x4){0.f, 0.f, 0.f, 0.f};
#pragma unroll 16
        for (int ks = 0; ks < 64; ++ks) { const bf16x8 a = *(const bf16x8*)(ap + ks * 32), b = *(const bf16x8*)(bp + ks * 32); acc = __builtin_amdgcn_mfma_f32_16x16x32_bf16(a, b, acc, 0, 0, 0); }
#pragma unroll
        for (int j = 0; j < 4; ++j) AB[(size_t)(16 * tt + quad * 4 + j) * 16 + l15] = acc[j];
    }
}

__device__ __forceinline__ void phase_odd_prep(const Ctx& cx, PP P, int o, LAS unsigned char* lds) {
    const int tid = cx.tid, lane = tid & 63, wave = __builtin_amdgcn_readfirstlane(tid >> 6);
    const int gw = cx.bid * NWAVES + wave, NGW = cx.G * NWAVES;
    unsigned char* ws = P->ws;
    const bf16_t* glu = (const bf16_t*)(ws + WS_ABUF); const bf16_t* qkv = (const bf16_t*)(ws + WS_UV);
    bf16_t* qkvc = (bf16_t*)(ws + WS_MIX); bf16_t* cat = (bf16_t*)(ws + WS_CAT);
    const float* AB = (const float*)(ws + WS_AB); float* Gg = (float*)(ws + WS_G); float* Bt = (float*)(ws + WS_BETA);
    const float* sconv = P->in[3] + (size_t)o * BS * 30 * 1024; const float* sdn = P->in[4] + (size_t)o * BS * 3 * 3072;
    const float* dw = P->in[18] + (size_t)o * 31 * 1024; const float* db = P->in[19] + o * 1024; const float* lng = P->in[20] + o * 1024; const float* lnb = P->in[21] + o * 1024;
    const float* cw = P->in[22] + (size_t)o * 4 * 3072; const float* alog = P->in[23] + o * 8; const float* dtb = P->in[24] + o * 8;
    float* out = P->out;
    LAS float* dwl = (LAS float*)lds;
    constexpr int GPS = (SEQ + 4) / 5;
#pragma unroll 8
    for (int i = tid; i < 31 * 256; i += NTHR) ((LAS f32x4*)dwl)[i] = ((const f32x4*)dw)[i];
    __syncthreads();
    for (int task = gw; task < BP * GPS + BS; task += NGW) {
      if (task >= BP * GPS) {
        const int m = MPR + task - BP * GPS; const bool prompt = false; const int b = m - MPR, t = 0;
        float y[2][8]; float sm = 0.f;
#pragma unroll
        for (int jj = 0; jj < 2; ++jj) {
            const int ch0 = (lane + 64 * jj) * 8;
            { const f32x4 d0 = *(const f32x4*)(db + ch0), d1 = *(const f32x4*)(db + ch0 + 4); y[jj][0] = d0.x; y[jj][1] = d0.y; y[jj][2] = d0.z; y[jj][3] = d0.w; y[jj][4] = d1.x; y[jj][5] = d1.y; y[jj][6] = d1.z; y[jj][7] = d1.w; }
            float cur[8];
            { const u32x4 r = *(const u32x4*)(glu + (size_t)m * 1024 + ch0); unpack8(r, cur); }
            { const f32x4 w0 = *(const LAS f32x4*)(dwl + 30 * 1024 + ch0), w1 = *(const LAS f32x4*)(dwl + 30 * 1024 + ch0 + 4);
              y[jj][0] += w0.x * cur[0]; y[jj][1] += w0.y * cur[1]; y[jj][2] += w0.z * cur[2]; y[jj][3] += w0.w * cur[3]; y[jj][4] += w1.x * cur[4]; y[jj][5] += w1.y * cur[5]; y[jj][6] += w1.z * cur[6]; y[jj][7] += w1.w * cur[7]; }
            if (prompt) {
                const int j0 = t >= 30 ? 0 : 30 - t;
#pragma unroll
                for (int hh = 0; hh < 2; ++hh) {
                    u32x4 rr[15];
#pragma unroll
                    for (int jx = 0; jx < 15; ++jx) { const int j = hh * 15 + jx; const int jm = (j >= j0) ? (m - 30 + j) : m; rr[jx] = *(const u32x4*)(glu + (size_t)jm * 1024 + ch0); }
#pragma unroll
                    for (int jx = 0; jx < 15; ++jx) { const int j = hh * 15 + jx; if (j >= j0) { float x[8]; unpack8(rr[jx], x);
                        const f32x4 w0 = *(const LAS f32x4*)(dwl + j * 1024 + ch0), w1 = *(const LAS f32x4*)(dwl + j * 1024 + ch0 + 4);
                        y[jj][0] += w0.x * x[0]; y[jj][1] += w0.y * x[1]; y[jj][2] += w0.z * x[2]; y[jj][3] += w0.w * x[3]; y[jj][4] += w1.x * x[4]; y[jj][5] += w1.y * x[5]; y[jj][6] += w1.z * x[6]; y[jj][7] += w1.w * x[7]; } }
                    asm volatile("" ::: "memory");
                }
            } else {
#pragma unroll 10
                for (int j = 0; j < 30; ++j) { const float* hp = sconv + ((size_t)b * 30 + j) * 1024 + ch0; const f32x4 h0 = *(const f32x4*)hp, h1 = *(const f32x4*)(hp + 4);
                    const f32x4 w0 = *(const LAS f32x4*)(dwl + j * 1024 + ch0), w1 = *(const LAS f32x4*)(dwl + j * 1024 + ch0 + 4);
                    y[jj][0] += w0.x * h0.x; y[jj][1] += w0.y * h0.y; y[jj][2] += w0.z * h0.z; y[jj][3] += w0.w * h0.w; y[jj][4] += w1.x * h1.x; y[jj][5] += w1.y * h1.y; y[jj][6] += w1.z * h1.z; y[jj][7] += w1.w * h1.w; }
            }
#pragma unroll
            for (int i = 0; i < 8; ++i) sm += y[jj][i];
            if (prompt) { if (t >= SEQ - 30) { float* op = out + O_CP + (((size_t)o * BP + b) * 30 + (t - (SEQ - 30))) * 1024 + ch0;
                    *(f32x4*)op = (f32x4){cur[0], cur[1], cur[2], cur[3]}; *(f32x4*)(op + 4) = (f32x4){cur[4], cur[5], cur[6], cur[7]}; } }
            else { float* ob = out + O_CS + ((size_t)o * BS + b) * 30 * 1024 + ch0;
                *(f32x4*)(ob + 29 * 1024) = (f32x4){cur[0], cur[1], cur[2], cur[3]}; *(f32x4*)(ob + 29 * 1024 + 4) = (f32x4){cur[4], cur[5], cur[6], cur[7]}; }
        }
        const float mu = wave_sum(sm) * (1.0f / 1024.f); float sq = 0.f;
#pragma unroll
        for (int jj = 0; jj < 2; ++jj)
#pragma unroll
            for (int i = 0; i < 8; ++i) { y[jj][i] -= mu; sq += y[jj][i] * y[jj][i]; }
        const float rstd = rsqrtf(wave_sum(sq) * (1.0f / 1024.f) + EPS);
#pragma unroll
        for (int jj = 0; jj < 2; ++jj) { const int ch0 = (lane + 64 * jj) * 8; float c[8];
#pragma unroll
            for (int i = 0; i < 8; ++i) c[i] = siluf_(y[jj][i] * rstd * lng[ch0 + i] + lnb[ch0 + i]);
            *(u32x4*)(cat + (size_t)m * 2048 + ch0) = pack8(c); }
          }
      else {
        const int b = task / GPS, gi = task - b * GPS, t0 = gi * 5, R = (SEQ - t0) < 5 ? (SEQ - t0) : 5, mbase = b * SEQ + t0;
        float y[2][5][8];
#pragma unroll
        for (int jj = 0; jj < 2; ++jj) { const int ch0 = (lane + 64 * jj) * 8; const f32x4 d0 = *(const f32x4*)(db + ch0), d1 = *(const f32x4*)(db + ch0 + 4);
#pragma unroll
            for (int r = 0; r < 5; ++r) { y[jj][r][0] = d0.x; y[jj][r][1] = d0.y; y[jj][r][2] = d0.z; y[jj][r][3] = d0.w; y[jj][r][4] = d1.x; y[jj][r][5] = d1.y; y[jj][r][6] = d1.z; y[jj][r][7] = d1.w; } }
#pragma unroll 1
        for (int bt = 0; bt < 5; ++bt) {
            u32x4 rg[2][7];
#pragma unroll
            for (int jj = 0; jj < 2; ++jj)
#pragma unroll
                for (int k = 0; k < 7; ++k) { const int rr = bt * 7 + k; const bool valid = (t0 - 30 + rr >= 0) && (rr < 30 + R);
                    const u32x4 v = *(const u32x4*)(glu + (size_t)(valid ? mbase - 30 + rr : mbase) * 1024 + (lane + 64 * jj) * 8); rg[jj][k] = valid ? v : (u32x4){0u, 0u, 0u, 0u}; }
#pragma unroll
            for (int jj = 0; jj < 2; ++jj) { const int ch0 = (lane + 64 * jj) * 8;
#pragma unroll
                for (int k = 0; k < 7; ++k) { const int rr = bt * 7 + k; float x[8]; unpack8(rg[jj][k], x);
#pragma unroll
                    for (int r = 0; r < 5; ++r) { const int j = rr - r; if (j >= 0 && j <= 30) {
                        const LAS float* wp = dwl + j * 1024 + ch0; const f32x4 w0 = *(const LAS f32x4*)wp, w1 = *(const LAS f32x4*)(wp + 4);
                        y[jj][r][0] += w0.x * x[0]; y[jj][r][1] += w0.y * x[1]; y[jj][r][2] += w0.z * x[2]; y[jj][r][3] += w0.w * x[3]; y[jj][r][4] += w1.x * x[4]; y[jj][r][5] += w1.y * x[5]; y[jj][r][6] += w1.z * x[6]; y[jj][r][7] += w1.w * x[7]; } } } }
        }
        if (t0 + R > SEQ - 30) {
#pragma unroll
            for (int jj = 0; jj < 2; ++jj) { const int ch0 = (lane + 64 * jj) * 8;
                for (int r = 0; r < R; ++r) if (t0 + r >= SEQ - 30) { float c8[8]; const u32x4 v = *(const u32x4*)(glu + (size_t)(mbase + r) * 1024 + ch0); unpack8(v, c8);
                    float* op = out + O_CP + (((size_t)o * BP + b) * 30 + (t0 + r - (SEQ - 30))) * 1024 + ch0;
                    *(f32x4*)op = (f32x4){c8[0], c8[1], c8[2], c8[3]}; *(f32x4*)(op + 4) = (f32x4){c8[4], c8[5], c8[6], c8[7]}; } } }
        float sm[5], sq[5];
#pragma unroll
        for (int r = 0; r < 5; ++r) { float a = 0.f;
#pragma unroll
            for (int jj = 0; jj < 2; ++jj)
#pragma unroll
                for (int i = 0; i < 8; ++i) a += y[jj][r][i];
            sm[r] = a; }
#pragma unroll
        for (int of = 1; of < 64; of <<= 1) {
#pragma unroll
            for (int r = 0; r < 5; ++r) sm[r] += __shfl_xor(sm[r], of); }
#pragma unroll
        for (int r = 0; r < 5; ++r) { const float mu = sm[r] * (1.0f / 1024.f); float a = 0.f;
#pragma unroll
            for (int jj = 0; jj < 2; ++jj)
#pragma unroll
                for (int i = 0; i < 8; ++i) { y[jj][r][i] -= mu; a += y[jj][r][i] * y[jj][r][i]; }
            sq[r] = a; }
#pragma unroll
        for (int of = 1; of < 64; of <<= 1) {
#pragma unroll
            for (int r = 0; r < 5; ++r) sq[r] += __shfl_xor(sq[r], of); }
#pragma unroll
        for (int jj = 0; jj < 2; ++jj) { const int ch0 = (lane + 64 * jj) * 8;
            const f32x4 g0 = *(const f32x4*)(lng + ch0), g1 = *(const f32x4*)(lng + ch0 + 4), b0 = *(const f32x4*)(lnb + ch0), b1 = *(const f32x4*)(lnb + ch0 + 4);
            const float gg[8] = {g0.x, g0.y, g0.z, g0.w, g1.x, g1.y, g1.z, g1.w}, bb[8] = {b0.x, b0.y, b0.z, b0.w, b1.x, b1.y, b1.z, b1.w};
#pragma unroll
            for (int r = 0; r < 5; ++r) if (r < R) { const float rstd = rsqrtf(sq[r] * (1.0f / 1024.f) + EPS); float c[8];
#pragma unroll
                for (int i = 0; i < 8; ++i) c[i] = siluf_(y[jj][r][i] * rstd * gg[i] + bb[i]);
                *(u32x4*)(cat + (size_t)(mbase + r) * 2048 + ch0) = pack8(c); } }
      }
    }
    asm volatile("" ::: "memory"); __builtin_amdgcn_sched_barrier(0);
    for (int task = gw; task < BP * GPS + BS; task += NGW) {
      if (task >= BP * GPS) {
        const int m = MPR + task - BP * GPS; const bool prompt = false; const int b = m - MPR, t = 0;
#pragma unroll
        for (int jj = 0; jj < 6; ++jj) {
            const int ch0 = (lane + 64 * jj) * 8; float a[8], cur[8];
#pragma unroll
            for (int i = 0; i < 8; ++i) a[i] = 0.f;
#pragma unroll
            for (int j = 0; j < 4; ++j) {
                float x[8]; bool have = true;
                if (j == 3 || prompt) { const int tt = t - 3 + j; if (tt >= 0) { const u32x4 r = *(const u32x4*)(qkv + (size_t)(m - 3 + j) * 3072 + ch0); unpack8(r, x); } else have = false; }
                else { const float* hp = sdn + ((size_t)b * 3 + j) * 3072 + ch0; const f32x4 h0 = *(const f32x4*)hp, h1 = *(const f32x4*)(hp + 4); x[0] = h0.x; x[1] = h0.y; x[2] = h0.z; x[3] = h0.w; x[4] = h1.x; x[5] = h1.y; x[6] = h1.z; x[7] = h1.w; }
                if (have) { const f32x4 w0 = *(const f32x4*)(cw + j * 3072 + ch0), w1 = *(const f32x4*)(cw + j * 3072 + ch0 + 4);
                    a[0] += w0.x * x[0]; a[1] += w0.y * x[1]; a[2] += w0.z * x[2]; a[3] += w0.w * x[3]; a[4] += w1.x * x[4]; a[5] += w1.y * x[5]; a[6] += w1.z * x[6]; a[7] += w1.w * x[7];
                    if (j == 3) {
#pragma unroll
                        for (int i = 0; i < 8; ++i) cur[i] = x[i]; } }
            }
            float ss = 0.f;
#pragma unroll
            for (int i = 0; i < 8; ++i) { a[i] = siluf_(a[i]); ss += a[i] * a[i]; }
            if (jj < 4) { ss = grp16_sum(ss); float r = rsqrtf(ss + EPS); if (jj < 2) r *= 0.08838834764831845f;
#pragma unroll
                for (int i = 0; i < 8; ++i) a[i] *= r; }
            *(u32x4*)(qkvc + (size_t)m * 3072 + ch0) = pack8(a);
            if (prompt) { if (t >= SEQ - 3) { float* op = out + O_DCP + (((size_t)o * BP + b) * 3 + (t - (SEQ - 3))) * 3072 + ch0;
                    *(f32x4*)op = (f32x4){cur[0], cur[1], cur[2], cur[3]}; *(f32x4*)(op + 4) = (f32x4){cur[4], cur[5], cur[6], cur[7]}; } }
            else { float* ob = out + O_DCS + ((size_t)o * BS + b) * 3 * 3072 + ch0;
                *(f32x4*)(ob + 2 * 3072) = (f32x4){cur[0], cur[1], cur[2], cur[3]}; *(f32x4*)(ob + 2 * 3072 + 4) = (f32x4){cur[4], cur[5], cur[6], cur[7]}; }
        }
        if (lane < 8) { const float av = AB[(size_t)m * 16 + lane] + dtb[lane], bv = AB[(size_t)m * 16 + 8 + lane];
            const float sp = av > 20.f ? av : log1pf(expf(av));
            Gg[(size_t)m * 8 + lane] = -expf(alog[lane]) * sp; Bt[(size_t)m * 8 + lane] = 1.0f / (1.0f + expf(-bv)); }
      }
      else {
        const int b = task / GPS, gi = task - b * GPS, t0 = gi * 5, R = (SEQ - t0) < 5 ? (SEQ - t0) : 5, mbase = b * SEQ + t0;
#pragma unroll 1
        for (int jj = 0; jj < 6; ++jj) {
            const int ch0 = (lane + 64 * jj) * 8;
            f32x4 w[4][2];
#pragma unroll
            for (int j = 0; j < 4; ++j) { w[j][0] = *(const f32x4*)(cw + j * 3072 + ch0); w[j][1] = *(const f32x4*)(cw + j * 3072 + ch0 + 4); }
            u32x4 rg[8];
#pragma unroll
            for (int rr = 0; rr < 8; ++rr) { const bool valid = (t0 - 3 + rr >= 0) && (rr < 3 + R);
                const u32x4 v = *(const u32x4*)(qkv + (size_t)(valid ? mbase - 3 + rr : mbase) * 3072 + ch0); rg[rr] = valid ? v : (u32x4){0u, 0u, 0u, 0u}; }
            float a[5][8];
#pragma unroll
            for (int r = 0; r < 5; ++r)
#pragma unroll
                for (int i = 0; i < 8; ++i) a[r][i] = 0.f;
#pragma unroll
            for (int rr = 0; rr < 8; ++rr) { float x[8]; unpack8(rg[rr], x);
#pragma unroll
                for (int r = 0; r < 5; ++r) { const int j = rr - r; if (j >= 0 && j <= 3) {
                    a[r][0] += w[j][0].x * x[0]; a[r][1] += w[j][0].y * x[1]; a[r][2] += w[j][0].z * x[2]; a[r][3] += w[j][0].w * x[3];
                    a[r][4] += w[j][1].x * x[4]; a[r][5] += w[j][1].y * x[5]; a[r][6] += w[j][1].z * x[6]; a[r][7] += w[j][1].w * x[7]; } } }
            float ss[5];
#pragma unroll
            for (int r = 0; r < 5; ++r) { float q = 0.f;
#pragma unroll
                for (int i = 0; i < 8; ++i) { a[r][i] = siluf_(a[r][i]); q += a[r][i] * a[r][i]; }
                ss[r] = q; }
            if (jj < 4) {
#pragma unroll
                for (int of = 1; of < 16; of <<= 1) {
#pragma unroll
                    for (int r = 0; r < 5; ++r) ss[r] += __shfl_xor(ss[r], of); }
#pragma unroll
                for (int r = 0; r < 5; ++r) { float sc = rsqrtf(ss[r] + EPS); if (jj < 2) sc *= 0.08838834764831845f;
#pragma unroll
                    for (int i = 0; i < 8; ++i) a[r][i] *= sc; } }
#pragma unroll
            for (int r = 0; r < 5; ++r) if (r < R) *(u32x4*)(qkvc + (size_t)(mbase + r) * 3072 + ch0) = pack8(a[r]);
            if (t0 + R > SEQ - 3) {
#pragma unroll
                for (int r = 0; r < 5; ++r) if (r < R && t0 + r >= SEQ - 3) { float c8[8]; unpack8(rg[r + 3], c8);
                    float* op = out + O_DCP + (((size_t)o * BP + b) * 3 + (t0 + r - (SEQ - 3))) * 3072 + ch0;
                    *(f32x4*)op = (f32x4){c8[0], c8[1], c8[2], c8[3]}; *(f32x4*)(op + 4) = (f32x4){c8[4], c8[5], c8[6], c8[7]}; } }
        }
        if (lane < 40) { const int r = lane >> 3, hh = lane & 7; if (r < R) { const int m = mbase + r;
            const float av = AB[(size_t)m * 16 + hh] + dtb[hh], bv = AB[(size_t)m * 16 + 8 + hh];
            const float sp = av > 20.f ? av : log1pf(expf(av));
            Gg[(size_t)m * 8 + hh] = -expf(alog[hh]) * sp; Bt[(size_t)m * 8 + hh] = 1.0f / (1.0f + expf(-bv)); } }
      }
    }
}

__device__ __forceinline__ void phase_dn_intra(const Ctx& cx, PP P, int o, LAS unsigned char* lds) {
    const int tid = cx.tid, lane = tid & 63, l15 = lane & 15, quad = lane >> 4;
    const int hb = __builtin_amdgcn_readfirstlane(tid >> 8), htid = tid & 255, hw = __builtin_amdgcn_readfirstlane((tid >> 6) & 3);
    const int G = cx.G;
    unsigned char* ws = P->ws;
    const bf16_t* qkvc = (const bf16_t*)(ws + WS_MIX); const float* Gg = (const float*)(ws + WS_G); const float* Bt = (const float*)(ws + WS_BETA);
    float* CU = (float*)(ws + WS_CU); bf16_t* CW = (bf16_t*)(ws + WS_CW); bf16_t* CQD = (bf16_t*)(ws + WS_CQD); bf16_t* CKDT = (bf16_t*)(ws + WS_CKDT); bf16_t* CQK = (bf16_t*)(ws + WS_CQK); float* CGL = (float*)(ws + WS_CGL);
    LAS float* L = (LAS float*)lds + hb * 4352; LAS float* gcs = L + 4096; LAS float* bet = L + 4096 + 64;
    for (int p = cx.bid; p < 512; p += G) {
        const int ci = 2 * p + hb, bh = ci >> 5, n = ci & 31, b = bh >> 3, h = bh & 7, m0 = b * SEQ + n * 64;
        if (hw == 0) { float g = Gg[(size_t)(m0 + lane) * 8 + h];
#pragma unroll
            for (int off = 1; off < 64; off <<= 1) { const float tv = __shfl_up(g, off); if (lane >= off) g += tv; }
            gcs[lane] = g; bet[lane] = Bt[(size_t)(m0 + lane) * 8 + h]; }
        __syncthreads();
        {
            const int mt = hw; const bf16_t* rp = qkvc + (size_t)(m0 + 16 * mt + l15) * 3072 + h * 128;
            bf16x8 ak[4], aq[4];
#pragma unroll
            for (int ks = 0; ks < 4; ++ks) { aq[ks] = *(const bf16x8*)(rp + ks * 32 + quad * 8); ak[ks] = *(const bf16x8*)(rp + 1024 + ks * 32 + quad * 8); }
#pragma unroll
            for (int nt = 0; nt < 4; ++nt) {
                f32x4 accK = (f32x4){0.f, 0.f, 0.f, 0.f}, accQ = (f32x4){0.f, 0.f, 0.f, 0.f};
                if (nt <= mt) { const bf16_t* bp = qkvc + (size_t)(m0 + 16 * nt + l15) * 3072 + 1024 + h * 128;
#pragma unroll
                    for (int ks = 0; ks < 4; ++ks) { const bf16x8 bk = *(const bf16x8*)(bp + ks * 32 + quad * 8);
                        accK = __builtin_amdgcn_mfma_f32_16x16x32_bf16(ak[ks], bk, accK, 0, 0, 0); accQ = __builtin_amdgcn_mfma_f32_16x16x32_bf16(aq[ks], bk, accQ, 0, 0, 0); } }
                const int j = 16 * nt + l15; const float gj = gcs[j];
#pragma unroll
                for (int jj = 0; jj < 4; ++jj) { const int i = 16 * mt + quad * 4 + jj; const float dec = (j <= i) ? __expf(gcs[i] - gj) : 0.f;
                    L[i * 64 + j] = (j < i) ? bet[i] * accK[jj] * dec : 0.f;
                    CQK[(size_t)ci * 4096 + i * 64 + j] = (bf16_t)(cvt_pk_bf16(accQ[jj] * dec, 0.f) & 0xffff); }
            }
        }
        __syncthreads();
        asm volatile("" ::: "memory"); __builtin_amdgcn_sched_barrier(0);
        {
            const int c = htid; float x[64];
            const bf16_t* vp = qkvc + (size_t)m0 * 3072 + (c < 128 ? 2048 + h * 128 + c : 1024 + h * 128 + (c - 128));
#pragma unroll
            for (int i = 0; i < 64; ++i) { const float r = bf1(*vp); vp += 3072; asm volatile("" : "+v"(vp)); const float sc = c < 128 ? bet[i] : bet[i] * __expf(gcs[i]); x[i] = r * sc; }
#pragma unroll
            for (int i = 1; i < 64; ++i) { float a0 = 0.f, a1 = 0.f, a2 = 0.f, a3 = 0.f;
#pragma unroll
                for (int j4 = 0; j4 < (i + 3) / 4; ++j4) { const f32x4 l = *(const LAS f32x4*)(L + i * 64 + j4 * 4);
                    a0 += l.x * x[j4 * 4 + 0]; if (j4 * 4 + 1 < i) a1 += l.y * x[j4 * 4 + 1]; if (j4 * 4 + 2 < i) a2 += l.z * x[j4 * 4 + 2]; if (j4 * 4 + 3 < i) a3 += l.w * x[j4 * 4 + 3];
                    if (j4 == 7) asm volatile("" ::: "memory"); }
                x[i] = x[i] - ((a0 + a1) + (a2 + a3)); asm volatile("" ::: "memory"); }
            if (c < 128) { float* up = CU + (size_t)ci * 8192 + c;
#pragma unroll
                for (int i = 0; i < 64; ++i) { *up = x[i]; up += 128; asm volatile("" : "+v"(up)); } }
            else { bf16_t* wp = CW + (size_t)ci * 8192 + (c - 128);
#pragma unroll
                for (int i = 0; i < 64; ++i) { *wp = (bf16_t)(cvt_pk_bf16(x[i], 0.f) & 0xffff); wp += 128; asm volatile("" : "+v"(wp)); } }
        }
        asm volatile("" ::: "memory"); __builtin_amdgcn_sched_barrier(0);
        {
            const float glast = gcs[63];
#pragma unroll
            for (int it = 0; it < 4; ++it) { const int idx = htid + 256 * it, i = idx >> 4, dq = idx & 15; float f[8];
                const u32x4 r = *(const u32x4*)(qkvc + (size_t)(m0 + i) * 3072 + h * 128 + dq * 8); unpack8(r, f); const float eg = __expf(gcs[i]);
#pragma unroll
                for (int k = 0; k < 8; ++k) f[k] *= eg;
                *(u32x4*)(CQD + (size_t)ci * 8192 + i * 128 + dq * 8) = pack8(f); }
#pragma unroll
            for (int it = 0; it < 4; ++it) { const int idx = htid + 256 * it, d = idx & 127, ig = idx >> 7; float f[8];
#pragma unroll
                for (int ii = 0; ii < 8; ++ii) { const int i = ig * 8 + ii; f[ii] = bf1(qkvc[(size_t)(m0 + i) * 3072 + 1024 + h * 128 + d]) * __expf(glast - gcs[i]); }
                *(u32x4*)(CKDT + (size_t)ci * 8192 + d * 64 + ig * 8) = pack8(f); }
            if (htid == 0) CGL[ci] = __expf(glast);
        }
        __syncthreads();
    }
}
__device__ __forceinline__ void phase_dn_sample(const Ctx& cx, PP P, int o, LAS unsigned char* lds) {
    const int tid = cx.tid; const int G = cx.G; unsigned char* ws = P->ws;
    const bf16_t* qkvc = (const bf16_t*)(ws + WS_MIX); const float* Gg = (const float*)(ws + WS_G); const float* Bt = (const float*)(ws + WS_BETA);
    const float* S0 = P->in[5] + (size_t)o * BS * 8 * 16384; float* Sout = P->out + O_SS + (size_t)o * BS * 8 * 16384; float* O = (float*)(ws + WS_O);
    LAS float* sq = (LAS float*)lds; LAS float* sk = sq + 128; LAS float* sv = sk + 128; LAS float* red = sv + 128;
    for (int task = cx.bid; task < BS * 8; task += G) {
        const int b = task >> 3, h = task & 7, m = MPR + b;
        if (tid < 384) { const int which = tid >> 7, d = tid & 127; sq[which * 128 + d] = bf1(qkvc[(size_t)m * 3072 + which * 1024 + h * 128 + d]); }
        __syncthreads();
        const int e = tid & 127, part = tid >> 7;
        const float* sp = S0 + (size_t)task * 16384 + (size_t)(part * 32) * 128 + e;
        float s[32]; float ks = 0.f, qs = 0.f, qk = 0.f;
#pragma unroll
        for (int d = 0; d < 32; ++d) { s[d] = *sp; sp += 128; asm volatile("" : "+v"(sp)); }
#pragma unroll
        for (int d = 0; d < 32; ++d) { ks += sk[part * 32 + d] * s[d]; qs += sq[part * 32 + d] * s[d]; }
        if (tid < 64) { const float pq = wave_sum(sq[tid] * sk[tid] + sq[tid + 64] * sk[tid + 64]); if (tid == 0) red[1024] = pq; }
        red[part * 128 + e] = ks; red[512 + part * 128 + e] = qs;
        __syncthreads();
        qk = red[1024];
        const float ksum = red[e] + red[128 + e] + red[256 + e] + red[384 + e], qsum = red[512 + e] + red[640 + e] + red[768 + e] + red[896 + e];
        const float g = Gg[(size_t)m * 8 + h], beta = Bt[(size_t)m * 8 + h], eg = __expf(g);
        const float vnew = beta * (sv[e] - eg * ksum);
        float* op = Sout + (size_t)task * 16384 + (size_t)(part * 32) * 128 + e;
#pragma unroll
        for (int d = 0; d < 32; ++d) { *op = eg * s[d] + sk[part * 32 + d] * vnew; op += 128; asm volatile("" : "+v"(op)); }
        if (part == 0) O[(size_t)m * 1024 + h * 128 + e] = eg * qsum + qk * vnew;
        __syncthreads();
    }
}

struct ScanOps { bf16x8 a1[4], a2[2], a3[2]; f32x4 u; float gl; };
__device__ __forceinline__ void scan_load(ScanOps& o, int ci, int w, int l15, int quad, int e0, const float* CU, const bf16_t* CW, const bf16_t* CQD, const bf16_t* CKDT, const bf16_t* CQK, const float* CGL) {
    const int mt = w & 3;
    { const bf16_t* ap = (w < 4 ? CW : CQD) + (size_t)ci * 8192 + (16 * mt + l15) * 128;
#pragma unroll
      for (int ks = 0; ks < 4; ++ks) o.a1[ks] = *(const bf16x8*)(ap + ks * 32 + quad * 8); }
    o.u = (f32x4){0.f, 0.f, 0.f, 0.f};
#pragma unroll
    for (int ks = 0; ks < 2; ++ks) o.a2[ks] = (bf16x8){0, 0, 0, 0, 0, 0, 0, 0};
    if (w < 4) {
#pragma unroll
        for (int j = 0; j < 4; ++j) o.u[j] = CU[(size_t)ci * 8192 + (16 * mt + quad * 4 + j) * 128 + e0 + l15]; }
    else { const bf16_t* qp = CQK + (size_t)ci * 4096 + (16 * mt + l15) * 64;
#pragma unroll
        for (int ks = 0; ks < 2; ++ks) o.a2[ks] = *(const bf16x8*)(qp + ks * 32 + quad * 8); }
    { const bf16_t* kp = CKDT + (size_t)ci * 8192 + (16 * w + l15) * 64;
#pragma unroll
      for (int ks = 0; ks < 2; ++ks) o.a3[ks] = *(const bf16x8*)(kp + ks * 32 + quad * 8); }
    o.gl = CGL[ci];
}
#define SCAN_BAR() do { asm volatile("s_waitcnt lgkmcnt(0)" ::: "memory"); __builtin_amdgcn_s_barrier(); asm volatile("" ::: "memory"); } while (0)
__device__ __forceinline__ void phase_dn_scan(const Ctx& cx, PP P, int o, LAS unsigned char* lds) {
    const int tid = cx.tid, lane = tid & 63, l15 = lane & 15, quad = lane >> 4, w = __builtin_amdgcn_readfirstlane(tid >> 6);
    const int G = cx.G;
    unsigned char* ws = P->ws;
    const float* CU = (const float*)(ws + WS_CU); const bf16_t* CW = (const bf16_t*)(ws + WS_CW); const bf16_t* CQD = (const bf16_t*)(ws + WS_CQD); const bf16_t* CKDT = (const bf16_t*)(ws + WS_CKDT); const bf16_t* CQK = (const bf16_t*)(ws + WS_CQK); const float* CGL = (const float*)(ws + WS_CGL);
    float* O = (float*)(ws + WS_O);
    LAS bf16_t* ST = (LAS bf16_t*)lds;
    LAS bf16_t* VT = ST + 16 * 136;
    for (int task0 = cx.bid; task0 < 256; task0 += G) {
        const int task = (G == 256) ? ((task0 & 7) * 32 + (task0 >> 3)) : task0;
        const int bh = task >> 3, es = task & 7, e0 = es * 16, b = bh >> 3, h = bh & 7;
        const int mt = w & 3;
        f32x4 S = (f32x4){0.f, 0.f, 0.f, 0.f};
        f32x4 oacc = (f32x4){0.f, 0.f, 0.f, 0.f};
        ScanOps cur, nxt;
        scan_load(cur, bh * 32, w, l15, quad, e0, CU, CW, CQD, CKDT, CQK, CGL);
        for (int n = 0; n < 32; ++n) {
            const int m0 = b * SEQ + n * 64;
            scan_load(nxt, bh * 32 + (n < 31 ? n + 1 : n), w, l15, quad, e0, CU, CW, CQD, CKDT, CQK, CGL);
            { u32x2 sw; sw.x = cvt_pk_bf16(S[0], S[1]); sw.y = cvt_pk_bf16(S[2], S[3]); *(LAS u32x2*)(ST + l15 * 136 + 16 * w + quad * 4) = sw; }
            SCAN_BAR();
            { f32x4 acc = (f32x4){0.f, 0.f, 0.f, 0.f};
#pragma unroll
              for (int ks = 0; ks < 4; ++ks) { const bf16x8 bs = *(const LAS bf16x8*)(ST + l15 * 136 + ks * 32 + quad * 8); acc = __builtin_amdgcn_mfma_f32_16x16x32_bf16(cur.a1[ks], bs, acc, 0, 0, 0); }
              if (w < 4) { const f32x4 vn = cur.u - acc; u32x2 vw; vw.x = cvt_pk_bf16(vn[0], vn[1]); vw.y = cvt_pk_bf16(vn[2], vn[3]); *(LAS u32x2*)(VT + l15 * 72 + 16 * mt + quad * 4) = vw; }
              else oacc = acc; }
            SCAN_BAR();
            bf16x8 bv[2];
#pragma unroll
            for (int ks = 0; ks < 2; ++ks) bv[ks] = *(const LAS bf16x8*)(VT + l15 * 72 + ks * 32 + quad * 8);
            if (w >= 4) {
#pragma unroll
                for (int ks = 0; ks < 2; ++ks) oacc = __builtin_amdgcn_mfma_f32_16x16x32_bf16(cur.a2[ks], bv[ks], oacc, 0, 0, 0);
#pragma unroll
                for (int j = 0; j < 4; ++j) O[(size_t)(m0 + 16 * mt + quad * 4 + j) * 1024 + h * 128 + e0 + l15] = oacc[j]; }
            S = S * cur.gl;
#pragma unroll
            for (int ks = 0; ks < 2; ++ks) S = __builtin_amdgcn_mfma_f32_16x16x32_bf16(cur.a3[ks], bv[ks], S, 0, 0, 0);
            cur = nxt;
        }
        float* sp = P->out + O_SP + (((size_t)o * BP + b) * 8 + h) * 16384;
#pragma unroll
        for (int j = 0; j < 4; ++j) sp[(size_t)(16 * w + quad * 4 + j) * 128 + e0 + l15] = S[j];
        __syncthreads();
    }
}

__device__ __forceinline__ void phase_dn_gate(const Ctx& cx, PP P, int o) {
    const int tid = cx.tid, lane = tid & 63, wave = __builtin_amdgcn_readfirstlane(tid >> 6);
    const int gw = cx.bid * NWAVES + wave, NGW = cx.G * NWAVES;
    const float* O = (const float*)(P->ws + WS_O); const bf16_t* zg = (const bf16_t*)(P->ws + WS_ZG); bf16_t* cat = (bf16_t*)(P->ws + WS_CAT);
    const float* ng = P->in[25] + o * 128;
    for (int m = gw; m < MT; m += NGW) {
#pragma unroll
        for (int jj = 0; jj < 2; ++jj) { const int ch0 = (lane + 64 * jj) * 8; const f32x4 o0 = *(const f32x4*)(O + (size_t)m * 1024 + ch0), o1 = *(const f32x4*)(O + (size_t)m * 1024 + ch0 + 4);
            float f[8] = {o0.x, o0.y, o0.z, o0.w, o1.x, o1.y, o1.z, o1.w}; float ss = 0.f;
#pragma unroll
            for (int i = 0; i < 8; ++i) ss += f[i] * f[i];
            const float rs = rsqrtf(grp16_sum(ss) * (1.0f / 128.f) + EPS);
            float z[8]; const u32x4 r = *(const u32x4*)(zg + (size_t)m * 1024 + ch0); unpack8(r, z);
#pragma unroll
            for (int i = 0; i < 8; ++i) f[i] = f[i] * rs * ng[(ch0 & 127) + i] * siluf_(z[i]);
            *(u32x4*)(cat + (size_t)m * 2048 + 1024 + ch0) = pack8(f); }
    }
}

#define XB_TMO      128
#define XB_XCNT(j)  (256  + 64 * (j))
#define XB_XSUB(j)  (1280 + 64 * (j))
#define XB_XGEN(j)  (2304 + 64 * (j))
#define XB_TOP      3328
#define XB_TOPGEN   3392
#define XCD_BAR_WORDS 3456
#define XB_SPIN_CAP (1u << 20)
__device__ __forceinline__ unsigned xb_ld(unsigned* p)              { return __hip_atomic_load(p, __ATOMIC_RELAXED, __HIP_MEMORY_SCOPE_AGENT); }
__device__ __forceinline__ unsigned xb_add(unsigned* p, unsigned v) { return __hip_atomic_fetch_add(p, v, __ATOMIC_RELAXED, __HIP_MEMORY_SCOPE_AGENT); }
__device__ __forceinline__ unsigned xb_xcc_id() { return (unsigned)__builtin_amdgcn_s_getreg((3 << 11) | 20) & 0xFu; }
#define XB_SPIN(cond, bar) do { unsigned _sp = 0; while (cond) { __builtin_amdgcn_s_sleep(1); \
    if ((++_sp & 255u) == 0u) { if (xb_ld(&(bar)[XB_TMO])) break; if (_sp > XB_SPIN_CAP) { atomicAdd(&(bar)[XB_TMO], 1u); break; } } } } while (0)
struct XcdBarrier { unsigned* bar; unsigned x; volatile LAS unsigned* st; };
__device__ __forceinline__ XcdBarrier xcd_barrier_post(unsigned* bar, volatile LAS unsigned* st) {
    XcdBarrier b; b.bar = bar; b.x = xb_xcc_id(); b.st = st;
    if (threadIdx.x == 0) (void)xb_add(&bar[XB_XCNT(b.x)], 1u);
    return b;
}
__device__ __forceinline__ void xcd_barrier_complete(unsigned* bar, unsigned x, unsigned& nloc, unsigned& nx) {
    const unsigned G = gridDim.x * gridDim.y * gridDim.z;
    unsigned sum, cnt, mine, sp = 0u;
    for (;;) {
        sum = 0u; cnt = 0u; mine = 0u;
#pragma unroll
        for (unsigned j = 0; j < 16; ++j) { const unsigned c = xb_ld(&bar[XB_XCNT(j)]); sum += c; cnt += (c > 0u) ? 1u : 0u; mine = (j == x) ? c : mine; }
        if (sum == G) break;
        __builtin_amdgcn_s_sleep(1);
        if ((++sp & 255u) == 0u) { if (xb_ld(&bar[XB_TMO])) break; if (sp > XB_SPIN_CAP) { atomicAdd(&bar[XB_TMO], 1u); break; } }
    }
    nloc = mine > 0u ? mine : 1u; nx = cnt > 0u ? cnt : 1u;
}
__device__ __forceinline__ void xcd_barrier(const XcdBarrier& b) {
    asm volatile("s_waitcnt vmcnt(0)" ::: "memory");
    __syncthreads();
    if (threadIdx.x == 0) {
        unsigned* bar = b.bar;
        __builtin_amdgcn_s_waitcnt(0);
        unsigned nloc = b.st[0], nx = b.st[1];
        if (nloc == 0u) { xcd_barrier_complete(bar, b.x, nloc, nx); b.st[0] = nloc; b.st[1] = nx; }
        const unsigned old = xb_add(&bar[XB_XSUB(b.x)], 1u);
        const unsigned gen = old / nloc;
        if (old + 1u == (gen + 1u) * nloc) {
            __builtin_amdgcn_fence(__ATOMIC_RELEASE, "agent");
            asm volatile("s_waitcnt vmcnt(0)" ::: "memory");
            const unsigned og = xb_add(&bar[XB_TOP], 1u);
            const unsigned tg = og / nx;
            if (og + 1u == (tg + 1u) * nx) xb_add(&bar[XB_TOPGEN], 1u);
            else XB_SPIN(xb_ld(&bar[XB_TOPGEN]) == tg, bar);
            __builtin_amdgcn_fence(__ATOMIC_ACQUIRE, "agent");
            xb_add(&bar[XB_XGEN(b.x)], 1u);
            asm volatile("s_waitcnt vmcnt(0)" ::: "memory");
        } else {
            XB_SPIN(xb_ld(&bar[XB_XGEN(b.x)]) == gen, bar);
            __builtin_amdgcn_fence(__ATOMIC_ACQUIRE, "agent");
            asm volatile("s_waitcnt vmcnt(0)" ::: "memory");
        }
    }
    __syncthreads();
}

__device__ __forceinline__ void copy_rows_shift(const Ctx& cx, const float* src, float* dst, int nb, int rows_in, int rows_copy, int width4) {
    const int per_b = rows_copy * width4, total = nb * per_b;
    for (int i = (cx.G - 1 - cx.bid) * NTHR + cx.tid; i < total; i += cx.G * NTHR) { const int b = i / per_b, r = i - b * per_b;
        ((f32x4*)dst)[(size_t)b * rows_in * width4 + r] = ((const f32x4*)src)[(size_t)b * rows_in * width4 + width4 + r]; }
}
constexpr int NPHASES = 1 + 8 + 10 + 8 + 10 + 1;
__global__ void __launch_bounds__(NTHR, 2) mega_fwd(Params Pin) {
    extern __shared__ __attribute__((aligned(16))) unsigned char lds_raw[];
    LAS unsigned char* lds = (LAS unsigned char*)lds_raw;
    const __attribute__((address_space(4))) unsigned char* kp = (const __attribute__((address_space(4))) unsigned char*)__builtin_amdgcn_kernarg_segment_ptr();
    constexpr int nM = MPAD / 256;
    volatile LAS unsigned* bst = (volatile LAS unsigned*)(lds + 131072);
    if (threadIdx.x < 2) bst[threadIdx.x] = 0u;
    __syncthreads();
    XcdBarrier gbar; gbar.bar = nullptr; gbar.x = 0; gbar.st = bst;
    if (((PP)kp)->coop) gbar = xcd_barrier_post((unsigned*)(((PP)kp)->ws + WS_BAR), bst);
    const int ph_lo = ((PP)kp)->ph_lo, ph_hi = ((PP)kp)->ph_hi;
#ifdef EXTRA_SYNCS
    for (int i = 0; i < EXTRA_SYNCS; ++i) xcd_barrier(gbar);
#endif
    int did_rep = 0;
    for (int ph = ph_lo; ph < ph_hi; ++ph) {
        asm volatile("" : "+s"(kp));
        Ctx cx; cx.tid = threadIdx.x; cx.bid = blockIdx.x; cx.G = gridDim.x;
        asm volatile("" : "+v"(cx.tid)); asm volatile("" : "+s"(cx.bid)); asm volatile("" : "+s"(cx.G));
        PP P = (PP)kp;
        unsigned char* ws = P->ws;
        float* X = (float*)(ws + WS_X); bf16_t* H = (bf16_t*)(ws + WS_H); bf16_t* ACT = (bf16_t*)(ws + WS_ACT); bf16_t* CAT = (bf16_t*)(ws + WS_CAT);
        float* PX = (float*)(ws + WS_PARTX);
        int l, op;
        if (ph == 0) { l = 0; op = 10; }
        else if (ph == NPHASES - 1) { l = 0; op = 11; }
        else { int r = ph - 1; const int pair = r / 18; r %= 18;
            if (r < 8) { l = 2 * pair; op = r < 4 ? r : r + 2; }
            else { l = 2 * pair + 1; op = r - 8; } }
        const bool even = (l & 1) == 0; const int e = l >> 1;
#ifndef OPMASK
#define OPMASK 0xfff
#endif
#ifndef REPMASK
#define REPMASK 0
#endif
        if (!(((OPMASK) >> op) & 1)) continue;
        const bool dry = REPMASK && ((REPMASK >> op) & 1) && !did_rep;
        switch (op) {
        case 10: phase_prep(cx, P, lds); phase_first_norm(cx, P, X, P->in[6], H); break;
        case 11: phase_rmsnorm<true>(cx, X, P->in[8], nullptr, P->out + O_YP, PX, 44, dry, lds); break;
        case 0: if (l > 0) phase_rmsnorm<false>(cx, X, P->in[6] + (size_t)l * D, H, nullptr, PX, l > 0 ? 44 : 0, dry, lds); break;
        case 7: phase_rmsnorm<false>(cx, X, P->in[7] + (size_t)l * D, H, nullptr, PX, 16, dry, lds); break;
        case 1:
            if (even) { pg8::StaticSched S; S.init(cx, H, (bf16_t*)(ws + WS_WEVIN) + (size_t)e * EV_IN * 2048, 2048, 2048, nM, EV_IN / 256, 2048, 0);
                pg8::EpiEvenIn E{(bf16_t*)(ws + WS_ABUF), (bf16_t*)(ws + WS_UV)}; pg8::gemm_phase(cx, lds, S, E);
                copy_rows_shift(cx, P->in[2] + (size_t)e * BS * 15 * 1024, P->out + O_PS + (size_t)e * BS * 15 * 1024, BS, 15, 14, 256); }
            else { pg8::StaticSched S; S.init(cx, H, (bf16_t*)(ws + WS_WODIN) + (size_t)e * OD_INM * 2048, 2048, 2048, nM, OD_INM / 256, 2048, 0);
                pg8::EpiOddIn E{(bf16_t*)(ws + WS_ABUF), (bf16_t*)(ws + WS_UV), (bf16_t*)(ws + WS_ZG)}; pg8::gemm_phase(cx, lds, S, E);
                phase_ab(cx, P, e);
                copy_rows_shift(cx, P->in[3] + (size_t)e * BS * 30 * 1024, P->out + O_CS + (size_t)e * BS * 30 * 1024, BS, 30, 29, 256);
                copy_rows_shift(cx, P->in[4] + (size_t)e * BS * 3 * 3072, P->out + O_DCS + (size_t)e * BS * 3 * 3072, BS, 3, 2, 768); }
            break;
        case 2: if (even) phase_even_prep(cx, P, e); else phase_odd_prep(cx, P, e, lds); break;
        case 3:
            if (even) {
#ifndef DBG_NO_POOL
                pg8::StaticSched S; S.init(cx, ws + WS_MIX, (bf16_t*)(ws + WS_WPOOL) + (size_t)e * 1024 * 256, 1024, 256, nM, 4, 256, 512);
                pg8::EpiPool E{CAT, P->in[11] + e * 1024}; pg8::gemm_phase(cx, lds, S, E);
                __syncthreads();
#endif
#ifndef DBG_NO_SGU
                phase_sgu(cx, P, e, lds);
#endif
            }
#ifndef DBG_NO_DNI
            else phase_dn_intra(cx, P, e, lds);
#endif
            break;
        case 4: phase_dn_sample(cx, P, e, lds); __syncthreads(); phase_dn_scan(cx, P, e, lds); break;
        case 5: phase_dn_gate(cx, P, e); break;
        case 6: { const bf16_t* Wt = (even ? (bf16_t*)(ws + WS_WEVOUT) : (bf16_t*)(ws + WS_WODOUT)) + (size_t)e * 2048 * 2048;
                pg8::ResidSched S; S.init(cx, CAT, Wt, 2048, 2048); pg8::EpiResidX E{{X, dry}, {PX, dry}}; pg8::gemm_phase(cx, lds, S, E); } break;
        case 8: { pg8::StaticSched S; S.init(cx, H, (bf16_t*)(ws + WS_WUP) + (size_t)l * 2 * DFF * 2048, 2048, 2048, nM, 2 * DFF / 256, 2048, 0);
                pg8::EpiUp E{ACT}; pg8::gemm_phase(cx, lds, S, E); } break;
        case 9: { const bf16_t* Wt = (bf16_t*)(ws + WS_WDOWN) + (size_t)l * 2048 * DFF;
                pg8::ResidSched S; S.init(cx, ACT, Wt, DFF, DFF); pg8::EpiResidX E{{X, dry}, {PX, dry}}; pg8::gemm_phase(cx, lds, S, E); } break;
        default: break;
        }
        if (REPMASK) { if (((REPMASK >> op) & 1) && !did_rep) { did_rep = 1; --ph; } else did_rep = 0; }
        if (ph + 1 < ph_hi && !(op == 0 && l == 0)) { if (P->coop) { if (ph == 0) cg::this_grid().sync(); else xcd_barrier(gbar); } }
    }
}

#ifndef MK_COOP
#define MK_COOP 1
#endif
extern "C" void kernel_launch(void* const* d_in, const int* in_sizes, int n_in, void* d_out, int out_size, void* d_ws, size_t ws_size, hipStream_t stream) {
    static int grid = 0;
    if (grid == 0) {
        if (n_in != 29 || (size_t)out_size != O_END || ws_size < WS_END) { fprintf(stderr, "kernel_launch: unexpected shapes n_in %d out %d ws %zu (need %zu)\n", n_in, out_size, ws_size, (size_t)WS_END); grid = -1; return; }
        int dev = 0, cus = 0, per_cu = 0;
        hipGetDevice(&dev); hipDeviceGetAttribute(&cus, hipDeviceAttributeMultiprocessorCount, dev);
        if (hipFuncSetAttribute((const void*)mega_fwd, hipFuncAttributeMaxDynamicSharedMemorySize, LDS_BYTES) != hipSuccess) { fprintf(stderr, "kernel_launch: hipFuncSetAttribute failed\n"); grid = -1; return; }
        if (hipOccupancyMaxActiveBlocksPerMultiprocessor(&per_cu, (const void*)mega_fwd, NTHR, LDS_BYTES) != hipSuccess || per_cu < 1) { fprintf(stderr, "kernel_launch: occupancy query says %d\n", per_cu); per_cu = 1; }
        (void)hipGetLastError();
        grid = cus < 256 ? cus : 256;
        if (grid <= 0) grid = 256;
    }
    if (grid < 0) return;
    Params p{};
    for (int i = 0; i < 29; ++i) p.in[i] = (const float*)d_in[i];
    p.out = (float*)d_out; p.ws = (unsigned char*)d_ws; p.pad = 0;
#if MK_COOP
    p.ph_lo = 0; p.ph_hi = NPHASES; p.coop = 1;
    if (hipMemsetAsync((char*)d_ws + WS_BAR, 0, WS_BAR_BYTES, stream) != hipSuccess) { fprintf(stderr, "kernel_launch: memset of barrier words failed\n"); return; }
    void* args[] = {&p};
    hipError_t e = hipLaunchCooperativeKernel((const void*)mega_fwd, dim3(grid), dim3(NTHR), args, LDS_BYTES, stream);
    if (e != hipSuccess) fprintf(stderr, "cooperative launch failed: %s (grid %d)\n", hipGetErrorString(e), grid);
#else
    p.coop = 0;
    for (int ph = 0; ph < NPHASES; ++ph) { p.ph_lo = ph; p.ph_hi = ph + 1; hipLaunchKernelGGL(mega_fwd, dim3(grid), dim3(NTHR), LDS_BYTES, stream, p); }
#endif
}
```

```cpp
#include <hip/hip_runtime.h>
#include <hip/hip_cooperative_groups.h>
#include <cstdio>
namespace cg = cooperative_groups;

#define LAS __attribute__((address_space(3)))
typedef unsigned short bf16_t;
typedef short bf16x8 __attribute__((ext_vector_type(8)));
typedef float f32x4 __attribute__((ext_vector_type(4)));
typedef float f32x2 __attribute__((ext_vector_type(2)));
typedef unsigned u32x4 __attribute__((ext_vector_type(4)));
typedef unsigned u32x2 __attribute__((ext_vector_type(2)));

constexpr int D = 2048, SEQ = 2048, BP = 4, MPR = BP * SEQ, BS = 128, MT = MPR + BS, MPAD = 8448;
constexpr int DFF = 5632, EV_IN = 3072, OD_IN = 6160, OD_INM = 6144;
constexpr float EPS = 1e-6f;
constexpr int NTHR = 512, NWAVES = 8;
constexpr int LDS_BYTES = 131072 + 1024;

constexpr size_t O_YP = 0;
constexpr size_t O_YS = O_YP + (size_t)MPR * D;
constexpr size_t O_PP = O_YS + (size_t)BS * D;
constexpr size_t O_PS = O_PP + (size_t)2 * BP * 15 * 1024;
constexpr size_t O_SV = O_PS + (size_t)2 * BS * 15 * 1024;
constexpr size_t O_CP = O_SV + (size_t)2 * BS * 1024;
constexpr size_t O_CS = O_CP + (size_t)2 * BP * 30 * 1024;
constexpr size_t O_DCP = O_CS + (size_t)2 * BS * 30 * 1024;
constexpr size_t O_DCS = O_DCP + (size_t)2 * BP * 3 * 3072;
constexpr size_t O_SP = O_DCS + (size_t)2 * BS * 3 * 3072;
constexpr size_t O_SS = O_SP + (size_t)2 * BP * 8 * 128 * 128;
constexpr size_t O_END = O_SS + (size_t)2 * BS * 8 * 128 * 128;

constexpr size_t al(size_t x) { return (x + 4095) & ~(size_t)4095; }
constexpr size_t WS_X = 0;
constexpr size_t WS_H = WS_X + al((size_t)MPAD * D * 4);
constexpr size_t WS_ACT = WS_H + al((size_t)MPAD * D * 2);
constexpr size_t WS_CAT = WS_ACT + al((size_t)MPAD * DFF * 2);
constexpr size_t WS_ABUF = WS_CAT + al((size_t)MPAD * D * 2);
constexpr size_t WS_UV = WS_ABUF + al((size_t)MPAD * 1024 * 2);
constexpr size_t WS_ZG = WS_UV + al((size_t)MPAD * 3072 * 2);
constexpr size_t WS_MIX = WS_ZG + al((size_t)MPAD * 1024 * 2);
constexpr size_t WS_VN = WS_MIX + al((size_t)MPAD * 3072 * 2);
constexpr size_t WS_AB = WS_VN + al((size_t)MPAD * 1024 * 2);
constexpr size_t WS_G = WS_AB + al((size_t)MPAD * 16 * 4);
constexpr size_t WS_BETA = WS_G + al((size_t)MPAD * 8 * 4);
constexpr size_t WS_O = WS_BETA + al((size_t)MPAD * 8 * 4);
constexpr size_t WS_CU = WS_O + al((size_t)MPAD * 1024 * 4);
constexpr size_t WS_CW = WS_CU + al((size_t)1024 * 8192 * 4);
constexpr size_t WS_CQD = WS_CW + al((size_t)1024 * 8192 * 2);
constexpr size_t WS_CKDT = WS_CQD + al((size_t)1024 * 8192 * 2);
constexpr size_t WS_CQK = WS_CKDT + al((size_t)1024 * 8192 * 2);
constexpr size_t WS_CGL = WS_CQK + al((size_t)1024 * 4096 * 2);
constexpr size_t WS_WEVIN = WS_CGL + al(4096);
constexpr size_t WS_WEVOUT = WS_WEVIN + al((size_t)2 * 3072 * 2048 * 2);
constexpr size_t WS_WODIN = WS_WEVOUT + al((size_t)2 * 2048 * 2048 * 2);
constexpr size_t WS_WODOUT = WS_WODIN + al((size_t)2 * 6144 * 2048 * 2);
constexpr size_t WS_WUP = WS_WODOUT + al((size_t)2 * 2048 * 2048 * 2);
constexpr size_t WS_WDOWN = WS_WUP + al((size_t)4 * 11264 * 2048 * 2);
constexpr size_t WS_WPOOL = WS_WDOWN + al((size_t)4 * 2048 * 5632 * 2);
constexpr size_t WS_PARTX = WS_WPOOL + al((size_t)2 * 1024 * 256 * 2);
constexpr size_t WS_WAB = WS_PARTX + al((size_t)256 * 32768 * 4);
constexpr size_t WS_BAR = WS_WAB + al((size_t)2 * 16 * 2048 * 2);
constexpr size_t WS_BAR_BYTES = 16384;
constexpr size_t WS_END = WS_BAR + WS_BAR_BYTES;

struct Params { const float* in[29]; float* out; unsigned char* ws; int ph_lo, ph_hi, coop, pad; };
typedef const __attribute__((address_space(4))) Params* PP;
struct Ctx { int tid, bid, G; };

__device__ __forceinline__ unsigned cvt_pk_bf16(float lo, float hi) { unsigned r; asm volatile("v_cvt_pk_bf16_f32 %0, %1, %2" : "=v"(r) : "v"(lo), "v"(hi)); return r; }
__device__ __forceinline__ float bf_lo(unsigned w) { return __uint_as_float(w << 16); }
__device__ __forceinline__ float bf_hi(unsigned w) { return __uint_as_float(w & 0xffff0000u); }
__device__ __forceinline__ float bf1(bf16_t h) { return __uint_as_float(((unsigned)h) << 16); }
__device__ __forceinline__ void unpack8(const u32x4 w, float (&f)[8]) { f[0] = bf_lo(w.x); f[1] = bf_hi(w.x); f[2] = bf_lo(w.y); f[3] = bf_hi(w.y); f[4] = bf_lo(w.z); f[5] = bf_hi(w.z); f[6] = bf_lo(w.w); f[7] = bf_hi(w.w); }
__device__ __forceinline__ u32x4 pack8(const float (&f)[8]) { u32x4 w; w.x = cvt_pk_bf16(f[0], f[1]); w.y = cvt_pk_bf16(f[2], f[3]); w.z = cvt_pk_bf16(f[4], f[5]); w.w = cvt_pk_bf16(f[6], f[7]); return w; }
__device__ __forceinline__ float sigmoidf_(float x) { return __builtin_amdgcn_rcpf(1.0f + __expf(-x)); }
__device__ __forceinline__ float siluf_(float x) { return x * sigmoidf_(x); }
__device__ __forceinline__ float wave_sum(float v) {
#pragma unroll
    for (int o = 1; o < 64; o <<= 1) v += __shfl_xor(v, o);
    return v;
}
__device__ __forceinline__ float grp16_sum(float v) {
#pragma unroll
    for (int o = 1; o < 16; o <<= 1) v += __shfl_xor(v, o);
    return v;
}
__device__ __forceinline__ f32x2 gelu_pk(f32x2 v) {
    const f32x2 av = __builtin_elementwise_abs(v), d = av * 0.2316418882f + 1.0f;
    f32x2 t; t.x = __builtin_amdgcn_rcpf(d.x); t.y = __builtin_amdgcn_rcpf(d.y);
    f32x2 q = t * 0.5307027145f + (-0.7265760135f); q = q * t + 0.7107068705f; q = q * t + (-0.142248368f); q = q * t + 0.127414796f; q = q * t;
    const f32x2 s = (v * v) * (-0.72134752044f);
    f32x2 e; e.x = __builtin_amdgcn_exp2f(s.x); e.y = __builtin_amdgcn_exp2f(s.y);
    const f32x2 m = v * (q * e), r = v - m;
    f32x2 o; o.x = v.x < 0.f ? m.x : r.x; o.y = v.y < 0.f ? m.y : r.y; return o;
}

namespace pg8 {
constexpr int BM = 256, BK = 64, HALF = 128, HTB = HALF * BK * 2, STAGE_BYTES = 8 * HTB, NXCD = 8, WGM = 8;
__device__ __forceinline__ int lds_byte(int r, int c) { const int st = (r >> 4) * 2 + (c >> 5), rr = r & 15, cc = c & 31, ob = rr * 64 + cc * 2; return st * 1024 + (ob ^ (((ob >> 9) & 1) << 5)); }
__device__ __forceinline__ void stage_rc(int b, int& R, int& C) { const int st = b / 1024, sb = b % 1024, swz = sb ^ (((sb >> 9) & 1) << 5); R = (st >> 1) * 16 + swz / 64; C = (st & 1) * 32 + (swz % 64) / 2; }
__device__ __forceinline__ int perm32(int rho) { const int n = rho >> 4, i = rho & 15; return 8 * (i >> 2) + 4 * n + (i & 3); }

struct Unit { int pm, pn, nt, pad; const char* A; const char* B; };

__device__ __forceinline__ void unit_pmpn(int wgid, int nM, int nN, int& pm, int& pn) {
    const int nig = WGM * nN, gid = wgid / nig, fm = gid * WGM, gsz = (nM - fm) < WGM ? (nM - fm) : WGM;
    pm = fm + ((wgid % nig) % gsz); pn = (wgid % nig) / gsz;
}
struct StaticSched {
    const char* A; const char* B; int lda, ldb, nM, nN, nwg, G, c, nt; size_t a_pn_stride;
    __device__ __forceinline__ void init(const Ctx& cx, const void* A_, const void* B_, int lda_, int ldb_, int nM_, int nN_, int K, size_t apn) {
        A = (const char*)A_; B = (const char*)B_; lda = lda_; ldb = ldb_; nM = nM_; nN = nN_; nwg = nM * nN; G = cx.G; c = cx.bid; nt = K / BK; a_pn_stride = apn; }
    __device__ __forceinline__ bool next(int i, Unit& u) const {
        const long L = (long)i * G + c; if (L >= nwg) return false;
        int wgid = (int)L; { const int q = nwg / NXCD, r = nwg % NXCD, xcd = wgid % NXCD, off = wgid / NXCD; wgid = (xcd < r ? xcd * (q + 1) : r * (q + 1) + (xcd - r) * q) + off; }
        unit_pmpn(wgid, nM, nN, u.pm, u.pn); u.nt = nt; u.pad = 0;
        u.A = A + (size_t)u.pm * BM * lda * 2 + (size_t)u.pn * a_pn_stride; u.B = B + (size_t)u.pn * BM * ldb * 2; return true;
    }
};
struct StreamKSched {
    const char* A; const char* B; int lda, ldb, pm_base, nN, ppu, p0, p1, u0, vc;
    __device__ __forceinline__ void init(const Ctx& cx, const void* A_, const void* B_, int lda_, int ldb_, int pm_base_, int nN_, int K) {
        A = (const char*)A_; B = (const char*)B_; lda = lda_; ldb = ldb_; pm_base = pm_base_; nN = nN_; ppu = K / (2 * BK);
        const int G = cx.G, bx = cx.bid; vc = (G % 8 == 0) ? (bx % 8) * (G / 8) + bx / 8 : bx;
        const long P = (long)nN * ppu; p0 = (int)((vc * P) / G); p1 = (int)(((vc + 1) * P) / G); u0 = p0 / ppu; }
    __device__ __forceinline__ bool next(int i, Unit& u) const {
        const int ui = u0 + i; const long lo = (long)ui * ppu; if (lo >= p1) return false;
        const int s = (int)(lo > p0 ? lo : p0), e = (int)((lo + ppu) < p1 ? (lo + ppu) : p1);
        u.pm = pm_base; u.pn = ui; u.nt = 2 * (e - s); u.pad = vc;
        const size_t koff = (size_t)(s - (int)lo) * 2 * BK * 2;
        u.A = A + (size_t)u.pm * BM * lda * 2 + koff; u.B = B + (size_t)u.pn * BM * ldb * 2 + koff; return true;
    }
};

struct ResidSched {
    StaticSched a; StreamKSched b; int na, lda, ldb;
    __device__ __forceinline__ void init(const Ctx& cx, const void* A_, const void* B_, int ld, int K) {
        a.init(cx, A_, B_, ld, ld, MPR / 256, 8, K, 0); b.init(cx, A_, B_, ld, ld, MPR / 256, 8, K); lda = ld; ldb = ld;
        na = (a.nwg - a.c + a.G - 1) / a.G; if (na < 0) na = 0; }
    __device__ __forceinline__ bool next(int i, Unit& u) const { if (i < na) return a.next(i, u); return b.next(i - na, u); }
};
template <class Epi, class Sched>
__device__ __forceinline__ void gemm_phase(const Ctx& cx, LAS unsigned char* lds, const Sched& S, const Epi& E) {
    const int tid = cx.tid, wid = __builtin_amdgcn_readfirstlane(tid >> 6), lane = tid & 63, wr = wid >> 2, wc = wid & 3, fr = lane & 15, fq = lane >> 4;
    const int lda = S.lda, ldb = S.ldb;
    unsigned voffA[2], voffB[2];
#pragma unroll
    for (int i = 0; i < 2; ++i) { int R, C; stage_rc(tid * 16 + i * 8192, R, C); const int Rb = Epi::PERM ? ((R & ~31) + perm32(R & 31)) : R;
        voffA[i] = (unsigned)(R * lda + C) * 2u; voffB[i] = (unsigned)(Rb * ldb + C) * 2u; }
    const size_t kstep = (size_t)(BK * 2);
    const size_t hstepA = (size_t)HALF * lda * 2, hstepB = (size_t)HALF * ldb * 2;
    const unsigned ldsw = (unsigned)wid * 1024u;
    const int aoff = lds_byte(wr * 64 + fr, fq * 8), boff = lds_byte(wc * 32 + fr, fq * 8);
#define PG8_SA(b, h) (((b) * 2 + (h)) * HTB)
#define PG8_SB(b, h) ((4 + (b) * 2 + (h)) * HTB)
#define PG8_STAGE(bufoff, gbase, voff) do { _Pragma("unroll") for (int _i = 0; _i < 2; ++_i) \
        __builtin_amdgcn_global_load_lds((const unsigned*)((const char*)(gbase) + (voff)[_i]), (LAS unsigned*)(lds + (bufoff) + ldsw + _i * 8192), 16, 0, 0); } while (0)
#define PG8_LDA(dst, b, h) do { _Pragma("unroll") for (int m = 0; m < 4; ++m) _Pragma("unroll") for (int k = 0; k < 2; ++k) dst[m][k] = *(const LAS bf16x8*)(lds + PG8_SA(b, h) + aoff + m * 2048 + k * 1024); } while (0)
#define PG8_LDB(dst, b, h) do { _Pragma("unroll") for (int n = 0; n < 2; ++n) _Pragma("unroll") for (int k = 0; k < 2; ++k) dst[n][k] = *(const LAS bf16x8*)(lds + PG8_SB(b, h) + boff + n * 2048 + k * 1024); } while (0)
#define PG8_MMA(ai, bj, At, Bt) do { __builtin_amdgcn_s_setprio(1); _Pragma("unroll") for (int m = 0; m < 4; ++m) _Pragma("unroll") for (int n = 0; n < 2; ++n) _Pragma("unroll") for (int k = 0; k < 2; ++k) \
        acc[ai][bj][m][n] = __builtin_amdgcn_mfma_f32_16x16x32_bf16(Bt[n][k], At[m][k], acc[ai][bj][m][n], 0, 0, 0); __builtin_amdgcn_s_setprio(0); } while (0)
#define PG8_WAIT_V(n) asm volatile("s_waitcnt vmcnt(" #n ")" ::: "memory")
#define PG8_WAIT_L(n) asm volatile("s_waitcnt lgkmcnt(" #n ")" ::: "memory")
#define PG8_BAR __builtin_amdgcn_s_barrier()
#define PG8_SCHED __builtin_amdgcn_sched_barrier(0)
    Unit cur, nxt; int ui = 0;
    if (!S.next(0, cur)) return;
    f32x4 acc[2][2][4][2];
#pragma unroll
    for (int a = 0; a < 2; ++a)
#pragma unroll
        for (int b = 0; b < 2; ++b)
#pragma unroll
            for (int m = 0; m < 4; ++m)
#pragma unroll
                for (int n = 0; n < 2; ++n) acc[a][b][m][n] = (f32x4){0.f, 0.f, 0.f, 0.f};
    bf16x8 At[4][2], B0[2][2], B1[2][2];
    const char* cA = cur.A; const char* cB = cur.B;
    PG8_STAGE(PG8_SB(0, 0), cB, voffB); PG8_STAGE(PG8_SA(0, 0), cA, voffA); PG8_STAGE(PG8_SB(0, 1), cB + hstepB, voffB); PG8_STAGE(PG8_SA(0, 1), cA + hstepA, voffA);
    if (wr == 1) PG8_BAR;
    PG8_WAIT_V(4); PG8_BAR;
    PG8_STAGE(PG8_SB(1, 0), cB + kstep, voffB); PG8_STAGE(PG8_SA(1, 0), cA + kstep, voffA); PG8_STAGE(PG8_SB(1, 1), cB + hstepB + kstep, voffB);
    PG8_WAIT_V(6); PG8_BAR;
    for (;;) {
        const bool has_next = S.next(ui + 1, nxt);
        const char* nA = has_next ? nxt.A : cA; const char* nB = has_next ? nxt.B : cB;
        const int nt = cur.nt;
        for (int t = 0; t < nt; t += 2) {
            const bool last = (t == nt - 2);
            const char* a1 = cA + (size_t)(t + 1) * kstep;
            const char* a2 = last ? nA : cA + (size_t)(t + 2) * kstep; const char* b2 = last ? nB : cB + (size_t)(t + 2) * kstep;
            const char* a3 = a2 + kstep; const char* b3 = b2 + kstep;
            PG8_LDB(B0, 0, 0); PG8_SCHED; PG8_LDA(At, 0, 0); PG8_STAGE(PG8_SA(1, 1), a1 + hstepA, voffA);
            PG8_WAIT_L(8); PG8_BAR; PG8_WAIT_L(0); PG8_MMA(0, 0, At, B0); PG8_BAR; PG8_SCHED;
            PG8_LDB(B1, 0, 1); PG8_STAGE(PG8_SB(0, 0), b2, voffB);
            PG8_BAR; PG8_WAIT_L(0); PG8_MMA(0, 1, At, B1); PG8_BAR;
            PG8_LDA(At, 0, 1); PG8_STAGE(PG8_SA(0, 0), a2, voffA);
            PG8_BAR; PG8_WAIT_L(0); PG8_MMA(1, 0, At, B0); PG8_BAR; PG8_SCHED;
            PG8_STAGE(PG8_SB(0, 1), b2 + hstepB, voffB);
            PG8_WAIT_V(6); PG8_BAR; PG8_MMA(1, 1, At, B1); PG8_BAR;
            PG8_LDB(B0, 1, 0); PG8_SCHED; PG8_LDA(At, 1, 0); PG8_STAGE(PG8_SA(0, 1), a2 + hstepA, voffA);
            PG8_WAIT_L(8); PG8_BAR; PG8_WAIT_L(0); PG8_MMA(0, 0, At, B0); PG8_BAR; PG8_SCHED;
            PG8_LDB(B1, 1, 1); PG8_STAGE(PG8_SB(1, 0), b3, voffB);
            PG8_BAR; PG8_WAIT_L(0); PG8_MMA(0, 1, At, B1); PG8_BAR;
            PG8_LDA(At, 1, 1); PG8_STAGE(PG8_SA(1, 0), a3, voffA);
            PG8_BAR; PG8_WAIT_L(0); PG8_MMA(1, 0, At, B0); PG8_BAR; PG8_SCHED;
            PG8_STAGE(PG8_SB(1, 1), b3 + hstepB, voffB);
            PG8_WAIT_V(6); PG8_BAR; PG8_MMA(1, 1, At, B1); PG8_BAR;
        }
        E(acc, cur, wr, wc, fr, fq);
        if (!has_next) break;
#pragma unroll
        for (int a = 0; a < 2; ++a)
#pragma unroll
            for (int b = 0; b < 2; ++b)
#pragma unroll
                for (int m = 0; m < 4; ++m)
#pragma unroll
                    for (int n = 0; n < 2; ++n) acc[a][b][m][n] = (f32x4){0.f, 0.f, 0.f, 0.f};
        cur = nxt; cA = nA; cB = nB; ++ui;
    }
    PG8_WAIT_V(0);
    if (wr == 0) PG8_BAR;
    PG8_BAR;
#undef PG8_SA
#undef PG8_SB
#undef PG8_STAGE
#undef PG8_LDA
#undef PG8_LDB
#undef PG8_MMA
#undef PG8_WAIT_V
#undef PG8_WAIT_L
#undef PG8_BAR
#undef PG8_SCHED
}
typedef f32x4 Acc[2][2][4][2];

__device__ __forceinline__ void store8(bf16_t* p, f32x4 v0, f32x4 v1) {
    u32x4 w; w.x = cvt_pk_bf16(v0[0], v0[1]); w.y = cvt_pk_bf16(v0[2], v0[3]); w.z = cvt_pk_bf16(v1[0], v1[1]); w.w = cvt_pk_bf16(v1[2], v1[3]); *(u32x4*)p = w; }
__device__ __forceinline__ f32x4 gelu4(f32x4 v) { f32x2 a = gelu_pk((f32x2){v[0], v[1]}), b = gelu_pk((f32x2){v[2], v[3]}); return (f32x4){a.x, a.y, b.x, b.y}; }
__device__ __forceinline__ f32x4 silu4(f32x4 v) { return (f32x4){siluf_(v[0]), siluf_(v[1]), siluf_(v[2]), siluf_(v[3])}; }
__device__ __forceinline__ f32x4 sigm4(f32x4 v) { return (f32x4){sigmoidf_(v[0]), sigmoidf_(v[1]), sigmoidf_(v[2]), sigmoidf_(v[3])}; }

struct EpiEvenIn {
    static constexpr bool PERM = true;
    bf16_t* abuf; bf16_t* uv;
    __device__ __forceinline__ void operator()(const Acc& acc, const Unit& u, int wr, int wc, int fr, int fq) const {
        const int row0 = u.pm * BM + wr * 64 + fr; const bool act = u.pn >= 4;
        bf16_t* base = act ? uv : abuf; const int ldc = act ? 2048 : 1024; const int col0 = (act ? (u.pn - 4) : u.pn) * BM + wc * 32 + 8 * fq;
#pragma unroll
        for (int ai = 0; ai < 2; ++ai)
#pragma unroll
            for (int m = 0; m < 4; ++m) { bf16_t* rowp = base + (size_t)(row0 + ai * HALF + m * 16) * ldc + col0;
#pragma unroll
                for (int bj = 0; bj < 2; ++bj) { f32x4 v0 = acc[ai][bj][m][0], v1 = acc[ai][bj][m][1];
                    if (act) { v0 = gelu4(v0); v1 = gelu4(v1); }
                    store8(rowp + bj * HALF, v0, v1); }
                asm volatile("" ::: "memory"); }
    }
};
struct EpiOddIn {
    static constexpr bool PERM = true;
    bf16_t* glu; bf16_t* qkv; bf16_t* zg;
    __device__ __forceinline__ void operator()(const Acc& acc, const Unit& u, int wr, int wc, int fr, int fq) const {
        const int row0 = u.pm * BM + wr * 64 + fr;
        if (u.pn < 8) {
            const int col0 = u.pn * 128 + wc * 32 + 8 * fq;
#pragma unroll
            for (int ai = 0; ai < 2; ++ai)
#pragma unroll
                for (int m = 0; m < 4; ++m) { bf16_t* rowp = glu + (size_t)(row0 + ai * HALF + m * 16) * 1024 + col0;
                    store8(rowp, acc[ai][0][m][0] * sigm4(acc[ai][1][m][0]), acc[ai][0][m][1] * sigm4(acc[ai][1][m][1])); asm volatile("" ::: "memory"); }
        } else {
            const bool isq = u.pn < 20; bf16_t* base = isq ? qkv : zg; const int ldc = isq ? 3072 : 1024; const int col0 = (isq ? (u.pn - 8) : (u.pn - 20)) * BM + wc * 32 + 8 * fq;
#pragma unroll
            for (int ai = 0; ai < 2; ++ai)
#pragma unroll
                for (int m = 0; m < 4; ++m) { bf16_t* rowp = base + (size_t)(row0 + ai * HALF + m * 16) * ldc + col0;
#pragma unroll
                    for (int bj = 0; bj < 2; ++bj) store8(rowp + bj * HALF, acc[ai][bj][m][0], acc[ai][bj][m][1]);
                    asm volatile("" ::: "memory"); }
        }
    }
};
struct EpiUp {
    static constexpr bool PERM = true;
    bf16_t* act;
    __device__ __forceinline__ void operator()(const Acc& acc, const Unit& u, int wr, int wc, int fr, int fq) const {
        const int row0 = u.pm * BM + wr * 64 + fr, col0 = u.pn * 128 + wc * 32 + 8 * fq;
#pragma unroll
        for (int ai = 0; ai < 2; ++ai)
#pragma unroll
            for (int m = 0; m < 4; ++m) { bf16_t* rowp = act + (size_t)(row0 + ai * HALF + m * 16) * DFF + col0;
                store8(rowp, silu4(acc[ai][0][m][0]) * acc[ai][1][m][0], silu4(acc[ai][0][m][1]) * acc[ai][1][m][1]); asm volatile("" ::: "memory"); }
    }
};
struct EpiPool {
    static constexpr bool PERM = true;
    bf16_t* cat; const float* scale;
    __device__ __forceinline__ void operator()(const Acc& acc, const Unit& u, int wr, int wc, int fr, int fq) const {
        const int row0 = u.pm * BM + wr * 64 + fr, col0 = u.pn * BM + wc * 32 + 8 * fq;
#pragma unroll
        for (int ai = 0; ai < 2; ++ai)
#pragma unroll
            for (int m = 0; m < 4; ++m) { bf16_t* rowp = cat + (size_t)(row0 + ai * HALF + m * 16) * 2048 + col0;
#pragma unroll
                for (int bj = 0; bj < 2; ++bj) { const f32x4 s0 = *(const f32x4*)(scale + col0 + bj * HALF), s1 = *(const f32x4*)(scale + col0 + bj * HALF + 4);
                    store8(rowp + bj * HALF, acc[ai][bj][m][0] * s0, acc[ai][bj][m][1] * s1); }
                asm volatile("" ::: "memory"); }
    }
};
struct EpiResid {
    static constexpr bool PERM = false;
    float* x; bool dry;
    __device__ __forceinline__ void operator()(const Acc& acc, const Unit& u, int wr, int wc, int fr, int fq) const {
        if (dry) return;
        const int row0 = u.pm * BM + wr * 64 + fr, col0 = u.pn * BM + wc * 32 + 4 * fq;
#pragma unroll
        for (int ai = 0; ai < 2; ++ai) {
            f32x4 t[4][2][2];
#pragma unroll
            for (int m = 0; m < 4; ++m) { const float* rowp = x + (size_t)(row0 + ai * HALF + m * 16) * 2048 + col0;
#pragma unroll
                for (int bj = 0; bj < 2; ++bj)
#pragma unroll
                    for (int n = 0; n < 2; ++n) t[m][bj][n] = *(const f32x4*)(rowp + bj * HALF + n * 16); }
#pragma unroll
            for (int m = 0; m < 4; ++m) { float* rowp = x + (size_t)(row0 + ai * HALF + m * 16) * 2048 + col0;
#pragma unroll
                for (int bj = 0; bj < 2; ++bj)
#pragma unroll
                    for (int n = 0; n < 2; ++n) *(f32x4*)(rowp + bj * HALF + n * 16) = t[m][bj][n] + acc[ai][bj][m][n]; }
            asm volatile("" ::: "memory"); }
    }
};
struct EpiPartX {
    static constexpr bool PERM = false;
    float* px; bool dry;
    __device__ __forceinline__ void operator()(const Acc& acc, const Unit& u, int wr, int wc, int fr, int fq) const {
        if (dry) return;
        float* base = px + (size_t)u.pad * 32768 + (size_t)(wr * 64 + fr) * 256 + wc * 32 + 4 * fq;
#pragma unroll
        for (int m = 0; m < 4; ++m)
#pragma unroll
            for (int bj = 0; bj < 2; ++bj)
#pragma unroll
                for (int n = 0; n < 2; ++n) *(f32x4*)(base + (size_t)(m * 16) * 256 + bj * HALF + n * 16) = acc[0][bj][m][n];
    }
};
struct EpiResidX {
    static constexpr bool PERM = false;
    EpiResid r; EpiPartX p;
    __device__ __forceinline__ void operator()(const Acc& acc, const Unit& u, int wr, int wc, int fr, int fq) const { if (u.pm < MPR / 256) r(acc, u, wr, wc, fr, fq); else p(acc, u, wr, wc, fr, fq); }
};
}

struct TItem { const float* src; bf16_t* dst; int ldw, K; };
__device__ __forceinline__ TItem titem_locate(PP P, unsigned char* ws, int it) {
    const float* W; bf16_t* WT; int ldw, K, Nd, pairLimit = 0, Hh = 0, r = it;
    if (r < 6144) { const int j = r / 3072; r -= j * 3072; W = P->in[9] + (size_t)j * 2048 * 3072; WT = (bf16_t*)(ws + WS_WEVIN) + (size_t)j * 3072 * 2048; ldw = 3072; K = 2048; Nd = 3072; }
    else if ((r -= 6144) < 4096) { const int e = r / 2048; r -= e * 2048; W = P->in[16] + (size_t)e * 2048 * 2048; WT = (bf16_t*)(ws + WS_WEVOUT) + (size_t)e * 2048 * 2048; ldw = 2048; K = 2048; Nd = 2048; }
    else if ((r -= 4096) < 12288) { const int o = r / 6144; r -= o * 6144; W = P->in[17] + (size_t)o * 2048 * OD_IN; WT = (bf16_t*)(ws + WS_WODIN) + (size_t)o * OD_INM * 2048; ldw = OD_IN; K = 2048; Nd = OD_INM; pairLimit = 2048; Hh = 1024; }
    else if ((r -= 12288) < 4096) { const int o = r / 2048; r -= o * 2048; W = P->in[26] + (size_t)o * 2048 * 2048; WT = (bf16_t*)(ws + WS_WODOUT) + (size_t)o * 2048 * 2048; ldw = 2048; K = 2048; Nd = 2048; }
    else if ((r -= 4096) < 45056) { const int l = r / 11264; r -= l * 11264; W = P->in[27] + (size_t)l * 2048 * 2 * DFF; WT = (bf16_t*)(ws + WS_WUP) + (size_t)l * 2 * DFF * 2048; ldw = 2 * DFF; K = 2048; Nd = 2 * DFF; pairLimit = 2 * DFF; Hh = DFF; }
    else if ((r -= 45056) < 22528) { const int l = r / 5632; r -= l * 5632; W = P->in[28] + (size_t)l * DFF * 2048; WT = (bf16_t*)(ws + WS_WDOWN) + (size_t)l * 2048 * DFF; ldw = 2048; K = DFF; Nd = 2048; }
    else { r -= 22528; const int eg = r / 32; r -= eg * 32; W = P->in[10] + (size_t)eg * 65536; WT = (bf16_t*)(ws + WS_WPOOL) + (size_t)eg * 65536; ldw = 256; K = 256; Nd = 256; }
    const int nblk = Nd / 32, kb = r / nblk, nb = r - kb * nblk, n0 = nb * 32; int src = n0;
    if (n0 < pairLimit) { const int pn = n0 >> 8, c = n0 & 255; src = c < 128 ? pn * 128 + c : Hh + pn * 128 + (c - 128); }
    TItem t; t.src = W + (size_t)(kb * 64) * ldw + src; t.dst = WT + (size_t)n0 * K + kb * 64; t.ldw = ldw; t.K = K; return t;
}
constexpr int T_ITEMS = 6144 + 4096 + 12288 + 4096 + 45056 + 22528 + 256;
__device__ __forceinline__ void titem_load(const TItem& t, float (&r)[32], int lane) {
    const float* p = t.src + (size_t)(lane >> 5) * t.ldw + (lane & 31);
#pragma unroll
    for (int i = 0; i < 32; ++i) r[i] = p[(size_t)(2 * i) * t.ldw];
}
__device__ __forceinline__ void titem_store(const TItem& t, const float (&r)[32], LAS float* scr, int lane) {
#pragma unroll
    for (int i = 0; i < 32; ++i) scr[(2 * i + (lane >> 5)) * 33 + (lane & 31)] = r[i];
    asm volatile("s_waitcnt lgkmcnt(0)" ::: "memory");
    const int c = lane & 7;
#pragma unroll
    for (int j = 0; j < 4; ++j) { const int n = (lane >> 3) + 8 * j; const LAS float* s = scr + (8 * c) * 33 + n;
        u32x4 o; o.x = cvt_pk_bf16(s[0 * 33], s[1 * 33]); o.y = cvt_pk_bf16(s[2 * 33], s[3 * 33]); o.z = cvt_pk_bf16(s[4 * 33], s[5 * 33]); o.w = cvt_pk_bf16(s[6 * 33], s[7 * 33]);
        *(u32x4*)(t.dst + (size_t)n * t.K + 8 * c) = o; }
    asm volatile("s_waitcnt lgkmcnt(0)" ::: "memory");
}
constexpr int L_EVEN_ITEMS = 3072 + 2048 + 128 + 11264 + 5632, L_ODD_ITEMS = 6144 + 2048 + 11264 + 5632;
__device__ __forceinline__ int layer_item(int l, int i) {
    const int h = l >> 1;
    if ((l & 1) == 0) { if (i < 3072) return h * 3072 + i; i -= 3072; if (i < 2048) return 6144 + h * 2048 + i; i -= 2048; if (i < 128) return 94208 + h * 128 + i; i -= 128; }
    else { if (i < 6144) return 10240 + h * 6144 + i; i -= 6144; if (i < 2048) return 22528 + h * 2048 + i; i -= 2048; }
    if (i < 11264) return 26624 + l * 11264 + i; i -= 11264; return 71680 + l * 5632 + i;
}
constexpr int DEF1_A = 5568, DEF1_B = 4032, DEF2_A = 7968, DEF2_B = 4032, DEF3_A = 5568, DEF3_B = 4032;
constexpr int PREP_L1 = L_ODD_ITEMS - DEF1_A - DEF1_B, PREP_L2 = L_EVEN_ITEMS - DEF2_A - DEF2_B, PREP_L3 = L_ODD_ITEMS - DEF3_A - DEF3_B;
constexpr int PREP_ITEMS = L_EVEN_ITEMS + PREP_L1 + PREP_L2 + PREP_L3;
__device__ __forceinline__ int prep_item(int p) {
    if (p < L_EVEN_ITEMS) return layer_item(0, p); p -= L_EVEN_ITEMS;
    if (p < PREP_L1) return layer_item(1, DEF1_A + DEF1_B + p); p -= PREP_L1;
    if (p < PREP_L2) return layer_item(2, DEF2_A + DEF2_B + p); p -= PREP_L2;
    return layer_item(3, DEF3_A + DEF3_B + p);
}
__device__ __forceinline__ void convert_span(PP P, LAS unsigned char* lds, int tid, int wv, int nwv, int count, int mode, int layer, int first) {
    const int lane = tid & 63, wave = tid >> 6;
    LAS float* scr = (LAS float*)(lds + wave * 8448);
    unsigned char* ws = P->ws;
    int it = wv; TItem dA, dB; float ra[32], rb[32];
#define CONV_MAP(j) (mode == 0 ? prep_item(j) : (mode == 2 ? (j) : layer_item(layer, first + (j))))
    if (it < count) { dA = titem_locate(P, ws, CONV_MAP(it)); titem_load(dA, ra, lane); }
    while (it < count) {
        const int itB = it + nwv; const bool hb = itB < count;
        if (hb) { dB = titem_locate(P, ws, CONV_MAP(itB)); titem_load(dB, rb, lane); }
        titem_store(dA, ra, scr, lane);
        if (!hb) break;
        const int itA = itB + nwv; const bool ha = itA < count;
        if (ha) { dA = titem_locate(P, ws, CONV_MAP(itA)); titem_load(dA, ra, lane); }
        titem_store(dB, rb, scr, lane);
        if (!ha) break;
        it = itA;
    }
#undef CONV_MAP
}
__device__ __forceinline__ void convert_slot(const Ctx& cx, PP P, LAS unsigned char* lds, int layer, int first, int count, int thr, int ncu) {
    if (cx.G != 256 || cx.bid < thr || cx.bid >= thr + ncu) return;
    __syncthreads();
    convert_span(P, lds, cx.tid, (cx.bid - thr) * NWAVES + (cx.tid >> 6), ncu * NWAVES, count, 1, layer, first);
}
__device__ __forceinline__ void phase_prep(const Ctx& cx, PP P, LAS unsigned char* lds) {
    const int tid = cx.tid;
    const int G = cx.G;
    unsigned char* ws = P->ws;
    if (G == 256) convert_span(P, lds, tid, cx.bid * NWAVES + (tid >> 6), G * NWAVES, PREP_ITEMS, 0, 0, 0);
    else convert_span(P, lds, tid, cx.bid * NWAVES + (tid >> 6), G * NWAVES, T_ITEMS, 2, 0, 0);
    {
        bf16_t* wab = (bf16_t*)(ws + WS_WAB);
        for (int i = cx.bid * NTHR + tid; i < 2 * 16 * 2048; i += G * NTHR) { const int o = i >> 15, c = (i >> 11) & 15, k = i & 2047;
            wab[i] = (bf16_t)(cvt_pk_bf16(P->in[17][(size_t)o * 2048 * OD_IN + (size_t)k * OD_IN + OD_INM + c], 0.f) & 0xffff); }
    }
}

template <bool F32OUT>
__device__ __forceinline__ void phase_rmsnorm(const Ctx& cx, float* X, const float* g, bf16_t* Hout, float* Fout, const float* px, int ppu, bool dry, LAS unsigned char* lds) {
    const int tid = cx.tid, lane = tid & 63, wave = __builtin_amdgcn_readfirstlane(tid >> 6);
    const int gw = cx.bid * NWAVES + wave, NGW = cx.G * NWAVES;
    if (ppu > 0) {
        LAS float* red = (LAS float*)lds;
        for (int r = cx.bid; r < BS; r += cx.G) {
            const int m = MPR + r, col = 256 * wave + lane * 4, P8 = 8 * ppu;
            f32x4 a = *(const f32x4*)(X + (size_t)m * D + col);
            const float* pr = px + (size_t)r * 256 + lane * 4 + (size_t)(32 * wave) * 32768;
#pragma unroll
            for (int i = 0; i < 32; ++i) { const int vc = 32 * wave + i; if (((vc + 1) * P8) / 256 > (vc * P8) / 256) a = a + *(const f32x4*)(pr + (size_t)i * 32768); }
            if (!dry) *(f32x4*)(X + (size_t)m * D + col) = a;
            const float ss = wave_sum((a.x * a.x + a.y * a.y) + (a.z * a.z + a.w * a.w));
            if (lane == 0) red[wave] = ss;
            __syncthreads();
            float tot = 0.f;
#pragma unroll
            for (int i = 0; i < 8; ++i) tot += red[i];
            const float rs = rsqrtf(tot * (1.0f / D) + EPS);
            const f32x4 g4 = *(const f32x4*)(g + col); const f32x4 o = a * rs * g4;
            if (F32OUT) *(f32x4*)(Fout + (size_t)m * D + col) = o;
            else { u32x2 w; w.x = cvt_pk_bf16(o.x, o.y); w.y = cvt_pk_bf16(o.z, o.w); *(u32x2*)(Hout + (size_t)m * D + col) = w; }
            __syncthreads();
        }
    }
    const int mend = ppu > 0 ? MPR : MT;
    for (int m = gw; m < mend; m += 4 * NGW) {
        f32x4 v[4][8]; float ss[4]; int mr[4]; bool ok[4];
#pragma unroll
        for (int k = 0; k < 4; ++k) { const int mk = m + k * NGW; ok[k] = mk < mend; mr[k] = ok[k] ? mk : m; const f32x4* xr = (const f32x4*)(X + (size_t)mr[k] * D) + lane;
#pragma unroll
            for (int j = 0; j < 8; ++j) v[k][j] = xr[64 * j]; }
#pragma unroll
        for (int k = 0; k < 4; ++k) { float a = 0.f;
#pragma unroll
            for (int j = 0; j < 8; ++j) a += (v[k][j].x * v[k][j].x + v[k][j].y * v[k][j].y) + (v[k][j].z * v[k][j].z + v[k][j].w * v[k][j].w);
            ss[k] = a; }
#pragma unroll
        for (int o = 1; o < 64; o <<= 1) {
#pragma unroll
            for (int k = 0; k < 4; ++k) ss[k] += __shfl_xor(ss[k], o); }
#pragma unroll
        for (int j = 0; j < 8; ++j) { const f32x4 g4 = ((const f32x4*)g)[lane + 64 * j];
#pragma unroll
            for (int k = 0; k < 4; ++k) if (ok[k]) { const float rs = rsqrtf(ss[k] * (1.0f / D) + EPS); const f32x4 o = v[k][j] * rs * g4;
                if (F32OUT) ((f32x4*)(Fout + (size_t)mr[k] * D))[lane + 64 * j] = o;
                else { u32x2 w; w.x = cvt_pk_bf16(o.x, o.y); w.y = cvt_pk_bf16(o.z, o.w); ((u32x2*)(Hout + (size_t)mr[k] * D))[lane + 64 * j] = w; } } }
    }
}

__device__ __forceinline__ void phase_first_norm(const Ctx& cx, PP P, float* X, const float* g, bf16_t* Hout) {
    const int tid = cx.tid, lane = tid & 63, wave = __builtin_amdgcn_readfirstlane(tid >> 6);
    const int gw = cx.bid * NWAVES + wave, NGW = cx.G * NWAVES;
    for (int m = gw; m < MT; m += NGW) {
        const float* src = m < MPR ? P->in[0] + (size_t)m * D : P->in[1] + (size_t)(m - MPR) * D;
        const f32x4* xr = (const f32x4*)src + lane; f32x4 v[8]; float ss = 0.f;
#pragma unroll
        for (int j = 0; j < 8; ++j) { v[j] = xr[64 * j]; ss += (v[j].x * v[j].x + v[j].y * v[j].y) + (v[j].z * v[j].z + v[j].w * v[j].w); }
        const float rs = rsqrtf(wave_sum(ss) * (1.0f / D) + EPS);
#pragma unroll
        for (int j = 0; j < 8; ++j) { ((f32x4*)(X + (size_t)m * D))[lane + 64 * j] = v[j]; const f32x4 g4 = ((const f32x4*)g)[lane + 64 * j]; const f32x4 o = v[j] * rs * g4;
            u32x2 w; w.x = cvt_pk_bf16(o.x, o.y); w.y = cvt_pk_bf16(o.z, o.w); ((u32x2*)(Hout + (size_t)m * D))[lane + 64 * j] = w; }
    }
}

__device__ __forceinline__ void phase_even_prep(const Ctx& cx, PP P, int e) {
    const int tid = cx.tid, lane = tid & 63, wave = __builtin_amdgcn_readfirstlane(tid >> 6);
    const int gw = cx.bid * NWAVES + wave, NGW = cx.G * NWAVES;
    unsigned char* ws = P->ws;
    const bf16_t* abuf = (const bf16_t*)(ws + WS_ABUF); const bf16_t* uv = (const bf16_t*)(ws + WS_UV);
    bf16_t* pooled = (bf16_t*)(ws + WS_MIX); bf16_t* vn = (bf16_t*)(ws + WS_VN); bf16_t* cat = (bf16_t*)(ws + WS_CAT);
    const float* spool = P->in[2] + (size_t)e * BS * 15 * 1024;
    const float* lng = P->in[12] + e * 1024; const float* lnb = P->in[13] + e * 1024;
    const float* sws = P->in[14] + (size_t)e * 4 * 128 * 128; const float* sb = P->in[15] + e * 4 * 128;
    float* out = P->out;
    constexpr int GPS = (SEQ + 4) / 5;
    for (int task = gw; task < BP * GPS + BS; task += NGW) {
      if (task >= BP * GPS) {
        const int m = MPR + task - BP * GPS; const bool prompt = false; const int b = m - MPR, t = 0;
#pragma unroll
        for (int p = 0; p < 4; ++p) {
            const int w = 2 << p, ch0 = p * 256 + lane * 4;
            float cur[4], sacc[4];
            { const u32x2 r = *(const u32x2*)(abuf + (size_t)m * 1024 + ch0); cur[0] = bf_lo(r.x); cur[1] = bf_hi(r.x); cur[2] = bf_lo(r.y); cur[3] = bf_hi(r.y); }
#pragma unroll
            for (int i = 0; i < 4; ++i) sacc[i] = cur[i];
            float cnt;
            if (prompt) {
#pragma unroll
                for (int d = 1; d < w; ++d) if (t - d >= 0) { const u32x2 r = *(const u32x2*)(abuf + (size_t)(m - d) * 1024 + ch0);
                    sacc[0] += bf_lo(r.x); sacc[1] += bf_hi(r.x); sacc[2] += bf_lo(r.y); sacc[3] += bf_hi(r.y); }
                cnt = (float)(w < t + 1 ? w : t + 1);
            } else {
#pragma unroll
                for (int d = 1; d < w; ++d) { const f32x4 h0 = *(const f32x4*)(spool + ((size_t)b * 15 + (15 - d)) * 1024 + ch0);
                    sacc[0] += h0.x; sacc[1] += h0.y; sacc[2] += h0.z; sacc[3] += h0.w; }
                cnt = (float)w;
            }
            const float ic = 1.0f / cnt;
            u32x2 pw; pw.x = cvt_pk_bf16(sacc[0] * ic - cur[0], sacc[1] * ic - cur[1]); pw.y = cvt_pk_bf16(sacc[2] * ic - cur[2], sacc[3] * ic - cur[3]);
            *(u32x2*)(pooled + (size_t)m * 1024 + ch0) = pw;
            const f32x4 c4 = (f32x4){cur[0], cur[1], cur[2], cur[3]};
            if (prompt) { if (t >= SEQ - 15) *(f32x4*)(out + O_PP + (((size_t)e * BP + b) * 15 + (t - (SEQ - 15))) * 1024 + ch0) = c4; }
            else { float* ob = out + O_PS + ((size_t)e * BS + b) * 15 * 1024 + ch0;
                *(f32x4*)(ob + 14 * 1024) = c4; }
        }
        float v[2][8]; float sm = 0.f;
#pragma unroll
        for (int jj = 0; jj < 2; ++jj) { const int ch0 = (lane + 64 * jj) * 8; const u32x4 r = *(const u32x4*)(uv + (size_t)m * 2048 + 1024 + ch0); unpack8(r, v[jj]);
#pragma unroll
            for (int i = 0; i < 8; ++i) sm += v[jj][i]; }
        const float mu = wave_sum(sm) * (1.0f / 1024.f); float sq = 0.f;
#pragma unroll
        for (int jj = 0; jj < 2; ++jj)
#pragma unroll
            for (int i = 0; i < 8; ++i) { v[jj][i] -= mu; sq += v[jj][i] * v[jj][i]; }
        const float rstd = rsqrtf(wave_sum(sq) * (1.0f / 1024.f) + EPS);
#pragma unroll
        for (int jj = 0; jj < 2; ++jj) { const int ch0 = (lane + 64 * jj) * 8; float o[8];
#pragma unroll
            for (int i = 0; i < 8; ++i) o[i] = v[jj][i] * rstd * lng[ch0 + i] + lnb[ch0 + i];
            *(u32x4*)(vn + (size_t)m * 1024 + ch0) = pack8(o);
            if (!prompt) {
                float* op = out + O_SV + ((size_t)e * BS + b) * 1024 + ch0;
                *(f32x4*)op = (f32x4){o[0], o[1], o[2], o[3]}; *(f32x4*)(op + 4) = (f32x4){o[4], o[5], o[6], o[7]};
                const int h = ch0 >> 8; const float w00 = sws[(size_t)h * 128 * 128], b0 = sb[h * 128];
                float uu[8]; const u32x4 r = *(const u32x4*)(uv + (size_t)m * 2048 + ch0); unpack8(r, uu);
                float c[8];
#pragma unroll
                for (int i = 0; i < 8; ++i) c[i] = uu[i] * (w00 * o[i] + b0);
                *(u32x4*)(cat + (size_t)m * 2048 + 1024 + ch0) = pack8(c);
            } }
      }
      else {
        const int b = task / GPS, gi = task - b * GPS, t0 = gi * 5, R = (SEQ - t0) < 5 ? (SEQ - t0) : 5, mbase = b * SEQ + t0;
#pragma unroll
        for (int p = 0; p < 4; ++p) {
            constexpr int dummy = 0; (void)dummy;
            const int w = 2 << p, ch0 = p * 256 + lane * 4;
            float x[20][4];
#pragma unroll
            for (int i = 0; i < 20; ++i) if (i < w + 4) { const int ti = t0 - (w - 1) + i; const bool valid = (ti >= 0) && (i < w - 1 + R);
                const u32x2 r = *(const u32x2*)(abuf + (size_t)(valid ? mbase - (w - 1) + i : mbase) * 1024 + ch0);
                x[i][0] = valid ? bf_lo(r.x) : 0.f; x[i][1] = valid ? bf_hi(r.x) : 0.f; x[i][2] = valid ? bf_lo(r.y) : 0.f; x[i][3] = valid ? bf_hi(r.y) : 0.f; }
            float sacc[4] = {0.f, 0.f, 0.f, 0.f};
#pragma unroll
            for (int i = 0; i < 16; ++i) if (i < w) {
#pragma unroll
                for (int c = 0; c < 4; ++c) sacc[c] += x[i][c]; }
#pragma unroll
            for (int r = 0; r < 5; ++r) {
                if (r > 0) {
#pragma unroll
                    for (int c = 0; c < 4; ++c) sacc[c] += x[r + w - 1][c] - x[r - 1][c]; }
                const int t = t0 + r; const float ic = 1.0f / (float)(w < t + 1 ? w : t + 1);
                const float* cur = x[r + w - 1];
                if (r < R) { u32x2 pw; pw.x = cvt_pk_bf16(sacc[0] * ic - cur[0], sacc[1] * ic - cur[1]); pw.y = cvt_pk_bf16(sacc[2] * ic - cur[2], sacc[3] * ic - cur[3]);
                    *(u32x2*)(pooled + (size_t)(mbase + r) * 1024 + ch0) = pw;
                    if (t >= SEQ - 15) *(f32x4*)(out + O_PP + (((size_t)e * BP + b) * 15 + (t - (SEQ - 15))) * 1024 + ch0) = (f32x4){cur[0], cur[1], cur[2], cur[3]}; }
            }
        }
        float v[5][2][8]; float sm[5], sq[5];
#pragma unroll
        for (int r = 0; r < 5; ++r) { const int mr = mbase + (r < R ? r : 0); float a = 0.f;
#pragma unroll
            for (int jj = 0; jj < 2; ++jj) { const int ch0 = (lane + 64 * jj) * 8; const u32x4 q = *(const u32x4*)(uv + (size_t)mr * 2048 + 1024 + ch0); unpack8(q, v[r][jj]);
#pragma unroll
                for (int i = 0; i < 8; ++i) a += v[r][jj][i]; }
            sm[r] = a; }
#pragma unroll
        for (int of = 1; of < 64; of <<= 1) {
#pragma unroll
            for (int r = 0; r < 5; ++r) sm[r] += __shfl_xor(sm[r], of); }
#pragma unroll
        for (int r = 0; r < 5; ++r) { const float mu = sm[r] * (1.0f / 1024.f); float a = 0.f;
#pragma unroll
            for (int jj = 0; jj < 2; ++jj)
#pragma unroll
                for (int i = 0; i < 8; ++i) { v[r][jj][i] -= mu; a += v[r][jj][i] * v[r][jj][i]; }
            sq[r] = a; }
#pragma unroll
        for (int of = 1; of < 64; of <<= 1) {
#pragma unroll
            for (int r = 0; r < 5; ++r) sq[r] += __shfl_xor(sq[r], of); }
#pragma unroll
        for (int jj = 0; jj < 2; ++jj) { const int ch0 = (lane + 64 * jj) * 8;
            const f32x4 g0 = *(const f32x4*)(lng + ch0), g1 = *(const f32x4*)(lng + ch0 + 4), b0 = *(const f32x4*)(lnb + ch0), b1 = *(const f32x4*)(lnb + ch0 + 4);
            const float gg[8] = {g0.x, g0.y, g0.z, g0.w, g1.x, g1.y, g1.z, g1.w}, bb[8] = {b0.x, b0.y, b0.z, b0.w, b1.x, b1.y, b1.z, b1.w};
#pragma unroll
            for (int r = 0; r < 5; ++r) if (r < R) { const float rstd = rsqrtf(sq[r] * (1.0f / 1024.f) + EPS); float o8[8];
#pragma unroll
                for (int i = 0; i < 8; ++i) o8[i] = v[r][jj][i] * rstd * gg[i] + bb[i];
                *(u32x4*)(vn + (size_t)(mbase + r) * 1024 + ch0) = pack8(o8); } }
      }
    }
}

__device__ __forceinline__ void phase_sgu(const Ctx& cx, PP P, int e, LAS unsigned char* lds) {
    const int tid = cx.tid, lane = tid & 63, wave = __builtin_amdgcn_readfirstlane(tid >> 6), l15 = lane & 15, quad = lane >> 4;
    const int G = cx.G;
    unsigned char* ws = P->ws;
    const bf16_t* uv = (const bf16_t*)(ws + WS_UV); const bf16_t* vn = (const bf16_t*)(ws + WS_VN); bf16_t* cat = (bf16_t*)(ws + WS_CAT);
    const float* sws = P->in[14] + (size_t)e * 4 * 128 * 128; const float* sb = P->in[15] + e * 4 * 128;
    LAS bf16_t* VT = (LAS bf16_t*)lds;
    for (int task = (G - 1 - cx.bid); task < 256; task += G) {
        const int b = task >> 6, n = (task >> 2) & 15, h = task & 3; const int m0 = b * SEQ + n * 128;
        for (int idx = tid; idx < 128 * 32; idx += NTHR) { const int r = idx >> 5, cq = idx & 31;
            const u32x4 w = *(const u32x4*)(vn + (size_t)(m0 + r) * 1024 + h * 256 + cq * 8);
            LAS bf16_t* d = VT + (cq * 8) * 136 + (r ^ ((cq & 7) << 3));
            d[0 * 136] = (bf16_t)(w.x & 0xffff); d[1 * 136] = (bf16_t)(w.x >> 16); d[2 * 136] = (bf16_t)(w.y & 0xffff); d[3 * 136] = (bf16_t)(w.y >> 16);
            d[4 * 136] = (bf16_t)(w.z & 0xffff); d[5 * 136] = (bf16_t)(w.z >> 16); d[6 * 136] = (bf16_t)(w.w & 0xffff); d[7 * 136] = (bf16_t)(w.w >> 16); }
        __syncthreads();
        const int irow = 16 * wave + l15;
        bf16x8 af[4];
#pragma unroll
        for (int ks = 0; ks < 4; ++ks) { const int k0 = ks * 32 + quad * 8; const float* wp = sws + ((size_t)h * 128 + irow) * 128 + k0; const f32x4 a0 = *(const f32x4*)wp, a1 = *(const f32x4*)(wp + 4);
            float f[8] = {a0.x, a0.y, a0.z, a0.w, a1.x, a1.y, a1.z, a1.w};
#pragma unroll
            for (int i = 0; i < 8; ++i) if (k0 + i > irow) f[i] = 0.f;
            const u32x4 pw = pack8(f); af[ks] = __builtin_bit_cast(bf16x8, pw); }
        const float bias = sb[h * 128 + irow];
#pragma unroll 2
        for (int nt = 0; nt < 16; ++nt) {
            f32x4 acc = (f32x4){0.f, 0.f, 0.f, 0.f};
#pragma unroll
            for (int ks = 0; ks < 4; ++ks) { const bf16x8 bfr = *(const LAS bf16x8*)(VT + (nt * 16 + l15) * 136 + ((ks * 32 + quad * 8) ^ ((((nt * 16 + l15) >> 3) & 7) << 3)));
                acc = __builtin_amdgcn_mfma_f32_16x16x32_bf16(bfr, af[ks], acc, 0, 0, 0); }
            const int c0 = h * 256 + nt * 16 + quad * 4;
            const u32x2 uw = *(const u32x2*)(uv + (size_t)(m0 + irow) * 2048 + c0);
            u32x2 ow; ow.x = cvt_pk_bf16(bf_lo(uw.x) * (acc[0] + bias), bf_hi(uw.x) * (acc[1] + bias)); ow.y = cvt_pk_bf16(bf_lo(uw.y) * (acc[2] + bias), bf_hi(uw.y) * (acc[3] + bias));
            *(u32x2*)(cat + (size_t)(m0 + irow) * 2048 + 1024 + c0) = ow;
        }
        __syncthreads();
    }
}

__device__ __forceinline__ void phase_ab(const Ctx& cx, PP P, int o) {
    const int tid = cx.tid, lane = tid & 63, l15 = lane & 15, quad = lane >> 4, wave = __builtin_amdgcn_readfirstlane(tid >> 6);
    const int gw = cx.bid * NWAVES + wave, NGW = cx.G * NWAVES;
    const bf16_t* H = (const bf16_t*)(P->ws + WS_H); float* AB = (float*)(P->ws + WS_AB);
    const bf16_t* Wt = (const bf16_t*)(P->ws + WS_WAB) + (size_t)o * 16 * 2048;
    for (int tt = NGW - 1 - gw; tt < MT / 16; tt += NGW) {
        const bf16_t* ap = H + (size_t)(16 * tt + l15) * D + quad * 8; const bf16_t* bp = Wt + (size_t)l15 * 2048 + quad * 8;
        f32x4 acc = (f32x4){0.f, 0.f, 0.f, 0.f};
#pragma unroll 16
        for (int ks = 0; ks < 64; ++ks) { const bf16x8 a = *(const bf16x8*)(ap + ks * 32), b = *(const bf16x8*)(bp + ks * 32); acc = __builtin_amdgcn_mfma_f32_16x16x32_bf16(a, b, acc, 0, 0, 0); }
#pragma unroll
        for (int j = 0; j < 4; ++j) AB[(size_t)(16 * tt + quad * 4 + j) * 16 + l15] = acc[j];
    }
}

__device__ __forceinline__ void phase_odd_prep(const Ctx& cx, PP P, int o, LAS unsigned char* lds) {
    const int tid = cx.tid, lane = tid & 63, wave = __builtin_amdgcn_readfirstlane(tid >> 6);
    const int gw = cx.bid * NWAVES + wave, NGW = cx.G * NWAVES;
    unsigned char* ws = P->ws;
    const bf16_t* glu = (const bf16_t*)(ws + WS_ABUF); const bf16_t* qkv = (const bf16_t*)(ws + WS_UV);
    bf16_t* qkvc = (bf16_t*)(ws + WS_MIX); bf16_t* cat = (bf16_t*)(ws + WS_CAT);
    const float* AB = (const float*)(ws + WS_AB); float* Gg = (float*)(ws + WS_G); float* Bt = (float*)(ws + WS_BETA);
    const float* sconv = P->in[3] + (size_t)o * BS * 30 * 1024; const float* sdn = P->in[4] + (size_t)o * BS * 3 * 3072;
    const float* dw = P->in[18] + (size_t)o * 31 * 1024; const float* db = P->in[19] + o * 1024; const float* lng = P->in[20] + o * 1024; const float* lnb = P->in[21] + o * 1024;
    const float* cw = P->in[22] + (size_t)o * 4 * 3072; const float* alog = P->in[23] + o * 8; const float* dtb = P->in[24] + o * 8;
    float* out = P->out;
    LAS float* dwl = (LAS float*)lds;
    constexpr int GPS = (SEQ + 4) / 5;
#pragma unroll 8
    for (int i = tid; i < 31 * 256; i += NTHR) ((LAS f32x4*)dwl)[i] = ((const f32x4*)dw)[i];
    __syncthreads();
    for (int task = gw; task < BP * GPS + BS; task += NGW) {
      if (task >= BP * GPS) {
        const int m = MPR + task - BP * GPS; const bool prompt = false; const int b = m - MPR, t = 0;
        float y[2][8]; float sm = 0.f;
#pragma unroll
        for (int jj = 0; jj < 2; ++jj) {
            const int ch0 = (lane + 64 * jj) * 8;
            { const f32x4 d0 = *(const f32x4*)(db + ch0), d1 = *(const f32x4*)(db + ch0 + 4); y[jj][0] = d0.x; y[jj][1] = d0.y; y[jj][2] = d0.z; y[jj][3] = d0.w; y[jj][4] = d1.x; y[jj][5] = d1.y; y[jj][6] = d1.z; y[jj][7] = d1.w; }
            float cur[8];
            { const u32x4 r = *(const u32x4*)(glu + (size_t)m * 1024 + ch0); unpack8(r, cur); }
            { const f32x4 w0 = *(const LAS f32x4*)(dwl + 30 * 1024 + ch0), w1 = *(const LAS f32x4*)(dwl + 30 * 1024 + ch0 + 4);
              y[jj][0] += w0.x * cur[0]; y[jj][1] += w0.y * cur[1]; y[jj][2] += w0.z * cur[2]; y[jj][3] += w0.w * cur[3]; y[jj][4] += w1.x * cur[4]; y[jj][5] += w1.y * cur[5]; y[jj][6] += w1.z * cur[6]; y[jj][7] += w1.w * cur[7]; }
            if (prompt) {
                const int j0 = t >= 30 ? 0 : 30 - t;
#pragma unroll
                for (int hh = 0; hh < 2; ++hh) {
                    u32x4 rr[15];
#pragma unroll
                    for (int jx = 0; jx < 15; ++jx) { const int j = hh * 15 + jx; const int jm = (j >= j0) ? (m - 30 + j) : m; rr[jx] = *(const u32x4*)(glu + (size_t)jm * 1024 + ch0); }
#pragma unroll
                    for (int jx = 0; jx < 15; ++jx) { const int j = hh * 15 + jx; if (j >= j0) { float x[8]; unpack8(rr[jx], x);
                        const f32x4 w0 = *(const LAS f32x4*)(dwl + j * 1024 + ch0), w1 = *(const LAS f32x4*)(dwl + j * 1024 + ch0 + 4);
                        y[jj][0] += w0.x * x[0]; y[jj][1] += w0.y * x[1]; y[jj][2] += w0.z * x[2]; y[jj][3] += w0.w * x[3]; y[jj][4] += w1.x * x[4]; y[jj][5] += w1.y * x[5]; y[jj][6] += w1.z * x[6]; y[jj][7] += w1.w * x[7]; } }
                    asm volatile("" ::: "memory");
                }
            } else {
#pragma unroll 10
                for (int j = 0; j < 30; ++j) { const float* hp = sconv + ((size_t)b * 30 + j) * 1024 + ch0; const f32x4 h0 = *(const f32x4*)hp, h1 = *(const f32x4*)(hp + 4);
                    const f32x4 w0 = *(const LAS f32x4*)(dwl + j * 1024 + ch0), w1 = *(const LAS f32x4*)(dwl + j * 1024 + ch0 + 4);
                    y[jj][0] += w0.x * h0.x; y[jj][1] += w0.y * h0.y; y[jj][2] += w0.z * h0.z; y[jj][3] += w0.w * h0.w; y[jj][4] += w1.x * h1.x; y[jj][5] += w1.y * h1.y; y[jj][6] += w1.z * h1.z; y[jj][7] += w1.w * h1.w; }
            }
#pragma unroll
            for (int i = 0; i < 8; ++i) sm += y[jj][i];
            if (prompt) { if (t >= SEQ - 30) { float* op = out + O_CP + (((size_t)o * BP + b) * 30 + (t - (SEQ - 30))) * 1024 + ch0;
                    *(f32x4*)op = (f32x4){cur[0], cur[1], cur[2], cur[3]}; *(f32x4*)(op + 4) = (f32x4){cur[4], cur[5], cur[6], cur[7]}; } }
            else { float* ob = out + O_CS + ((size_t)o * BS + b) * 30 * 1024 + ch0;
                *(f32x4*)(ob + 29 * 1024) = (f32x4){cur[0], cur[1], cur[2], cur[3]}; *(f32x4*)(ob + 29 * 1024 + 4) = (f32x4){cur[4], cur[5], cur[6], cur[7]}; }
        }
        const float mu = wave_sum(sm) * (1.0f / 1024.f); float sq = 0.f;
#pragma unroll
        for (int jj = 0; jj < 2; ++jj)
#pragma unroll
            for (int i = 0; i < 8; ++i) { y[jj][i] -= mu; sq += y[jj][i] * y[jj][i]; }
        const float rstd = rsqrtf(wave_sum(sq) * (1.0f / 1024.f) + EPS);
#pragma unroll
        for (int jj = 0; jj < 2; ++jj) { const int ch0 = (lane + 64 * jj) * 8; float c[8];
#pragma unroll
            for (int i = 0; i < 8; ++i) c[i] = siluf_(y[jj][i] * rstd * lng[ch0 + i] + lnb[ch0 + i]);
            *(u32x4*)(cat + (size_t)m * 2048 + ch0) = pack8(c); }
          }
      else {
        const int b = task / GPS, gi = task - b * GPS, t0 = gi * 5, R = (SEQ - t0) < 5 ? (SEQ - t0) : 5, mbase = b * SEQ + t0;
        float y[2][5][8];
#pragma unroll
        for (int jj = 0; jj < 2; ++jj) { const int ch0 = (lane + 64 * jj) * 8; const f32x4 d0 = *(const f32x4*)(db + ch0), d1 = *(const f32x4*)(db + ch0 + 4);
#pragma unroll
            for (int r = 0; r < 5; ++r) { y[jj][r][0] = d0.x; y[jj][r][1] = d0.y; y[jj][r][2] = d0.z; y[jj][r][3] = d0.w; y[jj][r][4] = d1.x; y[jj][r][5] = d1.y; y[jj][r][6] = d1.z; y[jj][r][7] = d1.w; } }
#pragma unroll 1
        for (int bt = 0; bt < 5; ++bt) {
            u32x4 rg[2][7];
#pragma unroll
            for (int jj = 0; jj < 2; ++jj)
#pragma unroll
                for (int k = 0; k < 7; ++k) { const int rr = bt * 7 + k; const bool valid = (t0 - 30 + rr >= 0) && (rr < 30 + R);
                    const u32x4 v = *(const u32x4*)(glu + (size_t)(valid ? mbase - 30 + rr : mbase) * 1024 + (lane + 64 * jj) * 8); rg[jj][k] = valid ? v : (u32x4){0u, 0u, 0u, 0u}; }
#pragma unroll
            for (int jj = 0; jj < 2; ++jj) { const int ch0 = (lane + 64 * jj) * 8;
#pragma unroll
                for (int k = 0; k < 7; ++k) { const int rr = bt * 7 + k; float x[8]; unpack8(rg[jj][k], x);
#pragma unroll
                    for (int r = 0; r < 5; ++r) { const int j = rr - r; if (j >= 0 && j <= 30) {
                        const LAS float* wp = dwl + j * 1024 + ch0; const f32x4 w0 = *(const LAS f32x4*)wp, w1 = *(const LAS f32x4*)(wp + 4);
                        y[jj][r][0] += w0.x * x[0]; y[jj][r][1] += w0.y * x[1]; y[jj][r][2] += w0.z * x[2]; y[jj][r][3] += w0.w * x[3]; y[jj][r][4] += w1.x * x[4]; y[jj][r][5] += w1.y * x[5]; y[jj][r][6] += w1.z * x[6]; y[jj][r][7] += w1.w * x[7]; } } } }
        }
        if (t0 + R > SEQ - 30) {
#pragma unroll
            for (int jj = 0; jj < 2; ++jj) { const int ch0 = (lane + 64 * jj) * 8;
                for (int r = 0; r < R; ++r) if (t0 + r >= SEQ - 30) { float c8[8]; const u32x4 v = *(const u32x4*)(glu + (size_t)(mbase + r) * 1024 + ch0); unpack8(v, c8);
                    float* op = out + O_CP + (((size_t)o * BP + b) * 30 + (t0 + r - (SEQ - 30))) * 1024 + ch0;
                    *(f32x4*)op = (f32x4){c8[0], c8[1], c8[2], c8[3]}; *(f32x4*)(op + 4) = (f32x4){c8[4], c8[5], c8[6], c8[7]}; } } }
        float sm[5], sq[5];
#pragma unroll
        for (int r = 0; r < 5; ++r) { float a = 0.f;
#pragma unroll
            for (int jj = 0; jj < 2; ++jj)
#pragma unroll
                for (int i = 0; i < 8; ++i) a += y[jj][r][i];
            sm[r] = a; }
#pragma unroll
        for (int of = 1; of < 64; of <<= 1) {
#pragma unroll
            for (int r = 0; r < 5; ++r) sm[r] += __shfl_xor(sm[r], of); }
#pragma unroll
        for (int r = 0; r < 5; ++r) { const float mu = sm[r] * (1.0f / 1024.f); float a = 0.f;
#pragma unroll
            for (int jj = 0; jj < 2; ++jj)
#pragma unroll
                for (int i = 0; i < 8; ++i) { y[jj][r][i] -= mu; a += y[jj][r][i] * y[jj][r][i]; }
            sq[r] = a; }
#pragma unroll
        for (int of = 1; of < 64; of <<= 1) {
#pragma unroll
            for (int r = 0; r < 5; ++r) sq[r] += __shfl_xor(sq[r], of); }
#pragma unroll
        for (int jj = 0; jj < 2; ++jj) { const int ch0 = (lane + 64 * jj) * 8;
            const f32x4 g0 = *(const f32x4*)(lng + ch0), g1 = *(const f32x4*)(lng + ch0 + 4), b0 = *(const f32x4*)(lnb + ch0), b1 = *(const f32x4*)(lnb + ch0 + 4);
            const float gg[8] = {g0.x, g0.y, g0.z, g0.w, g1.x, g1.y, g1.z, g1.w}, bb[8] = {b0.x, b0.y, b0.z, b0.w, b1.x, b1.y, b1.z, b1.w};
#pragma unroll
            for (int r = 0; r < 5; ++r) if (r < R) { const float rstd = rsqrtf(sq[r] * (1.0f / 1024.f) + EPS); float c[8];
#pragma unroll
                for (int i = 0; i < 8; ++i) c[i] = siluf_(y[jj][r][i] * rstd * gg[i] + bb[i]);
                *(u32x4*)(cat + (size_t)(mbase + r) * 2048 + ch0) = pack8(c); } }
      }
    }
    asm volatile("" ::: "memory"); __builtin_amdgcn_sched_barrier(0);
    for (int task = gw; task < BP * GPS + BS; task += NGW) {
      if (task >= BP * GPS) {
        const int m = MPR + task - BP * GPS; const bool prompt = false; const int b = m - MPR, t = 0;
#pragma unroll
        for (int jj = 0; jj < 6; ++jj) {
            const int ch0 = (lane + 64 * jj) * 8; float a[8], cur[8];
#pragma unroll
            for (int i = 0; i < 8; ++i) a[i] = 0.f;
#pragma unroll
            for (int j = 0; j < 4; ++j) {
                float x[8]; bool have = true;
                if (j == 3 || prompt) { const int tt = t - 3 + j; if (tt >= 0) { const u32x4 r = *(const u32x4*)(qkv + (size_t)(m - 3 + j) * 3072 + ch0); unpack8(r, x); } else have = false; }
                else { const float* hp = sdn + ((size_t)b * 3 + j) * 3072 + ch0; const f32x4 h0 = *(const f32x4*)hp, h1 = *(const f32x4*)(hp + 4); x[0] = h0.x; x[1] = h0.y; x[2] = h0.z; x[3] = h0.w; x[4] = h1.x; x[5] = h1.y; x[6] = h1.z; x[7] = h1.w; }
                if (have) { const f32x4 w0 = *(const f32x4*)(cw + j * 3072 + ch0), w1 = *(const f32x4*)(cw + j * 3072 + ch0 + 4);
                    a[0] += w0.x * x[0]; a[1] += w0.y * x[1]; a[2] += w0.z * x[2]; a[3] += w0.w * x[3]; a[4] += w1.x * x[4]; a[5] += w1.y * x[5]; a[6] += w1.z * x[6]; a[7] += w1.w * x[7];
                    if (j == 3) {
#pragma unroll
                        for (int i = 0; i < 8; ++i) cur[i] = x[i]; } }
            }
            float ss = 0.f;
#pragma unroll
            for (int i = 0; i < 8; ++i) { a[i] = siluf_(a[i]); ss += a[i] * a[i]; }
            if (jj < 4) { ss = grp16_sum(ss); float r = rsqrtf(ss + EPS); if (jj < 2) r *= 0.08838834764831845f;
#pragma unroll
                for (int i = 0; i < 8; ++i) a[i] *= r; }
            *(u32x4*)(qkvc + (size_t)m * 3072 + ch0) = pack8(a);
            if (prompt) { if (t >= SEQ - 3) { float* op = out + O_DCP + (((size_t)o * BP + b) * 3 + (t - (SEQ - 3))) * 3072 + ch0;
                    *(f32x4*)op = (f32x4){cur[0], cur[1], cur[2], cur[3]}; *(f32x4*)(op + 4) = (f32x4){cur[4], cur[5], cur[6], cur[7]}; } }
            else { float* ob = out + O_DCS + ((size_t)o * BS + b) * 3 * 3072 + ch0;
                *(f32x4*)(ob + 2 * 3072) = (f32x4){cur[0], cur[1], cur[2], cur[3]}; *(f32x4*)(ob + 2 * 3072 + 4) = (f32x4){cur[4], cur[5], cur[6], cur[7]}; }
        }
        if (lane < 8) { const float av = AB[(size_t)m * 16 + lane] + dtb[lane], bv = AB[(size_t)m * 16 + 8 + lane];
            const float sp = av > 20.f ? av : log1pf(expf(av));
            Gg[(size_t)m * 8 + lane] = -expf(alog[lane]) * sp; Bt[(size_t)m * 8 + lane] = 1.0f / (1.0f + expf(-bv)); }
      }
      else {
        const int b = task / GPS, gi = task - b * GPS, t0 = gi * 5, R = (SEQ - t0) < 5 ? (SEQ - t0) : 5, mbase = b * SEQ + t0;
#pragma unroll 1
        for (int jj = 0; jj < 6; ++jj) {
            const int ch0 = (lane + 64 * jj) * 8;
            f32x4 w[4][2];
#pragma unroll
            for (int j = 0; j < 4; ++j) { w[j][0] = *(const f32x4*)(cw + j * 3072 + ch0); w[j][1] = *(const f32x4*)(cw + j * 3072 + ch0 + 4); }
            u32x4 rg[8];
#pragma unroll
            for (int rr = 0; rr < 8; ++rr) { const bool valid = (t0 - 3 + rr >= 0) && (rr < 3 + R);
                const u32x4 v = *(const u32x4*)(qkv + (size_t)(valid ? mbase - 3 + rr : mbase) * 3072 + ch0); rg[rr] = valid ? v : (u32x4){0u, 0u, 0u, 0u}; }
            float a[5][8];
#pragma unroll
            for (int r = 0; r < 5; ++r)
#pragma unroll
                for (int i = 0; i < 8; ++i) a[r][i] = 0.f;
#pragma unroll
            for (int rr = 0; rr < 8; ++rr) { float x[8]; unpack8(rg[rr], x);
#pragma unroll
                for (int r = 0; r < 5; ++r) { const int j = rr - r; if (j >= 0 && j <= 3) {
                    a[r][0] += w[j][0].x * x[0]; a[r][1] += w[j][0].y * x[1]; a[r][2] += w[j][0].z * x[2]; a[r][3] += w[j][0].w * x[3];
                    a[r][4] += w[j][1].x * x[4]; a[r][5] += w[j][1].y * x[5]; a[r][6] += w[j][1].z * x[6]; a[r][7] += w[j][1].w * x[7]; } } }
            float ss[5];
#pragma unroll
            for (int r = 0; r < 5; ++r) { float q = 0.f;
#pragma unroll
                for (int i = 0; i < 8; ++i) { a[r][i] = siluf_(a[r][i]); q += a[r][i] * a[r][i]; }
                ss[r] = q; }
            if (jj < 4) {
#pragma unroll
                for (int of = 1; of < 16; of <<= 1) {
#pragma unroll
                    for (int r = 0; r < 5; ++r) ss[r] += __shfl_xor(ss[r], of); }
#pragma unroll
                for (int r = 0; r < 5; ++r) { float sc = rsqrtf(ss[r] + EPS); if (jj < 2) sc *= 0.08838834764831845f;
#pragma unroll
                    for (int i = 0; i < 8; ++i) a[r][i] *= sc; } }
#pragma unroll
            for (int r = 0; r < 5; ++r) if (r < R) *(u32x4*)(qkvc + (size_t)(mbase + r) * 3072 + ch0) = pack8(a[r]);
            if (t0 + R > SEQ - 3) {
#pragma unroll
                for (int r = 0; r < 5; ++r) if (r < R && t0 + r >= SEQ - 3) { float c8[8]; unpack8(rg[r + 3], c8);
                    float* op = out + O_DCP + (((size_t)o * BP + b) * 3 + (t0 + r - (SEQ - 3))) * 3072 + ch0;
                    *(f32x4*)op = (f32x4){c8[0], c8[1], c8[2], c8[3]}; *(f32x4*)(op + 4) = (f32x4){c8[4], c8[5], c8[6], c8[7]}; } }
        }
        if (lane < 40) { const int r = lane >> 3, hh = lane & 7; if (r < R) { const int m = mbase + r;
            const float av = AB[(size_t)m * 16 + hh] + dtb[hh], bv = AB[(size_t)m * 16 + 8 + hh];
            const float sp = av > 20.f ? av : log1pf(expf(av));
            Gg[(size_t)m * 8 + hh] = -expf(alog[hh]) * sp; Bt[(size_t)m * 8 + hh] = 1.0f / (1.0f + expf(-bv)); } }
      }
    }
}

__device__ __forceinline__ void phase_dn_intra(const Ctx& cx, PP P, int o, LAS unsigned char* lds) {
    const int tid = cx.tid, lane = tid & 63, l15 = lane & 15, quad = lane >> 4;
    const int hb = __builtin_amdgcn_readfirstlane(tid >> 8), htid = tid & 255, hw = __builtin_amdgcn_readfirstlane((tid >> 6) & 3);
    const int G = cx.G;
    unsigned char* ws = P->ws;
    const bf16_t* qkvc = (const bf16_t*)(ws + WS_MIX); const float* Gg = (const float*)(ws + WS_G); const float* Bt = (const float*)(ws + WS_BETA);
    float* CU = (float*)(ws + WS_CU); bf16_t* CW = (bf16_t*)(ws + WS_CW); bf16_t* CQD = (bf16_t*)(ws + WS_CQD); bf16_t* CKDT = (bf16_t*)(ws + WS_CKDT); bf16_t* CQK = (bf16_t*)(ws + WS_CQK); float* CGL = (float*)(ws + WS_CGL);
    LAS float* L = (LAS float*)lds + hb * 4352; LAS float* gcs = L + 4096; LAS float* bet = L + 4096 + 64;
    for (int p = cx.bid; p < 512; p += G) {
        const int ci = 2 * p + hb, bh = ci >> 5, n = ci & 31, b = bh >> 3, h = bh & 7, m0 = b * SEQ + n * 64;
        if (hw == 0) { float g = Gg[(size_t)(m0 + lane) * 8 + h];
#pragma unroll
            for (int off = 1; off < 64; off <<= 1) { const float tv = __shfl_up(g, off); if (lane >= off) g += tv; }
            gcs[lane] = g; bet[lane] = Bt[(size_t)(m0 + lane) * 8 + h]; }
        __syncthreads();
        {
            const int mt = hw; const bf16_t* rp = qkvc + (size_t)(m0 + 16 * mt + l15) * 3072 + h * 128;
            bf16x8 ak[4], aq[4];
#pragma unroll
            for (int ks = 0; ks < 4; ++ks) { aq[ks] = *(const bf16x8*)(rp + ks * 32 + quad * 8); ak[ks] = *(const bf16x8*)(rp + 1024 + ks * 32 + quad * 8); }
#pragma unroll
            for (int nt = 0; nt < 4; ++nt) {
                f32x4 accK = (f32x4){0.f, 0.f, 0.f, 0.f}, accQ = (f32x4){0.f, 0.f, 0.f, 0.f};
                if (nt <= mt) { const bf16_t* bp = qkvc + (size_t)(m0 + 16 * nt + l15) * 3072 + 1024 + h * 128;
#pragma unroll
                    for (int ks = 0; ks < 4; ++ks) { const bf16x8 bk = *(const bf16x8*)(bp + ks * 32 + quad * 8);
                        accK = __builtin_amdgcn_mfma_f32_16x16x32_bf16(ak[ks], bk, accK, 0, 0, 0); accQ = __builtin_amdgcn_mfma_f32_16x16x32_bf16(aq[ks], bk, accQ, 0, 0, 0); } }
                const int j = 16 * nt + l15; const float gj = gcs[j];
#pragma unroll
                for (int jj = 0; jj < 4; ++jj) { const int i = 16 * mt + quad * 4 + jj; const float dec = (j <= i) ? __expf(gcs[i] - gj) : 0.f;
                    L[i * 64 + j] = (j < i) ? bet[i] * accK[jj] * dec : 0.f;
                    CQK[(size_t)ci * 4096 + i * 64 + j] = (bf16_t)(cvt_pk_bf16(accQ[jj] * dec, 0.f) & 0xffff); }
            }
        }
        __syncthreads();
        asm volatile("" ::: "memory"); __builtin_amdgcn_sched_barrier(0);
        {
            const int c = htid; float x[64];
            const bf16_t* vp = qkvc + (size_t)m0 * 3072 + (c < 128 ? 2048 + h * 128 + c : 1024 + h * 128 + (c - 128));
#pragma unroll
            for (int i = 0; i < 64; ++i) { const float r = bf1(*vp); vp += 3072; asm volatile("" : "+v"(vp)); const float sc = c < 128 ? bet[i] : bet[i] * __expf(gcs[i]); x[i] = r * sc; }
#pragma unroll
            for (int i = 1; i < 64; ++i) { float a0 = 0.f, a1 = 0.f, a2 = 0.f, a3 = 0.f;
#pragma unroll
                for (int j4 = 0; j4 < (i + 3) / 4; ++j4) { const f32x4 l = *(const LAS f32x4*)(L + i * 64 + j4 * 4);
                    a0 += l.x * x[j4 * 4 + 0]; if (j4 * 4 + 1 < i) a1 += l.y * x[j4 * 4 + 1]; if (j4 * 4 + 2 < i) a2 += l.z * x[j4 * 4 + 2]; if (j4 * 4 + 3 < i) a3 += l.w * x[j4 * 4 + 3];
                    if (j4 == 7) asm volatile("" ::: "memory"); }
                x[i] = x[i] - ((a0 + a1) + (a2 + a3)); asm volatile("" ::: "memory"); }
            if (c < 128) { float* up = CU + (size_t)ci * 8192 + c;
#pragma unroll
                for (int i = 0; i < 64; ++i) { *up = x[i]; up += 128; asm volatile("" : "+v"(up)); } }
            else { bf16_t* wp = CW + (size_t)ci * 8192 + (c - 128);
#pragma unroll
                for (int i = 0; i < 64; ++i) { *wp = (bf16_t)(cvt_pk_bf16(x[i], 0.f) & 0xffff); wp += 128; asm volatile("" : "+v"(wp)); } }
        }
        asm volatile("" ::: "memory"); __builtin_amdgcn_sched_barrier(0);
        {
            const float glast = gcs[63];
#pragma unroll
            for (int it = 0; it < 4; ++it) { const int idx = htid + 256 * it, i = idx >> 4, dq = idx & 15; float f[8];
                const u32x4 r = *(const u32x4*)(qkvc + (size_t)(m0 + i) * 3072 + h * 128 + dq * 8); unpack8(r, f); const float eg = __expf(gcs[i]);
#pragma unroll
                for (int k = 0; k < 8; ++k) f[k] *= eg;
                *(u32x4*)(CQD + (size_t)ci * 8192 + i * 128 + dq * 8) = pack8(f); }
#pragma unroll
            for (int it = 0; it < 4; ++it) { const int idx = htid + 256 * it, d = idx & 127, ig = idx >> 7; float f[8];
#pragma unroll
                for (int ii = 0; ii < 8; ++ii) { const int i = ig * 8 + ii; f[ii] = bf1(qkvc[(size_t)(m0 + i) * 3072 + 1024 + h * 128 + d]) * __expf(glast - gcs[i]); }
                *(u32x4*)(CKDT + (size_t)ci * 8192 + d * 64 + ig * 8) = pack8(f); }
            if (htid == 0) CGL[ci] = __expf(glast);
        }
        __syncthreads();
    }
}
__device__ __forceinline__ void phase_dn_sample(const Ctx& cx, PP P, int o, LAS unsigned char* lds) {
    const int tid = cx.tid; const int G = cx.G; unsigned char* ws = P->ws;
    const bf16_t* qkvc = (const bf16_t*)(ws + WS_MIX); const float* Gg = (const float*)(ws + WS_G); const float* Bt = (const float*)(ws + WS_BETA);
    const float* S0 = P->in[5] + (size_t)o * BS * 8 * 16384; float* Sout = P->out + O_SS + (size_t)o * BS * 8 * 16384; float* O = (float*)(ws + WS_O);
    LAS float* sq = (LAS float*)lds; LAS float* sk = sq + 128; LAS float* sv = sk + 128; LAS float* red = sv + 128;
    for (int task = cx.bid; task < BS * 8; task += G) {
        const int b = task >> 3, h = task & 7, m = MPR + b;
        if (tid < 384) { const int which = tid >> 7, d = tid & 127; sq[which * 128 + d] = bf1(qkvc[(size_t)m * 3072 + which * 1024 + h * 128 + d]); }
        __syncthreads();
        const int e = tid & 127, part = tid >> 7;
        const float* sp = S0 + (size_t)task * 16384 + (size_t)(part * 32) * 128 + e;
        float s[32]; float ks = 0.f, qs = 0.f, qk = 0.f;
#pragma unroll
        for (int d = 0; d < 32; ++d) { s[d] = *sp; sp += 128; asm volatile("" : "+v"(sp)); }
#pragma unroll
        for (int d = 0; d < 32; ++d) { ks += sk[part * 32 + d] * s[d]; qs += sq[part * 32 + d] * s[d]; }
        if (tid < 64) { const float pq = wave_sum(sq[tid] * sk[tid] + sq[tid + 64] * sk[tid + 64]); if (tid == 0) red[1024] = pq; }
        red[part * 128 + e] = ks; red[512 + part * 128 + e] = qs;
        __syncthreads();
        qk = red[1024];
        const float ksum = red[e] + red[128 + e] + red[256 + e] + red[384 + e], qsum = red[512 + e] + red[640 + e] + red[768 + e] + red[896 + e];
        const float g = Gg[(size_t)m * 8 + h], beta = Bt[(size_t)m * 8 + h], eg = __expf(g);
        const float vnew = beta * (sv[e] - eg * ksum);
        float* op = Sout + (size_t)task * 16384 + (size_t)(part * 32) * 128 + e;
#pragma unroll
        for (int d = 0; d < 32; ++d) { *op = eg * s[d] + sk[part * 32 + d] * vnew; op += 128; asm volatile("" : "+v"(op)); }
        if (part == 0) O[(size_t)m * 1024 + h * 128 + e] = eg * qsum + qk * vnew;
        __syncthreads();
    }
}

struct ScanOps { bf16x8 a1[4], a2[2], a3[2]; f32x4 u; float gl; };
__device__ __forceinline__ void scan_load(ScanOps& o, int ci, int w, int l15, int quad, int e0, const float* CU, const bf16_t* CW, const bf16_t* CQD, const bf16_t* CKDT, const bf16_t* CQK, const float* CGL) {
    const int mt = w & 3;
    { const bf16_t* ap = (w < 4 ? CW : CQD) + (size_t)ci * 8192 + (16 * mt + l15) * 128;
#pragma unroll
      for (int ks = 0; ks < 4; ++ks) o.a1[ks] = *(const bf16x8*)(ap + ks * 32 + quad * 8); }
    o.u = (f32x4){0.f, 0.f, 0.f, 0.f};
#pragma unroll
    for (int ks = 0; ks < 2; ++ks) o.a2[ks] = (bf16x8){0, 0, 0, 0, 0, 0, 0, 0};
    if (w < 4) {
#pragma unroll
        for (int j = 0; j < 4; ++j) o.u[j] = CU[(size_t)ci * 8192 + (16 * mt + quad * 4 + j) * 128 + e0 + l15]; }
    else { const bf16_t* qp = CQK + (size_t)ci * 4096 + (16 * mt + l15) * 64;
#pragma unroll
        for (int ks = 0; ks < 2; ++ks) o.a2[ks] = *(const bf16x8*)(qp + ks * 32 + quad * 8); }
    { const bf16_t* kp = CKDT + (size_t)ci * 8192 + (16 * w + l15) * 64;
#pragma unroll
      for (int ks = 0; ks < 2; ++ks) o.a3[ks] = *(const bf16x8*)(kp + ks * 32 + quad * 8); }
    o.gl = CGL[ci];
}
#define SCAN_BAR() do { asm volatile("s_waitcnt lgkmcnt(0)" ::: "memory"); __builtin_amdgcn_s_barrier(); asm volatile("" ::: "memory"); } while (0)
__device__ __forceinline__ void phase_dn_scan(const Ctx& cx, PP P, int o, LAS unsigned char* lds) {
    const int tid = cx.tid, lane = tid & 63, l15 = lane & 15, quad = lane >> 4, w = __builtin_amdgcn_readfirstlane(tid >> 6);
    const int G = cx.G;
    unsigned char* ws = P->ws;
    const float* CU = (const float*)(ws + WS_CU); const bf16_t* CW = (const bf16_t*)(ws + WS_CW); const bf16_t* CQD = (const bf16_t*)(ws + WS_CQD); const bf16_t* CKDT = (const bf16_t*)(ws + WS_CKDT); const bf16_t* CQK = (const bf16_t*)(ws + WS_CQK); const float* CGL = (const float*)(ws + WS_CGL);
    float* O = (float*)(ws + WS_O);
    LAS bf16_t* ST = (LAS bf16_t*)lds;
    LAS bf16_t* VT = ST + 16 * 136;
    for (int task0 = cx.bid; task0 < 256; task0 += G) {
        const int task = (G == 256) ? ((task0 & 7) * 32 + (task0 >> 3)) : task0;
        const int bh = task >> 3, es = task & 7, e0 = es * 16, b = bh >> 3, h = bh & 7;
        const int mt = w & 3;
        f32x4 S = (f32x4){0.f, 0.f, 0.f, 0.f};
        f32x4 oacc = (f32x4){0.f, 0.f, 0.f, 0.f};
        ScanOps cur, nxt;
        scan_load(cur, bh * 32, w, l15, quad, e0, CU, CW, CQD, CKDT, CQK, CGL);
        for (int n = 0; n < 32; ++n) {
            const int m0 = b * SEQ + n * 64;
            scan_load(nxt, bh * 32 + (n < 31 ? n + 1 : n), w, l15, quad, e0, CU, CW, CQD, CKDT, CQK, CGL);
            { u32x2 sw; sw.x = cvt_pk_bf16(S[0], S[1]); sw.y = cvt_pk_bf16(S[2], S[3]); *(LAS u32x2*)(ST + l15 * 136 + 16 * w + quad * 4) = sw; }
            SCAN_BAR();
            { f32x4 acc = (f32x4){0.f, 0.f, 0.f, 0.f};
#pragma unroll
              for (int ks = 0; ks < 4; ++ks) { const bf16x8 bs = *(const LAS bf16x8*)(ST + l15 * 136 + ks * 32 + quad * 8); acc = __builtin_amdgcn_mfma_f32_16x16x32_bf16(cur.a1[ks], bs, acc, 0, 0, 0); }
              if (w < 4) { const f32x4 vn = cur.u - acc; u32x2 vw; vw.x = cvt_pk_bf16(vn[0], vn[1]); vw.y = cvt_pk_bf16(vn[2], vn[3]); *(LAS u32x2*)(VT + l15 * 72 + 16 * mt + quad * 4) = vw; }
              else oacc = acc; }
            SCAN_BAR();
            bf16x8 bv[2];
#pragma unroll
            for (int ks = 0; ks < 2; ++ks) bv[ks] = *(const LAS bf16x8*)(VT + l15 * 72 + ks * 32 + quad * 8);
            if (w >= 4) {
#pragma unroll
                for (int ks = 0; ks < 2; ++ks) oacc = __builtin_amdgcn_mfma_f32_16x16x32_bf16(cur.a2[ks], bv[ks], oacc, 0, 0, 0);
#pragma unroll
                for (int j = 0; j < 4; ++j) O[(size_t)(m0 + 16 * mt + quad * 4 + j) * 1024 + h * 128 + e0 + l15] = oacc[j]; }
            S = S * cur.gl;
#pragma unroll
            for (int ks = 0; ks < 2; ++ks) S = __builtin_amdgcn_mfma_f32_16x16x32_bf16(cur.a3[ks], bv[ks], S, 0, 0, 0);
            cur = nxt;
        }
        float* sp = P->out + O_SP + (((size_t)o * BP + b) * 8 + h) * 16384;
#pragma unroll
        for (int j = 0; j < 4; ++j) sp[(size_t)(16 * w + quad * 4 + j) * 128 + e0 + l15] = S[j];
        __syncthreads();
    }
}

__device__ __forceinline__ void phase_dn_gate(const Ctx& cx, PP P, int o) {
    const int tid = cx.tid, lane = tid & 63, wave = __builtin_amdgcn_readfirstlane(tid >> 6);
    const int gw = cx.bid * NWAVES + wave, NGW = cx.G * NWAVES;
    const float* O = (const float*)(P->ws + WS_O); const bf16_t* zg = (const bf16_t*)(P->ws + WS_ZG); bf16_t* cat = (bf16_t*)(P->ws + WS_CAT);
    const float* ng = P->in[25] + o * 128;
    for (int m = gw; m < MT; m += NGW) {
#pragma unroll
        for (int jj = 0; jj < 2; ++jj) { const int ch0 = (lane + 64 * jj) * 8; const f32x4 o0 = *(const f32x4*)(O + (size_t)m * 1024 + ch0), o1 = *(const f32x4*)(O + (size_t)m * 1024 + ch0 + 4);
            float f[8] = {o0.x, o0.y, o0.z, o0.w, o1.x, o1.y, o1.z, o1.w}; float ss = 0.f;
#pragma unroll
            for (int i = 0; i < 8; ++i) ss += f[i] * f[i];
            const float rs = rsqrtf(grp16_sum(ss) * (1.0f / 128.f) + EPS);
            float z[8]; const u32x4 r = *(const u32x4*)(zg + (size_t)m * 1024 + ch0); unpack8(r, z);
#pragma unroll
            for (int i = 0; i < 8; ++i) f[i] = f[i] * rs * ng[(ch0 & 127) + i] * siluf_(z[i]);
            *(u32x4*)(cat + (size_t)m * 2048 + 1024 + ch0) = pack8(f); }
    }
}

#define XB_TMO      128
#define XB_XCNT(j)  (256  + 64 * (j))
#define XB_XSUB(j)  (1280 + 64 * (j))
#define XB_XGEN(j)  (2304 + 64 * (j))
#define XB_TOP      3328
#define XB_TOPGEN   3392
#define XCD_BAR_WORDS 3456
#define XB_SPIN_CAP (1u << 20)
__device__ __forceinline__ unsigned xb_ld(unsigned* p)              { return __hip_atomic_load(p, __ATOMIC_RELAXED, __HIP_MEMORY_SCOPE_AGENT); }
__device__ __forceinline__ unsigned xb_add(unsigned* p, unsigned v) { return __hip_atomic_fetch_add(p, v, __ATOMIC_RELAXED, __HIP_MEMORY_SCOPE_AGENT); }
__device__ __forceinline__ unsigned xb_xcc_id() { return (unsigned)__builtin_amdgcn_s_getreg((3 << 11) | 20) & 0xFu; }
#define XB_SPIN(cond, bar) do { unsigned _sp = 0; while (cond) { __builtin_amdgcn_s_sleep(1); \
    if ((++_sp & 255u) == 0u) { if (xb_ld(&(bar)[XB_TMO])) break; if (_sp > XB_SPIN_CAP) { atomicAdd(&(bar)[XB_TMO], 1u); break; } } } } while (0)
struct XcdBarrier { unsigned* bar; unsigned x; volatile LAS unsigned* st; };
__device__ __forceinline__ XcdBarrier xcd_barrier_post(unsigned* bar, volatile LAS unsigned* st) {
    XcdBarrier b; b.bar = bar; b.x = xb_xcc_id(); b.st = st;
    if (threadIdx.x == 0) (void)xb_add(&bar[XB_XCNT(b.x)], 1u);
    return b;
}
__device__ __forceinline__ void xcd_barrier_complete(unsigned* bar, unsigned x, unsigned& nloc, unsigned& nx) {
    const unsigned G = gridDim.x * gridDim.y * gridDim.z;
    unsigned sum, cnt, mine, sp = 0u;
    for (;;) {
        sum = 0u; cnt = 0u; mine = 0u;
#pragma unroll
        for (unsigned j = 0; j < 16; ++j) { const unsigned c = xb_ld(&bar[XB_XCNT(j)]); sum += c; cnt += (c > 0u) ? 1u : 0u; mine = (j == x) ? c : mine; }
        if (sum == G) break;
        __builtin_amdgcn_s_sleep(1);
        if ((++sp & 255u) == 0u) { if (xb_ld(&bar[XB_TMO])) break; if (sp > XB_SPIN_CAP) { atomicAdd(&bar[XB_TMO], 1u); break; } }
    }
    nloc = mine > 0u ? mine : 1u; nx = cnt > 0u ? cnt : 1u;
}
__device__ __forceinline__ void xcd_barrier(const XcdBarrier& b) {
    asm volatile("s_waitcnt vmcnt(0)" ::: "memory");
    __syncthreads();
    if (threadIdx.x == 0) {
        unsigned* bar = b.bar;
        __builtin_amdgcn_s_waitcnt(0);
        unsigned nloc = b.st[0], nx = b.st[1];
        if (nloc == 0u) { xcd_barrier_complete(bar, b.x, nloc, nx); b.st[0] = nloc; b.st[1] = nx; }
        const unsigned old = xb_add(&bar[XB_XSUB(b.x)], 1u);
        const unsigned gen = old / nloc;
        if (old + 1u == (gen + 1u) * nloc) {
            __builtin_amdgcn_fence(__ATOMIC_RELEASE, "agent");
            asm volatile("s_waitcnt vmcnt(0)" ::: "memory");
            const unsigned og = xb_add(&bar[XB_TOP], 1u);
            const unsigned tg = og / nx;
            if (og + 1u == (tg + 1u) * nx) xb_add(&bar[XB_TOPGEN], 1u);
            else XB_SPIN(xb_ld(&bar[XB_TOPGEN]) == tg, bar);
            __builtin_amdgcn_fence(__ATOMIC_ACQUIRE, "agent");
            xb_add(&bar[XB_XGEN(b.x)], 1u);
            asm volatile("s_waitcnt vmcnt(0)" ::: "memory");
        } else {
            XB_SPIN(xb_ld(&bar[XB_XGEN(b.x)]) == gen, bar);
            __builtin_amdgcn_fence(__ATOMIC_ACQUIRE, "agent");
            asm volatile("s_waitcnt vmcnt(0)" ::: "memory");
        }
    }
    __syncthreads();
}

__device__ __forceinline__ void copy_rows_shift(const Ctx& cx, const float* src, float* dst, int nb, int rows_in, int rows_copy, int width4) {
    const int per_b = rows_copy * width4, total = nb * per_b;
    for (int i = (cx.G - 1 - cx.bid) * NTHR + cx.tid; i < total; i += cx.G * NTHR) { const int b = i / per_b, r = i - b * per_b;
        ((f32x4*)dst)[(size_t)b * rows_in * width4 + r] = ((const f32x4*)src)[(size_t)b * rows_in * width4 + width4 + r]; }
}
constexpr int NPHASES = 1 + 8 + 10 + 8 + 10 + 1;
__global__ void __launch_bounds__(NTHR, 2) mega_fwd(Params Pin) {
    extern __shared__ __attribute__((aligned(16))) unsigned char lds_raw[];
    LAS unsigned char* lds = (LAS unsigned char*)lds_raw;
    const __attribute__((address_space(4))) unsigned char* kp = (const __attribute__((address_space(4))) unsigned char*)__builtin_amdgcn_kernarg_segment_ptr();
    constexpr int nM = MPAD / 256;
    volatile LAS unsigned* bst = (volatile LAS unsigned*)(lds + 131072);
    if (threadIdx.x < 2) bst[threadIdx.x] = 0u;
    __syncthreads();
    XcdBarrier gbar; gbar.bar = nullptr; gbar.x = 0; gbar.st = bst;
    if (((PP)kp)->coop) gbar = xcd_barrier_post((unsigned*)(((PP)kp)->ws + WS_BAR), bst);
    const int ph_lo = ((PP)kp)->ph_lo, ph_hi = ((PP)kp)->ph_hi;
#ifdef EXTRA_SYNCS
    for (int i = 0; i < EXTRA_SYNCS; ++i) xcd_barrier(gbar);
#endif
    int did_rep = 0;
    for (int ph = ph_lo; ph < ph_hi; ++ph) {
        asm volatile("" : "+s"(kp));
        Ctx cx; cx.tid = threadIdx.x; cx.bid = blockIdx.x; cx.G = gridDim.x;
        asm volatile("" : "+v"(cx.tid)); asm volatile("" : "+s"(cx.bid)); asm volatile("" : "+s"(cx.G));
        PP P = (PP)kp;
        unsigned char* ws = P->ws;
        float* X = (float*)(ws + WS_X); bf16_t* H = (bf16_t*)(ws + WS_H); bf16_t* ACT = (bf16_t*)(ws + WS_ACT); bf16_t* CAT = (bf16_t*)(ws + WS_CAT);
        float* PX = (float*)(ws + WS_PARTX);
        int l, op;
        if (ph == 0) { l = 0; op = 10; }
        else if (ph == NPHASES - 1) { l = 0; op = 11; }
        else { int r = ph - 1; const int pair = r / 18; r %= 18;
            if (r < 8) { l = 2 * pair; op = r < 4 ? r : r + 2; }
            else { l = 2 * pair + 1; op = r - 8; } }
        const bool even = (l & 1) == 0; const int e = l >> 1;
#ifndef OPMASK
#define OPMASK 0xfff
#endif
#ifndef REPMASK
#define REPMASK 0
#endif
        if (!(((OPMASK) >> op) & 1)) continue;
        const bool dry = REPMASK && ((REPMASK >> op) & 1) && !did_rep;
        switch (op) {
        case 10: phase_prep(cx, P, lds); phase_first_norm(cx, P, X, P->in[6], H); break;
        case 11: phase_rmsnorm<true>(cx, X, P->in[8], nullptr, P->out + O_YP, PX, 44, dry, lds); break;
        case 0: if (l > 0) phase_rmsnorm<false>(cx, X, P->in[6] + (size_t)l * D, H, nullptr, PX, l > 0 ? 44 : 0, dry, lds); break;
        case 7: phase_rmsnorm<false>(cx, X, P->in[7] + (size_t)l * D, H, nullptr, PX, 16, dry, lds); break;
        case 1:
            if (even) { pg8::StaticSched S; S.init(cx, H, (bf16_t*)(ws + WS_WEVIN) + (size_t)e * EV_IN * 2048, 2048, 2048, nM, EV_IN / 256, 2048, 0);
                pg8::EpiEvenIn E{(bf16_t*)(ws + WS_ABUF), (bf16_t*)(ws + WS_UV)}; pg8::gemm_phase(cx, lds, S, E);
                copy_rows_shift(cx, P->in[2] + (size_t)e * BS * 15 * 1024, P->out + O_PS + (size_t)e * BS * 15 * 1024, BS, 15, 14, 256);
                if (l == 0) convert_slot(cx, P, lds, 1, 0, DEF1_A, 140, 116); else convert_slot(cx, P, lds, 3, 0, DEF3_A, 140, 116); }
            else { pg8::StaticSched S; S.init(cx, H, (bf16_t*)(ws + WS_WODIN) + (size_t)e * OD_INM * 2048, 2048, 2048, nM, OD_INM / 256, 2048, 0);
                pg8::EpiOddIn E{(bf16_t*)(ws + WS_ABUF), (bf16_t*)(ws + WS_UV), (bf16_t*)(ws + WS_ZG)}; pg8::gemm_phase(cx, lds, S, E);
                phase_ab(cx, P, e);
                copy_rows_shift(cx, P->in[3] + (size_t)e * BS * 30 * 1024, P->out + O_CS + (size_t)e * BS * 30 * 1024, BS, 30, 29, 256);
                copy_rows_shift(cx, P->in[4] + (size_t)e * BS * 3 * 3072, P->out + O_DCS + (size_t)e * BS * 3 * 3072, BS, 3, 2, 768);
                if (l == 1) convert_slot(cx, P, lds, 2, 0, DEF2_A, 24, 166); }
            break;
        case 2: if (even) phase_even_prep(cx, P, e); else phase_odd_prep(cx, P, e, lds); break;
        case 3:
            if (even) {
#ifndef DBG_NO_POOL
                pg8::StaticSched S; S.init(cx, ws + WS_MIX, (bf16_t*)(ws + WS_WPOOL) + (size_t)e * 1024 * 256, 1024, 256, nM, 4, 256, 512);
                pg8::EpiPool E{CAT, P->in[11] + e * 1024}; pg8::gemm_phase(cx, lds, S, E);
                __syncthreads();
#endif
#ifndef DBG_NO_SGU
                phase_sgu(cx, P, e, lds);
#endif
            }
#ifndef DBG_NO_DNI
            else phase_dn_intra(cx, P, e, lds);
#endif
            break;
        case 4: phase_dn_sample(cx, P, e, lds); __syncthreads(); phase_dn_scan(cx, P, e, lds); break;
        case 5: phase_dn_gate(cx, P, e); break;
        case 6: { const bf16_t* Wt = (even ? (bf16_t*)(ws + WS_WEVOUT) : (bf16_t*)(ws + WS_WODOUT)) + (size_t)e * 2048 * 2048;
                pg8::ResidSched S; S.init(cx, CAT, Wt, 2048, 2048); pg8::EpiResidX E{{X, dry}, {PX, dry}}; pg8::gemm_phase(cx, lds, S, E); } break;
        case 8: { pg8::StaticSched S; S.init(cx, H, (bf16_t*)(ws + WS_WUP) + (size_t)l * 2 * DFF * 2048, 2048, 2048, nM, 2 * DFF / 256, 2048, 0);
                pg8::EpiUp E{ACT}; pg8::gemm_phase(cx, lds, S, E);
                if (l == 0) convert_slot(cx, P, lds, 1, DEF1_A, DEF1_B, 172, 84); else if (l == 1) convert_slot(cx, P, lds, 2, DEF2_A, DEF2_B, 172, 84); else if (l == 2) convert_slot(cx, P, lds, 3, DEF3_A, DEF3_B, 172, 84); } break;
        case 9: { const bf16_t* Wt = (bf16_t*)(ws + WS_WDOWN) + (size_t)l * 2048 * DFF;
                pg8::ResidSched S; S.init(cx, ACT, Wt, DFF, DFF); pg8::EpiResidX E{{X, dry}, {PX, dry}}; pg8::gemm_phase(cx, lds, S, E); } break;
        default: break;
        }
        if (REPMASK) { if (((REPMASK >> op) & 1) && !did_rep) { did_rep = 1; --ph; } else did_rep = 0; }
        if (ph + 1 < ph_hi && !(op == 0 && l == 0)) { if (P->coop) { if (ph == 0) cg::this_grid().sync(); else xcd_barrier(gbar); } }
    }
}

#ifndef MK_COOP
#define MK_COOP 1
#endif
extern "C" void kernel_launch(void* const* d_in, const int* in_sizes, int n_in, void* d_out, int out_size, void* d_ws, size_t ws_size, hipStream_t stream) {
    static int grid = 0;
    if (grid == 0) {
        if (n_in != 29 || (size_t)out_size != O_END || ws_size < WS_END) { fprintf(stderr, "kernel_launch: unexpected shapes n_in %d out %d ws %zu (need %zu)\n", n_in, out_size, ws_size, (size_t)WS_END); grid = -1; return; }
        int dev = 0, cus = 0, per_cu = 0;
        hipGetDevice(&dev); hipDeviceGetAttribute(&cus, hipDeviceAttributeMultiprocessorCount, dev);
        if (hipFuncSetAttribute((const void*)mega_fwd, hipFuncAttributeMaxDynamicSharedMemorySize, LDS_BYTES) != hipSuccess) { fprintf(stderr, "kernel_launch: hipFuncSetAttribute failed\n"); grid = -1; return; }
        if (hipOccupancyMaxActiveBlocksPerMultiprocessor(&per_cu, (const void*)mega_fwd, NTHR, LDS_BYTES) != hipSuccess || per_cu < 1) { fprintf(stderr, "kernel_launch: occupancy query says %d\n", per_cu); per_cu = 1; }
        (void)hipGetLastError();
        grid = cus < 256 ? cus : 256;
        if (grid <= 0) grid = 256;
    }
    if (grid < 0) return;
    Params p{};
    for (int i = 0; i < 29; ++i) p.in[i] = (const float*)d_in[i];
    p.out = (float*)d_out; p.ws = (unsigned char*)d_ws; p.pad = 0;
#if MK_COOP
    p.ph_lo = 0; p.ph_hi = NPHASES; p.coop = 1;
    if (hipMemsetAsync((char*)d_ws + WS_BAR, 0, WS_BAR_BYTES, stream) != hipSuccess) { fprintf(stderr, "kernel_launch: memset of barrier words failed\n"); return; }
    void* args[] = {&p};
    hipError_t e = hipLaunchCooperativeKernel((const void*)mega_fwd, dim3(grid), dim3(NTHR), args, LDS_BYTES, stream);
    if (e != hipSuccess) fprintf(stderr, "cooperative launch failed: %s (grid %d)\n", hipGetErrorString(e), grid);
#else
    p.coop = 0;
    for (int ph = 0; ph < NPHASES; ++ph) { p.ph_lo = ph; p.ph_hi = ph + 1; hipLaunchKernelGGL(mega_fwd, dim3(grid), dim3(NTHR), LDS_BYTES, stream, p); }
#endif
}
```

```cpp
#include <hip/hip_runtime.h>
#include <hip/hip_cooperative_groups.h>
#include <cstdio>
namespace cg = cooperative_groups;

#define LAS __attribute__((address_space(3)))
typedef unsigned short bf16_t;
typedef short bf16x8 __attribute__((ext_vector_type(8)));
typedef float f32x4 __attribute__((ext_vector_type(4)));
typedef float f32x2 __attribute__((ext_vector_type(2)));
typedef unsigned u32x4 __attribute__((ext_vector_type(4)));
typedef unsigned u32x2 __attribute__((ext_vector_type(2)));

constexpr int D = 2048, SEQ = 2048, BP = 4, MPR = BP * SEQ, BS = 128, MT = MPR + BS, MPAD = 8448;
constexpr int DFF = 5632, EV_IN = 3072, OD_IN = 6160, OD_INM = 6144;
constexpr float EPS = 1e-6f;
constexpr int NTHR = 512, NWAVES = 8;
constexpr int LDS_BYTES = 131072 + 1024;

constexpr size_t O_YP = 0;
constexpr size_t O_YS = O_YP + (size_t)MPR * D;
constexpr size_t O_PP = O_YS + (size_t)BS * D;
constexpr size_t O_PS = O_PP + (size_t)2 * BP * 15 * 1024;
constexpr size_t O_SV = O_PS + (size_t)2 * BS * 15 * 1024;
constexpr size_t O_CP = O_SV + (size_t)2 * BS * 1024;
constexpr size_t O_CS = O_CP + (size_t)2 * BP * 30 * 1024;
constexpr size_t O_DCP = O_CS + (size_t)2 * BS * 30 * 1024;
constexpr size_t O_DCS = O_DCP + (size_t)2 * BP * 3 * 3072;
constexpr size_t O_SP = O_DCS + (size_t)2 * BS * 3 * 3072;
constexpr size_t O_SS = O_SP + (size_t)2 * BP * 8 * 128 * 128;
constexpr size_t O_END = O_SS + (size_t)2 * BS * 8 * 128 * 128;

constexpr size_t al(size_t x) { return (x + 4095) & ~(size_t)4095; }
constexpr size_t WS_X = 0;
constexpr size_t WS_H = WS_X + al((size_t)MPAD * D * 4);
constexpr size_t WS_ACT = WS_H + al((size_t)MPAD * D * 2);
constexpr size_t WS_CAT = WS_ACT + al((size_t)MPAD * DFF * 2);
constexpr size_t WS_ABUF = WS_CAT + al((size_t)MPAD * D * 2);
constexpr size_t WS_UV = WS_ABUF + al((size_t)MPAD * 1024 * 2);
constexpr size_t WS_ZG = WS_UV + al((size_t)MPAD * 3072 * 2);
constexpr size_t WS_MIX = WS_ZG + al((size_t)MPAD * 1024 * 2);
constexpr size_t WS_VN = WS_MIX + al((size_t)MPAD * 3072 * 2);
constexpr size_t WS_AB = WS_VN + al((size_t)MPAD * 1024 * 2);
constexpr size_t WS_G = WS_AB + al((size_t)MPAD * 16 * 4);
constexpr size_t WS_BETA = WS_G + al((size_t)MPAD * 8 * 4);
constexpr size_t WS_O = WS_BETA + al((size_t)MPAD * 8 * 4);
constexpr size_t WS_CU = WS_O + al((size_t)MPAD * 1024 * 4);
constexpr size_t WS_CW = WS_CU + al((size_t)1024 * 8192 * 4);
constexpr size_t WS_CQD = WS_CW + al((size_t)1024 * 8192 * 2);
constexpr size_t WS_CKDT = WS_CQD + al((size_t)1024 * 8192 * 2);
constexpr size_t WS_CQK = WS_CKDT + al((size_t)1024 * 8192 * 2);
constexpr size_t WS_CGL = WS_CQK + al((size_t)1024 * 4096 * 2);
constexpr size_t WS_WEVIN = WS_CGL + al(4096);
constexpr size_t WS_WEVOUT = WS_WEVIN + al((size_t)2 * 3072 * 2048 * 2);
constexpr size_t WS_WODIN = WS_WEVOUT + al((size_t)2 * 2048 * 2048 * 2);
constexpr size_t WS_WODOUT = WS_WODIN + al((size_t)2 * 6144 * 2048 * 2);
constexpr size_t WS_WUP = WS_WODOUT + al((size_t)2 * 2048 * 2048 * 2);
constexpr size_t WS_WDOWN = WS_WUP + al((size_t)4 * 11264 * 2048 * 2);
constexpr size_t WS_WPOOL = WS_WDOWN + al((size_t)4 * 2048 * 5632 * 2);
constexpr size_t WS_PARTX = WS_WPOOL + al((size_t)2 * 1024 * 256 * 2);
constexpr size_t WS_WAB = WS_PARTX + al((size_t)256 * 32768 * 4);
constexpr size_t WS_BAR = WS_WAB + al((size_t)2 * 16 * 2048 * 2);
constexpr size_t WS_BAR_BYTES = 16384;
constexpr size_t WS_END = WS_BAR + WS_BAR_BYTES;

struct Params { const float* in[29]; float* out; unsigned char* ws; int ph_lo, ph_hi, coop, pad; };
typedef const __attribute__((address_space(4))) Params* PP;
struct Ctx { int tid, bid, G; };

__device__ __forceinline__ unsigned cvt_pk_bf16(float lo, float hi) { unsigned r; asm volatile("v_cvt_pk_bf16_f32 %0, %1, %2" : "=v"(r) : "v"(lo), "v"(hi)); return r; }
__device__ __forceinline__ float bf_lo(unsigned w) { return __uint_as_float(w << 16); }
__device__ __forceinline__ float bf_hi(unsigned w) { return __uint_as_float(w & 0xffff0000u); }
__device__ __forceinline__ float bf1(bf16_t h) { return __uint_as_float(((unsigned)h) << 16); }
__device__ __forceinline__ void unpack8(const u32x4 w, float (&f)[8]) { f[0] = bf_lo(w.x); f[1] = bf_hi(w.x); f[2] = bf_lo(w.y); f[3] = bf_hi(w.y); f[4] = bf_lo(w.z); f[5] = bf_hi(w.z); f[6] = bf_lo(w.w); f[7] = bf_hi(w.w); }
__device__ __forceinline__ u32x4 pack8(const float (&f)[8]) { u32x4 w; w.x = cvt_pk_bf16(f[0], f[1]); w.y = cvt_pk_bf16(f[2], f[3]); w.z = cvt_pk_bf16(f[4], f[5]); w.w = cvt_pk_bf16(f[6], f[7]); return w; }
__device__ __forceinline__ float sigmoidf_(float x) { return __builtin_amdgcn_rcpf(1.0f + __expf(-x)); }
__device__ __forceinline__ float siluf_(float x) { return x * sigmoidf_(x); }
__device__ __forceinline__ float wave_sum(float v) {
#pragma unroll
    for (int o = 1; o < 64; o <<= 1) v += __shfl_xor(v, o);
    return v;
}
__device__ __forceinline__ float grp16_sum(float v) {
#pragma unroll
    for (int o = 1; o < 16; o <<= 1) v += __shfl_xor(v, o);
    return v;
}
__device__ __forceinline__ f32x2 gelu_pk(f32x2 v) {
    const f32x2 av = __builtin_elementwise_abs(v), d = av * 0.2316418882f + 1.0f;
    f32x2 t; t.x = __builtin_amdgcn_rcpf(d.x); t.y = __builtin_amdgcn_rcpf(d.y);
    f32x2 q = t * 0.5307027145f + (-0.7265760135f); q = q * t + 0.7107068705f; q = q * t + (-0.142248368f); q = q * t + 0.127414796f; q = q * t;
    const f32x2 s = (v * v) * (-0.72134752044f);
    f32x2 e; e.x = __builtin_amdgcn_exp2f(s.x); e.y = __builtin_amdgcn_exp2f(s.y);
    const f32x2 m = v * (q * e), r = v - m;
    f32x2 o; o.x = v.x < 0.f ? m.x : r.x; o.y = v.y < 0.f ? m.y : r.y; return o;
}

namespace pg8 {
constexpr int BM = 256, BK = 64, HALF = 128, HTB = HALF * BK * 2, STAGE_BYTES = 8 * HTB, NXCD = 8, WGM = 8;
__device__ __forceinline__ int lds_byte(int r, int c) { const int st = (r >> 4) * 2 + (c >> 5), rr = r & 15, cc = c & 31, ob = rr * 64 + cc * 2; return st * 1024 + (ob ^ (((ob >> 9) & 1) << 5)); }
__device__ __forceinline__ void stage_rc(int b, int& R, int& C) { const int st = b / 1024, sb = b % 1024, swz = sb ^ (((sb >> 9) & 1) << 5); R = (st >> 1) * 16 + swz / 64; C = (st & 1) * 32 + (swz % 64) / 2; }
__device__ __forceinline__ int perm32(int rho) { const int n = rho >> 4, i = rho & 15; return 8 * (i >> 2) + 4 * n + (i & 3); }

struct Unit { int pm, pn, nt, pad; const char* A; const char* B; };

__device__ __forceinline__ void unit_pmpn(int wgid, int nM, int nN, int& pm, int& pn) {
    const int nig = WGM * nN, gid = wgid / nig, fm = gid * WGM, gsz = (nM - fm) < WGM ? (nM - fm) : WGM;
    pm = fm + ((wgid % nig) % gsz); pn = (wgid % nig) / gsz;
}
struct StaticSched {
    const char* A; const char* B; int lda, ldb, nM, nN, nwg, G, c, nt; size_t a_pn_stride;
    __device__ __forceinline__ void init(const Ctx& cx, const void* A_, const void* B_, int lda_, int ldb_, int nM_, int nN_, int K, size_t apn) {
        A = (const char*)A_; B = (const char*)B_; lda = lda_; ldb = ldb_; nM = nM_; nN = nN_; nwg = nM * nN; G = cx.G; c = cx.bid; nt = K / BK; a_pn_stride = apn; }
    __device__ __forceinline__ bool next(int i, Unit& u) const {
        const long L = (long)i * G + c; if (L >= nwg) return false;
        int wgid = (int)L; { const int q = nwg / NXCD, r = nwg % NXCD, xcd = wgid % NXCD, off = wgid / NXCD; wgid = (xcd < r ? xcd * (q + 1) : r * (q + 1) + (xcd - r) * q) + off; }
        unit_pmpn(wgid, nM, nN, u.pm, u.pn); u.nt = nt; u.pad = 0;
        u.A = A + (size_t)u.pm * BM * lda * 2 + (size_t)u.pn * a_pn_stride; u.B = B + (size_t)u.pn * BM * ldb * 2; return true;
    }
};
struct StreamKSched {
    const char* A; const char* B; int lda, ldb, pm_base, nN, ppu, p0, p1, u0, vc;
    __device__ __forceinline__ void init(const Ctx& cx, const void* A_, const void* B_, int lda_, int ldb_, int pm_base_, int nN_, int K) {
        A = (const char*)A_; B = (const char*)B_; lda = lda_; ldb = ldb_; pm_base = pm_base_; nN = nN_; ppu = K / (2 * BK);
        const int G = cx.G, bx = cx.bid; vc = (G % 8 == 0) ? (bx % 8) * (G / 8) + bx / 8 : bx;
        const long P = (long)nN * ppu; p0 = (int)((vc * P) / G); p1 = (int)(((vc + 1) * P) / G); u0 = p0 / ppu; }
    __device__ __forceinline__ bool next(int i, Unit& u) const {
        const int ui = u0 + i; const long lo = (long)ui * ppu; if (lo >= p1) return false;
        const int s = (int)(lo > p0 ? lo : p0), e = (int)((lo + ppu) < p1 ? (lo + ppu) : p1);
        u.pm = pm_base; u.pn = ui; u.nt = 2 * (e - s); u.pad = vc;
        const size_t koff = (size_t)(s - (int)lo) * 2 * BK * 2;
        u.A = A + (size_t)u.pm * BM * lda * 2 + koff; u.B = B + (size_t)u.pn * BM * ldb * 2 + koff; return true;
    }
};

struct ResidSched {
    StaticSched a; StreamKSched b; int na, lda, ldb;
    __device__ __forceinline__ void init(const Ctx& cx, const void* A_, const void* B_, int ld, int K) {
        a.init(cx, A_, B_, ld, ld, MPR / 256, 8, K, 0); b.init(cx, A_, B_, ld, ld, MPR / 256, 8, K); lda = ld; ldb = ld;
        na = (a.nwg - a.c + a.G - 1) / a.G; if (na < 0) na = 0; }
    __device__ __forceinline__ bool next(int i, Unit& u) const { if (i < na) return a.next(i, u); return b.next(i - na, u); }
};
template <class Epi, class Sched>
__device__ __forceinline__ void gemm_phase(const Ctx& cx, LAS unsigned char* lds, const Sched& S, const Epi& E) {
    const int tid = cx.tid, wid = __builtin_amdgcn_readfirstlane(tid >> 6), lane = tid & 63, wr = wid >> 2, wc = wid & 3, fr = lane & 15, fq = lane >> 4;
    const int lda = S.lda, ldb = S.ldb;
    unsigned voffA[2], voffB[2];
#pragma unroll
    for (int i = 0; i < 2; ++i) { int R, C; stage_rc(tid * 16 + i * 8192, R, C); const int Rb = Epi::PERM ? ((R & ~31) + perm32(R & 31)) : R;
        voffA[i] = (unsigned)(R * lda + C) * 2u; voffB[i] = (unsigned)(Rb * ldb + C) * 2u; }
    const size_t kstep = (size_t)(BK * 2);
    const size_t hstepA = (size_t)HALF * lda * 2, hstepB = (size_t)HALF * ldb * 2;
    const unsigned ldsw = (unsigned)wid * 1024u;
    const int aoff = lds_byte(wr * 64 + fr, fq * 8), boff = lds_byte(wc * 32 + fr, fq * 8);
#define PG8_SA(b, h) (((b) * 2 + (h)) * HTB)
#define PG8_SB(b, h) ((4 + (b) * 2 + (h)) * HTB)
#define PG8_STAGE(bufoff, gbase, voff) do { _Pragma("unroll") for (int _i = 0; _i < 2; ++_i) \
        __builtin_amdgcn_global_load_lds((const unsigned*)((const char*)(gbase) + (voff)[_i]), (LAS unsigned*)(lds + (bufoff) + ldsw + _i * 8192), 16, 0, 0); } while (0)
#define PG8_LDA(dst, b, h) do { _Pragma("unroll") for (int m = 0; m < 4; ++m) _Pragma("unroll") for (int k = 0; k < 2; ++k) dst[m][k] = *(const LAS bf16x8*)(lds + PG8_SA(b, h) + aoff + m * 2048 + k * 1024); } while (0)
#define PG8_LDB(dst, b, h) do { _Pragma("unroll") for (int n = 0; n < 2; ++n) _Pragma("unroll") for (int k = 0; k < 2; ++k) dst[n][k] = *(const LAS bf16x8*)(lds + PG8_SB(b, h) + boff + n * 2048 + k * 1024); } while (0)
#define PG8_MMA(ai, bj, At, Bt) do { __builtin_amdgcn_s_setprio(1); _Pragma("unroll") for (int m = 0; m < 4; ++m) _Pragma("unroll") for (int n = 0; n < 2; ++n) _Pragma("unroll") for (int k = 0; k < 2; ++k) \
        acc[ai][bj][m][n] = __builtin_amdgcn_mfma_f32_16x16x32_bf16(Bt[n][k], At[m][k], acc[ai][bj][m][n], 0, 0, 0); __builtin_amdgcn_s_setprio(0); } while (0)
#define PG8_WAIT_V(n) asm volatile("s_waitcnt vmcnt(" #n ")" ::: "memory")
#define PG8_WAIT_L(n) asm volatile("s_waitcnt lgkmcnt(" #n ")" ::: "memory")
#define PG8_BAR __builtin_amdgcn_s_barrier()
#define PG8_SCHED __builtin_amdgcn_sched_barrier(0)
    Unit cur, nxt; int ui = 0;
    if (!S.next(0, cur)) return;
    f32x4 acc[2][2][4][2];
#pragma unroll
    for (int a = 0; a < 2; ++a)
#pragma unroll
        for (int b = 0; b < 2; ++b)
#pragma unroll
            for (int m = 0; m < 4; ++m)
#pragma unroll
                for (int n = 0; n < 2; ++n) acc[a][b][m][n] = (f32x4){0.f, 0.f, 0.f, 0.f};
    bf16x8 At[4][2], B0[2][2], B1[2][2];
    const char* cA = cur.A; const char* cB = cur.B;
    PG8_STAGE(PG8_SB(0, 0), cB, voffB); PG8_STAGE(PG8_SA(0, 0), cA, voffA); PG8_STAGE(PG8_SB(0, 1), cB + hstepB, voffB); PG8_STAGE(PG8_SA(0, 1), cA + hstepA, voffA);
    if (wr == 1) PG8_BAR;
    PG8_WAIT_V(4); PG8_BAR;
    PG8_STAGE(PG8_SB(1, 0), cB + kstep, voffB); PG8_STAGE(PG8_SA(1, 0), cA + kstep, voffA); PG8_STAGE(PG8_SB(1, 1), cB + hstepB + kstep, voffB);
    PG8_WAIT_V(6); PG8_BAR;
    for (;;) {
        const bool has_next = S.next(ui + 1, nxt);
        const char* nA = has_next ? nxt.A : cA; const char* nB = has_next ? nxt.B : cB;
        const int nt = cur.nt;
        for (int t = 0; t < nt; t += 2) {
            const bool last = (t == nt - 2);
            const char* a1 = cA + (size_t)(t + 1) * kstep;
            const char* a2 = last ? nA : cA + (size_t)(t + 2) * kstep; const char* b2 = last ? nB : cB + (size_t)(t + 2) * kstep;
            const char* a3 = a2 + kstep; const char* b3 = b2 + kstep;
            PG8_LDB(B0, 0, 0); PG8_SCHED; PG8_LDA(At, 0, 0); PG8_STAGE(PG8_SA(1, 1), a1 + hstepA, voffA);
            PG8_WAIT_L(8); PG8_BAR; PG8_WAIT_L(0); PG8_MMA(0, 0, At, B0); PG8_BAR; PG8_SCHED;
            PG8_LDB(B1, 0, 1); PG8_STAGE(PG8_SB(0, 0), b2, voffB);
            PG8_BAR; PG8_WAIT_L(0); PG8_MMA(0, 1, At, B1); PG8_BAR;
            PG8_LDA(At, 0, 1); PG8_STAGE(PG8_SA(0, 0), a2, voffA);
            PG8_BAR; PG8_WAIT_L(0); PG8_MMA(1, 0, At, B0); PG8_BAR; PG8_SCHED;
            PG8_STAGE(PG8_SB(0, 1), b2 + hstepB, voffB);
            PG8_WAIT_V(6); PG8_BAR; PG8_MMA(1, 1, At, B1); PG8_BAR;
            PG8_LDB(B0, 1, 0); PG8_SCHED; PG8_LDA(At, 1, 0); PG8_STAGE(PG8_SA(0, 1), a2 + hstepA, voffA);
            PG8_WAIT_L(8); PG8_BAR; PG8_WAIT_L(0); PG8_MMA(0, 0, At, B0); PG8_BAR; PG8_SCHED;
            PG8_LDB(B1, 1, 1); PG8_STAGE(PG8_SB(1, 0), b3, voffB);
            PG8_BAR; PG8_WAIT_L(0); PG8_MMA(0, 1, At, B1); PG8_BAR;
            PG8_LDA(At, 1, 1); PG8_STAGE(PG8_SA(1, 0), a3, voffA);
            PG8_BAR; PG8_WAIT_L(0); PG8_MMA(1, 0, At, B0); PG8_BAR; PG8_SCHED;
            PG8_STAGE(PG8_SB(1, 1), b3 + hstepB, voffB);
            PG8_WAIT_V(6); PG8_BAR; PG8_MMA(1, 1, At, B1); PG8_BAR;
        }
        E(acc, cur, wr, wc, fr, fq);
        if (!has_next) break;
#pragma unroll
        for (int a = 0; a < 2; ++a)
#pragma unroll
            for (int b = 0; b < 2; ++b)
#pragma unroll
                for (int m = 0; m < 4; ++m)
#pragma unroll
                    for (int n = 0; n < 2; ++n) acc[a][b][m][n] = (f32x4){0.f, 0.f, 0.f, 0.f};
        cur = nxt; cA = nA; cB = nB; ++ui;
    }
    PG8_WAIT_V(0);
    if (wr == 0) PG8_BAR;
    PG8_BAR;
#undef PG8_SA
#undef PG8_SB
#undef PG8_STAGE
#undef PG8_LDA
#undef PG8_LDB
#undef PG8_MMA
#undef PG8_WAIT_V
#undef PG8_WAIT_L
#undef PG8_BAR
#undef PG8_SCHED
}
typedef f32x4 Acc[2][2][4][2];

__device__ __forceinline__ void store8(bf16_t* p, f32x4 v0, f32x4 v1) {
    u32x4 w; w.x = cvt_pk_bf16(v0[0], v0[1]); w.y = cvt_pk_bf16(v0[2], v0[3]); w.z = cvt_pk_bf16(v1[0], v1[1]); w.w = cvt_pk_bf16(v1[2], v1[3]); *(u32x4*)p = w; }
__device__ __forceinline__ f32x4 gelu4(f32x4 v) { f32x2 a = gelu_pk((f32x2){v[0], v[1]}), b = gelu_pk((f32x2){v[2], v[3]}); return (f32x4){a.x, a.y, b.x, b.y}; }
__device__ __forceinline__ f32x4 silu4(f32x4 v) { return (f32x4){siluf_(v[0]), siluf_(v[1]), siluf_(v[2]), siluf_(v[3])}; }
__device__ __forceinline__ f32x4 sigm4(f32x4 v) { return (f32x4){sigmoidf_(v[0]), sigmoidf_(v[1]), sigmoidf_(v[2]), sigmoidf_(v[3])}; }

struct EpiEvenIn {
    static constexpr bool PERM = true;
    bf16_t* abuf; bf16_t* uv;
    __device__ __forceinline__ void operator()(const Acc& acc, const Unit& u, int wr, int wc, int fr, int fq) const {
        const int row0 = u.pm * BM + wr * 64 + fr; const bool act = u.pn >= 4;
        bf16_t* base = act ? uv : abuf; const int ldc = act ? 2048 : 1024; const int col0 = (act ? (u.pn - 4) : u.pn) * BM + wc * 32 + 8 * fq;
#pragma unroll
        for (int ai = 0; ai < 2; ++ai)
#pragma unroll
            for (int m = 0; m < 4; ++m) { bf16_t* rowp = base + (size_t)(row0 + ai * HALF + m * 16) * ldc + col0;
#pragma unroll
                for (int bj = 0; bj < 2; ++bj) { f32x4 v0 = acc[ai][bj][m][0], v1 = acc[ai][bj][m][1];
                    if (act) { v0 = gelu4(v0); v1 = gelu4(v1); }
                    store8(rowp + bj * HALF, v0, v1); }
                asm volatile("" ::: "memory"); }
    }
};
struct EpiOddIn {
    static constexpr bool PERM = true;
    bf16_t* glu; bf16_t* qkv; bf16_t* zg;
    __device__ __forceinline__ void operator()(const Acc& acc, const Unit& u, int wr, int wc, int fr, int fq) const {
        const int row0 = u.pm * BM + wr * 64 + fr;
        if (u.pn < 8) {
            const int col0 = u.pn * 128 + wc * 32 + 8 * fq;
#pragma unroll
            for (int ai = 0; ai < 2; ++ai)
#pragma unroll
                for (int m = 0; m < 4; ++m) { bf16_t* rowp = glu + (size_t)(row0 + ai * HALF + m * 16) * 1024 + col0;
                    store8(rowp, acc[ai][0][m][0] * sigm4(acc[ai][1][m][0]), acc[ai][0][m][1] * sigm4(acc[ai][1][m][1])); asm volatile("" ::: "memory"); }
        } else {
            const bool isq = u.pn < 20; bf16_t* base = isq ? qkv : zg; const int ldc = isq ? 3072 : 1024; const int col0 = (isq ? (u.pn - 8) : (u.pn - 20)) * BM + wc * 32 + 8 * fq;
#pragma unroll
            for (int ai = 0; ai < 2; ++ai)
#pragma unroll
                for (int m = 0; m < 4; ++m) { bf16_t* rowp = base + (size_t)(row0 + ai * HALF + m * 16) * ldc + col0;
#pragma unroll
                    for (int bj = 0; bj < 2; ++bj) store8(rowp + bj * HALF, acc[ai][bj][m][0], acc[ai][bj][m][1]);
                    asm volatile("" ::: "memory"); }
        }
    }
};
struct EpiUp {
    static constexpr bool PERM = true;
    bf16_t* act;
    __device__ __forceinline__ void operator()(const Acc& acc, const Unit& u, int wr, int wc, int fr, int fq) const {
        const int row0 = u.pm * BM + wr * 64 + fr, col0 = u.pn * 128 + wc * 32 + 8 * fq;
#pragma unroll
        for (int ai = 0; ai < 2; ++ai)
#pragma unroll
            for (int m = 0; m < 4; ++m) { bf16_t* rowp = act + (size_t)(row0 + ai * HALF + m * 16) * DFF + col0;
                store8(rowp, silu4(acc[ai][0][m][0]) * acc[ai][1][m][0], silu4(acc[ai][0][m][1]) * acc[ai][1][m][1]); asm volatile("" ::: "memory"); }
    }
};
struct EpiPool {
    static constexpr bool PERM = true;
    bf16_t* cat; const float* scale;
    __device__ __forceinline__ void operator()(const Acc& acc, const Unit& u, int wr, int wc, int fr, int fq) const {
        const int row0 = u.pm * BM + wr * 64 + fr, col0 = u.pn * BM + wc * 32 + 8 * fq;
#pragma unroll
        for (int ai = 0; ai < 2; ++ai)
#pragma unroll
            for (int m = 0; m < 4; ++m) { bf16_t* rowp = cat + (size_t)(row0 + ai * HALF + m * 16) * 2048 + col0;
#pragma unroll
                for (int bj = 0; bj < 2; ++bj) { const f32x4 s0 = *(const f32x4*)(scale + col0 + bj * HALF), s1 = *(const f32x4*)(scale + col0 + bj * HALF + 4);
                    store8(rowp + bj * HALF, acc[ai][bj][m][0] * s0, acc[ai][bj][m][1] * s1); }
                asm volatile("" ::: "memory"); }
    }
};
struct EpiResid {
    static constexpr bool PERM = false;
    float* x; bool dry;
    __device__ __forceinline__ void operator()(const Acc& acc, const Unit& u, int wr, int wc, int fr, int fq) const {
        if (dry) return;
        const int row0 = u.pm * BM + wr * 64 + fr, col0 = u.pn * BM + wc * 32 + 4 * fq;
#pragma unroll
        for (int ai = 0; ai < 2; ++ai) {
            f32x4 t[4][2][2];
#pragma unroll
            for (int m = 0; m < 4; ++m) { const float* rowp = x + (size_t)(row0 + ai * HALF + m * 16) * 2048 + col0;
#pragma unroll
                for (int bj = 0; bj < 2; ++bj)
#pragma unroll
                    for (int n = 0; n < 2; ++n) t[m][bj][n] = *(const f32x4*)(rowp + bj * HALF + n * 16); }
#pragma unroll
            for (int m = 0; m < 4; ++m) { float* rowp = x + (size_t)(row0 + ai * HALF + m * 16) * 2048 + col0;
#pragma unroll
                for (int bj = 0; bj < 2; ++bj)
#pragma unroll
                    for (int n = 0; n < 2; ++n) *(f32x4*)(rowp + bj * HALF + n * 16) = t[m][bj][n] + acc[ai][bj][m][n]; }
            asm volatile("" ::: "memory"); }
    }
};
struct EpiPartX {
    static constexpr bool PERM = false;
    float* px; bool dry;
    __device__ __forceinline__ void operator()(const Acc& acc, const Unit& u, int wr, int wc, int fr, int fq) const {
        if (dry) return;
        float* base = px + (size_t)u.pad * 32768 + (size_t)(wr * 64 + fr) * 256 + wc * 32 + 4 * fq;
#pragma unroll
        for (int m = 0; m < 4; ++m)
#pragma unroll
            for (int bj = 0; bj < 2; ++bj)
#pragma unroll
                for (int n = 0; n < 2; ++n) *(f32x4*)(base + (size_t)(m * 16) * 256 + bj * HALF + n * 16) = acc[0][bj][m][n];
    }
};
struct EpiResidX {
    static constexpr bool PERM = false;
    EpiResid r; EpiPartX p;
    __device__ __forceinline__ void operator()(const Acc& acc, const Unit& u, int wr, int wc, int fr, int fq) const { if (u.pm < MPR / 256) r(acc, u, wr, wc, fr, fq); else p(acc, u, wr, wc, fr, fq); }
};
}

struct TItem { const float* src; bf16_t* dst; int ldw, K; };
__device__ __forceinline__ TItem titem_locate(PP P, unsigned char* ws, int it) {
    const float* W; bf16_t* WT; int ldw, K, Nd, pairLimit = 0, Hh = 0, r = it;
    if (r < 6144) { const int j = r / 3072; r -= j * 3072; W = P->in[9] + (size_t)j * 2048 * 3072; WT = (bf16_t*)(ws + WS_WEVIN) + (size_t)j * 3072 * 2048; ldw = 3072; K = 2048; Nd = 3072; }
    else if ((r -= 6144) < 4096) { const int e = r / 2048; r -= e * 2048; W = P->in[16] + (size_t)e * 2048 * 2048; WT = (bf16_t*)(ws + WS_WEVOUT) + (size_t)e * 2048 * 2048; ldw = 2048; K = 2048; Nd = 2048; }
    else if ((r -= 4096) < 12288) { const int o = r / 6144; r -= o * 6144; W = P->in[17] + (size_t)o * 2048 * OD_IN; WT = (bf16_t*)(ws + WS_WODIN) + (size_t)o * OD_INM * 2048; ldw = OD_IN; K = 2048; Nd = OD_INM; pairLimit = 2048; Hh = 1024; }
    else if ((r -= 12288) < 4096) { const int o = r / 2048; r -= o * 2048; W = P->in[26] + (size_t)o * 2048 * 2048; WT = (bf16_t*)(ws + WS_WODOUT) + (size_t)o * 2048 * 2048; ldw = 2048; K = 2048; Nd = 2048; }
    else if ((r -= 4096) < 45056) { const int l = r / 11264; r -= l * 11264; W = P->in[27] + (size_t)l * 2048 * 2 * DFF; WT = (bf16_t*)(ws + WS_WUP) + (size_t)l * 2 * DFF * 2048; ldw = 2 * DFF; K = 2048; Nd = 2 * DFF; pairLimit = 2 * DFF; Hh = DFF; }
    else if ((r -= 45056) < 22528) { const int l = r / 5632; r -= l * 5632; W = P->in[28] + (size_t)l * DFF * 2048; WT = (bf16_t*)(ws + WS_WDOWN) + (size_t)l * 2048 * DFF; ldw = 2048; K = DFF; Nd = 2048; }
    else { r -= 22528; const int eg = r / 32; r -= eg * 32; W = P->in[10] + (size_t)eg * 65536; WT = (bf16_t*)(ws + WS_WPOOL) + (size_t)eg * 65536; ldw = 256; K = 256; Nd = 256; }
    const int nblk = Nd / 32, kb = r / nblk, nb = r - kb * nblk, n0 = nb * 32; int src = n0;
    if (n0 < pairLimit) { const int pn = n0 >> 8, c = n0 & 255; src = c < 128 ? pn * 128 + c : Hh + pn * 128 + (c - 128); }
    TItem t; t.src = W + (size_t)(kb * 64) * ldw + src; t.dst = WT + (size_t)n0 * K + kb * 64; t.ldw = ldw; t.K = K; return t;
}
constexpr int T_ITEMS = 6144 + 4096 + 12288 + 4096 + 45056 + 22528 + 256;
__device__ __forceinline__ void titem_load(const TItem& t, float (&r)[32], int lane) {
    const float* p = t.src + (size_t)(lane >> 5) * t.ldw + (lane & 31);
#pragma unroll
    for (int i = 0; i < 32; ++i) r[i] = p[(size_t)(2 * i) * t.ldw];
}
__device__ __forceinline__ void titem_store(const TItem& t, const float (&r)[32], LAS float* scr, int lane) {
#pragma unroll
    for (int i = 0; i < 32; ++i) scr[(2 * i + (lane >> 5)) * 33 + (lane & 31)] = r[i];
    asm volatile("s_waitcnt lgkmcnt(0)" ::: "memory");
    const int c = lane & 7;
#pragma unroll
    for (int j = 0; j < 4; ++j) { const int n = (lane >> 3) + 8 * j; const LAS float* s = scr + (8 * c) * 33 + n;
        u32x4 o; o.x = cvt_pk_bf16(s[0 * 33], s[1 * 33]); o.y = cvt_pk_bf16(s[2 * 33], s[3 * 33]); o.z = cvt_pk_bf16(s[4 * 33], s[5 * 33]); o.w = cvt_pk_bf16(s[6 * 33], s[7 * 33]);
        *(u32x4*)(t.dst + (size_t)n * t.K + 8 * c) = o; }
    asm volatile("s_waitcnt lgkmcnt(0)" ::: "memory");
}
constexpr int L_EVEN_ITEMS = 3072 + 2048 + 128 + 11264 + 5632, L_ODD_ITEMS = 6144 + 2048 + 11264 + 5632;
__device__ __forceinline__ int layer_item(int l, int i) {
    const int h = l >> 1;
    if ((l & 1) == 0) { if (i < 3072) return h * 3072 + i; i -= 3072; if (i < 2048) return 6144 + h * 2048 + i; i -= 2048; if (i < 128) return 94208 + h * 128 + i; i -= 128; }
    else { if (i < 6144) return 10240 + h * 6144 + i; i -= 6144; if (i < 2048) return 22528 + h * 2048 + i; i -= 2048; }
    if (i < 11264) return 26624 + l * 11264 + i; i -= 11264; return 71680 + l * 5632 + i;
}
constexpr int DEF1_A = 5568, DEF1_B = 4032, DEF2_A = 7968, DEF2_B = 4032, DEF3_A = 5568, DEF3_B = 4032;
constexpr int PREP_L1 = L_ODD_ITEMS - DEF1_A - DEF1_B, PREP_L2 = L_EVEN_ITEMS - DEF2_A - DEF2_B, PREP_L3 = L_ODD_ITEMS - DEF3_A - DEF3_B;
constexpr int PREP_ITEMS = L_EVEN_ITEMS + PREP_L1 + PREP_L2 + PREP_L3;
__device__ __forceinline__ int prep_item(int p) {
    if (p < L_EVEN_ITEMS) return layer_item(0, p); p -= L_EVEN_ITEMS;
    if (p < PREP_L1) return layer_item(1, DEF1_A + DEF1_B + p); p -= PREP_L1;
    if (p < PREP_L2) return layer_item(2, DEF2_A + DEF2_B + p); p -= PREP_L2;
    return layer_item(3, DEF3_A + DEF3_B + p);
}
__device__ __forceinline__ void convert_span(PP P, LAS unsigned char* lds, int tid, int wv, int nwv, int count, int mode, int layer, int first) {
    const int lane = tid & 63, wave = tid >> 6;
    LAS float* scr = (LAS float*)(lds + wave * 8448);
    unsigned char* ws = P->ws;
    int it = wv; TItem dA, dB; float ra[32], rb[32];
#define CONV_MAP(j) (mode == 0 ? prep_item(j) : (mode == 2 ? (j) : layer_item(layer, first + (j))))
    if (it < count) { dA = titem_locate(P, ws, CONV_MAP(it)); titem_load(dA, ra, lane); }
    while (it < count) {
        const int itB = it + nwv; const bool hb = itB < count;
        if (hb) { dB = titem_locate(P, ws, CONV_MAP(itB)); titem_load(dB, rb, lane); }
        titem_store(dA, ra, scr, lane);
        if (!hb) break;
        const int itA = itB + nwv; const bool ha = itA < count;
        if (ha) { dA = titem_locate(P, ws, CONV_MAP(itA)); titem_load(dA, ra, lane); }
        titem_store(dB, rb, scr, lane);
        if (!ha) break;
        it = itA;
    }
#undef CONV_MAP
}
__device__ __forceinline__ void convert_slot(const Ctx& cx, PP P, LAS unsigned char* lds, int layer, int first, int count, int thr, int ncu) {
    if (cx.G != 256 || cx.bid < thr || cx.bid >= thr + ncu) return;
    __syncthreads();
    convert_span(P, lds, cx.tid, (cx.bid - thr) * NWAVES + (cx.tid >> 6), ncu * NWAVES, count, 1, layer, first);
}
__device__ __forceinline__ void phase_prep(const Ctx& cx, PP P, LAS unsigned char* lds) {
    const int tid = cx.tid;
    const int G = cx.G;
    unsigned char* ws = P->ws;
    if (G == 256) convert_span(P, lds, tid, cx.bid * NWAVES + (tid >> 6), G * NWAVES, PREP_ITEMS, 0, 0, 0);
    else convert_span(P, lds, tid, cx.bid * NWAVES + (tid >> 6), G * NWAVES, T_ITEMS, 2, 0, 0);
    {
        bf16_t* wab = (bf16_t*)(ws + WS_WAB);
        for (int i = cx.bid * NTHR + tid; i < 2 * 16 * 2048; i += G * NTHR) { const int o = i >> 15, c = (i >> 11) & 15, k = i & 2047;
            wab[i] = (bf16_t)(cvt_pk_bf16(P->in[17][(size_t)o * 2048 * OD_IN + (size_t)k * OD_IN + OD_INM + c], 0.f) & 0xffff); }
    }
}

template <bool F32OUT>
__device__ __forceinline__ void phase_rmsnorm(const Ctx& cx, float* X, const float* g, bf16_t* Hout, float* Fout, const float* px, int ppu, bool dry, LAS unsigned char* lds) {
    const int tid = cx.tid, lane = tid & 63, wave = __builtin_amdgcn_readfirstlane(tid >> 6);
    const int gw = cx.bid * NWAVES + wave, NGW = cx.G * NWAVES;
    if (ppu > 0) {
        LAS float* red = (LAS float*)lds;
        for (int r = cx.bid; r < BS; r += cx.G) {
            const int m = MPR + r, col = 256 * wave + lane * 4, P8 = 8 * ppu;
            f32x4 a = *(const f32x4*)(X + (size_t)m * D + col);
            const float* pr = px + (size_t)r * 256 + lane * 4 + (size_t)(32 * wave) * 32768;
#pragma unroll
            for (int i = 0; i < 32; ++i) { const int vc = 32 * wave + i; if (((vc + 1) * P8) / 256 > (vc * P8) / 256) a = a + *(const f32x4*)(pr + (size_t)i * 32768); }
            if (!dry) *(f32x4*)(X + (size_t)m * D + col) = a;
            const float ss = wave_sum((a.x * a.x + a.y * a.y) + (a.z * a.z + a.w * a.w));
            if (lane == 0) red[wave] = ss;
            __syncthreads();
            float tot = 0.f;
#pragma unroll
            for (int i = 0; i < 8; ++i) tot += red[i];
            const float rs = rsqrtf(tot * (1.0f / D) + EPS);
            const f32x4 g4 = *(const f32x4*)(g + col); const f32x4 o = a * rs * g4;
            if (F32OUT) *(f32x4*)(Fout + (size_t)m * D + col) = o;
            else { u32x2 w; w.x = cvt_pk_bf16(o.x, o.y); w.y = cvt_pk_bf16(o.z, o.w); *(u32x2*)(Hout + (size_t)m * D + col) = w; }
            __syncthreads();
        }
    }
    const int mend = ppu > 0 ? MPR : MT;
    for (int m = gw; m < mend; m += 4 * NGW) {
        f32x4 v[4][8]; float ss[4]; int mr[4]; bool ok[4];
#pragma unroll
        for (int k = 0; k < 4; ++k) { const int mk = m + k * NGW; ok[k] = mk < mend; mr[k] = ok[k] ? mk : m; const f32x4* xr = (const f32x4*)(X + (size_t)mr[k] * D) + lane;
#pragma unroll
            for (int j = 0; j < 8; ++j) v[k][j] = xr[64 * j]; }
#pragma unroll
        for (int k = 0; k < 4; ++k) { float a = 0.f;
#pragma unroll
            for (int j = 0; j < 8; ++j) a += (v[k][j].x * v[k][j].x + v[k][j].y * v[k][j].y) + (v[k][j].z * v[k][j].z + v[k][j].w * v[k][j].w);
            ss[k] = a; }
#pragma unroll
        for (int o = 1; o < 64; o <<= 1) {
#pragma unroll
            for (int k = 0; k < 4; ++k) ss[k] += __shfl_xor(ss[k], o); }
#pragma unroll
        for (int j = 0; j < 8; ++j) { const f32x4 g4 = ((const f32x4*)g)[lane + 64 * j];
#pragma unroll
            for (int k = 0; k < 4; ++k) if (ok[k]) { const float rs = rsqrtf(ss[k] * (1.0f / D) + EPS); const f32x4 o = v[k][j] * rs * g4;
                if (F32OUT) ((f32x4*)(Fout + (size_t)mr[k] * D))[lane + 64 * j] = o;
                else { u32x2 w; w.x = cvt_pk_bf16(o.x, o.y); w.y = cvt_pk_bf16(o.z, o.w); ((u32x2*)(Hout + (size_t)mr[k] * D))[lane + 64 * j] = w; } } }
    }
}

__device__ __forceinline__ void phase_first_norm(const Ctx& cx, PP P, float* X, const float* g, bf16_t* Hout) {
    const int tid = cx.tid, lane = tid & 63, wave = __builtin_amdgcn_readfirstlane(tid >> 6);
    const int gw = cx.bid * NWAVES + wave, NGW = cx.G * NWAVES;
    for (int m = gw; m < MT; m += NGW) {
        const float* src = m < MPR ? P->in[0] + (size_t)m * D : P->in[1] + (size_t)(m - MPR) * D;
        const f32x4* xr = (const f32x4*)src + lane; f32x4 v[8]; float ss = 0.f;
#pragma unroll
        for (int j = 0; j < 8; ++j) { v[j] = xr[64 * j]; ss += (v[j].x * v[j].x + v[j].y * v[j].y) + (v[j].z * v[j].z + v[j].w * v[j].w); }
        const float rs = rsqrtf(wave_sum(ss) * (1.0f / D) + EPS);
#pragma unroll
        for (int j = 0; j < 8; ++j) { ((f32x4*)(X + (size_t)m * D))[lane + 64 * j] = v[j]; const f32x4 g4 = ((const f32x4*)g)[lane + 64 * j]; const f32x4 o = v[j] * rs * g4;
            u32x2 w; w.x = cvt_pk_bf16(o.x, o.y); w.y = cvt_pk_bf16(o.z, o.w); ((u32x2*)(Hout + (size_t)m * D))[lane + 64 * j] = w; }
    }
}

__device__ __forceinline__ void phase_even_prep(const Ctx& cx, PP P, int e) {
    const int tid = cx.tid, lane = tid & 63, wave = __builtin_amdgcn_readfirstlane(tid >> 6);
    const int gw = cx.bid * NWAVES + wave, NGW = cx.G * NWAVES;
    unsigned char* ws = P->ws;
    const bf16_t* abuf = (const bf16_t*)(ws + WS_ABUF); const bf16_t* uv = (const bf16_t*)(ws + WS_UV);
    bf16_t* pooled = (bf16_t*)(ws + WS_MIX); bf16_t* vn = (bf16_t*)(ws + WS_VN); bf16_t* cat = (bf16_t*)(ws + WS_CAT);
    const float* spool = P->in[2] + (size_t)e * BS * 15 * 1024;
    const float* lng = P->in[12] + e * 1024; const float* lnb = P->in[13] + e * 1024;
    const float* sws = P->in[14] + (size_t)e * 4 * 128 * 128; const float* sb = P->in[15] + e * 4 * 128;
    float* out = P->out;
    constexpr int GPS = (SEQ + 4) / 5;
    for (int task = gw; task < BP * GPS + BS; task += NGW) {
      if (task >= BP * GPS) {
        const int m = MPR + task - BP * GPS; const bool prompt = false; const int b = m - MPR, t = 0;
#pragma unroll
        for (int p = 0; p < 4; ++p) {
            const int w = 2 << p, ch0 = p * 256 + lane * 4;
            float cur[4], sacc[4];
            { const u32x2 r = *(const u32x2*)(abuf + (size_t)m * 1024 + ch0); cur[0] = bf_lo(r.x); cur[1] = bf_hi(r.x); cur[2] = bf_lo(r.y); cur[3] = bf_hi(r.y); }
#pragma unroll
            for (int i = 0; i < 4; ++i) sacc[i] = cur[i];
            float cnt;
            if (prompt) {
#pragma unroll
                for (int d = 1; d < w; ++d) if (t - d >= 0) { const u32x2 r = *(const u32x2*)(abuf + (size_t)(m - d) * 1024 + ch0);
                    sacc[0] += bf_lo(r.x); sacc[1] += bf_hi(r.x); sacc[2] += bf_lo(r.y); sacc[3] += bf_hi(r.y); }
                cnt = (float)(w < t + 1 ? w : t + 1);
            } else {
#pragma unroll
                for (int d = 1; d < w; ++d) { const f32x4 h0 = *(const f32x4*)(spool + ((size_t)b * 15 + (15 - d)) * 1024 + ch0);
                    sacc[0] += h0.x; sacc[1] += h0.y; sacc[2] += h0.z; sacc[3] += h0.w; }
                cnt = (float)w;
            }
            const float ic = 1.0f / cnt;
            u32x2 pw; pw.x = cvt_pk_bf16(sacc[0] * ic - cur[0], sacc[1] * ic - cur[1]); pw.y = cvt_pk_bf16(sacc[2] * ic - cur[2], sacc[3] * ic - cur[3]);
            *(u32x2*)(pooled + (size_t)m * 1024 + ch0) = pw;
            const f32x4 c4 = (f32x4){cur[0], cur[1], cur[2], cur[3]};
            if (prompt) { if (t >= SEQ - 15) *(f32x4*)(out + O_PP + (((size_t)e * BP + b) * 15 + (t - (SEQ - 15))) * 1024 + ch0) = c4; }
            else { float* ob = out + O_PS + ((size_t)e * BS + b) * 15 * 1024 + ch0;
                *(f32x4*)(ob + 14 * 1024) = c4; }
        }
        float v[2][8]; float sm = 0.f;
#pragma unroll
        for (int jj = 0; jj < 2; ++jj) { const int ch0 = (lane + 64 * jj) * 8; const u32x4 r = *(const u32x4*)(uv + (size_t)m * 2048 + 1024 + ch0); unpack8(r, v[jj]);
#pragma unroll
            for (int i = 0; i < 8; ++i) sm += v[jj][i]; }
        const float mu = wave_sum(sm) * (1.0f / 1024.f); float sq = 0.f;
#pragma unroll
        for (int jj = 0; jj < 2; ++jj)
#pragma unroll
            for (int i = 0; i < 8; ++i) { v[jj][i] -= mu; sq += v[jj][i] * v[jj][i]; }
        const float rstd = rsqrtf(wave_sum(sq) * (1.0f / 1024.f) + EPS);
#pragma unroll
        for (int jj = 0; jj < 2; ++jj) { const int ch0 = (lane + 64 * jj) * 8; float o[8];
#pragma unroll
            for (int i = 0; i < 8; ++i) o[i] = v[jj][i] * rstd * lng[ch0 + i] + lnb[ch0 + i];
            *(u32x4*)(vn + (size_t)m * 1024 + ch0) = pack8(o);
            if (!prompt) {
                float* op = out + O_SV + ((size_t)e * BS + b) * 1024 + ch0;
                *(f32x4*)op = (f32x4){o[0], o[1], o[2], o[3]}; *(f32x4*)(op + 4) = (f32x4){o[4], o[5], o[6], o[7]};
                const int h = ch0 >> 8; const float w00 = sws[(size_t)h * 128 * 128], b0 = sb[h * 128];
                float uu[8]; const u32x4 r = *(const u32x4*)(uv + (size_t)m * 2048 + ch0); unpack8(r, uu);
                float c[8];
#pragma unroll
                for (int i = 0; i < 8; ++i) c[i] = uu[i] * (w00 * o[i] + b0);
                *(u32x4*)(cat + (size_t)m * 2048 + 1024 + ch0) = pack8(c);
            } }
      }
      else {
        const int b = task / GPS, gi = task - b * GPS, t0 = gi * 5, R = (SEQ - t0) < 5 ? (SEQ - t0) : 5, mbase = b * SEQ + t0;
#pragma unroll
        for (int p = 0; p < 4; ++p) {
            constexpr int dummy = 0; (void)dummy;
            const int w = 2 << p, ch0 = p * 256 + lane * 4;
            float x[20][4];
#pragma unroll
            for (int i = 0; i < 20; ++i) if (i < w + 4) { const int ti = t0 - (w - 1) + i; const bool valid = (ti >= 0) && (i < w - 1 + R);
                const u32x2 r = *(const u32x2*)(abuf + (size_t)(valid ? mbase - (w - 1) + i : mbase) * 1024 + ch0);
                x[i][0] = valid ? bf_lo(r.x) : 0.f; x[i][1] = valid ? bf_hi(r.x) : 0.f; x[i][2] = valid ? bf_lo(r.y) : 0.f; x[i][3] = valid ? bf_hi(r.y) : 0.f; }
            float sacc[4] = {0.f, 0.f, 0.f, 0.f};
#pragma unroll
            for (int i = 0; i < 16; ++i) if (i < w) {
#pragma unroll
                for (int c = 0; c < 4; ++c) sacc[c] += x[i][c]; }
#pragma unroll
            for (int r = 0; r < 5; ++r) {
                if (r > 0) {
#pragma unroll
                    for (int c = 0; c < 4; ++c) sacc[c] += x[r + w - 1][c] - x[r - 1][c]; }
                const int t = t0 + r; const float ic = 1.0f / (float)(w < t + 1 ? w : t + 1);
                const float* cur = x[r + w - 1];
                if (r < R) { u32x2 pw; pw.x = cvt_pk_bf16(sacc[0] * ic - cur[0], sacc[1] * ic - cur[1]); pw.y = cvt_pk_bf16(sacc[2] * ic - cur[2], sacc[3] * ic - cur[3]);
                    *(u32x2*)(pooled + (size_t)(mbase + r) * 1024 + ch0) = pw;
                    if (t >= SEQ - 15) *(f32x4*)(out + O_PP + (((size_t)e * BP + b) * 15 + (t - (SEQ - 15))) * 1024 + ch0) = (f32x4){cur[0], cur[1], cur[2], cur[3]}; }
            }
        }
        float v[5][2][8]; float sm[5], sq[5];
#pragma unroll
        for (int r = 0; r < 5; ++r) { const int mr = mbase + (r < R ? r : 0); float a = 0.f;
#pragma unroll
            for (int jj = 0; jj < 2; ++jj) { const int ch0 = (lane + 64 * jj) * 8; const u32x4 q = *(const u32x4*)(uv + (size_t)mr * 2048 + 1024 + ch0); unpack8(q, v[r][jj]);
#pragma unroll
                for (int i = 0; i < 8; ++i) a += v[r][jj][i]; }
            sm[r] = a; }
#pragma unroll
        for (int of = 1; of < 64; of <<= 1) {
#pragma unroll
            for (int r = 0; r < 5; ++r) sm[r] += __shfl_xor(sm[r], of); }
#pragma unroll
        for (int r = 0; r < 5; ++r) { const float mu = sm[r] * (1.0f / 1024.f); float a = 0.f;
#pragma unroll
            for (int jj = 0; jj < 2; ++jj)
#pragma unroll
                for (int i = 0; i < 8; ++i) { v[r][jj][i] -= mu; a += v[r][jj][i] * v[r][jj][i]; }
            sq[r] = a; }
#pragma unroll
        for (int of = 1; of < 64; of <<= 1) {
#pragma unroll
            for (int r = 0; r < 5; ++r) sq[r] += __shfl_xor(sq[r], of); }
#pragma unroll
        for (int jj = 0; jj < 2; ++jj) { const int ch0 = (lane + 64 * jj) * 8;
            const f32x4 g0 = *(const f32x4*)(lng + ch0), g1 = *(const f32x4*)(lng + ch0 + 4), b0 = *(const f32x4*)(lnb + ch0), b1 = *(const f32x4*)(lnb + ch0 + 4);
            const float gg[8] = {g0.x, g0.y, g0.z, g0.w, g1.x, g1.y, g1.z, g1.w}, bb[8] = {b0.x, b0.y, b0.z, b0.w, b1.x, b1.y, b1.z, b1.w};
#pragma unroll
            for (int r = 0; r < 5; ++r) if (r < R) { const float rstd = rsqrtf(sq[r] * (1.0f / 1024.f) + EPS); float o8[8];
#pragma unroll
                for (int i = 0; i < 8; ++i) o8[i] = v[r][jj][i] * rstd * gg[i] + bb[i];
                *(u32x4*)(vn + (size_t)(mbase + r) * 1024 + ch0) = pack8(o8); } }
      }
    }
}

__device__ __forceinline__ void phase_sgu(const Ctx& cx, PP P, int e, LAS unsigned char* lds) {
    const int tid = cx.tid, lane = tid & 63, wave = __builtin_amdgcn_readfirstlane(tid >> 6), l15 = lane & 15, quad = lane >> 4;
    const int G = cx.G;
    unsigned char* ws = P->ws;
    const bf16_t* uv = (const bf16_t*)(ws + WS_UV); const bf16_t* vn = (const bf16_t*)(ws + WS_VN); bf16_t* cat = (bf16_t*)(ws + WS_CAT);
    const float* sws = P->in[14] + (size_t)e * 4 * 128 * 128; const float* sb = P->in[15] + e * 4 * 128;
    LAS bf16_t* VT = (LAS bf16_t*)lds;
    for (int task = (G - 1 - cx.bid); task < 256; task += G) {
        const int b = task >> 6, n = (task >> 2) & 15, h = task & 3; const int m0 = b * SEQ + n * 128;
        for (int idx = tid; idx < 128 * 32; idx += NTHR) { const int r = idx >> 5, cq = idx & 31;
            const u32x4 w = *(const u32x4*)(vn + (size_t)(m0 + r) * 1024 + h * 256 + cq * 8);
            LAS bf16_t* d = VT + (cq * 8) * 136 + (r ^ ((cq & 7) << 3));
            d[0 * 136] = (bf16_t)(w.x & 0xffff); d[1 * 136] = (bf16_t)(w.x >> 16); d[2 * 136] = (bf16_t)(w.y & 0xffff); d[3 * 136] = (bf16_t)(w.y >> 16);
            d[4 * 136] = (bf16_t)(w.z & 0xffff); d[5 * 136] = (bf16_t)(w.z >> 16); d[6 * 136] = (bf16_t)(w.w & 0xffff); d[7 * 136] = (bf16_t)(w.w >> 16); }
        __syncthreads();
        const int irow = 16 * wave + l15;
        bf16x8 af[4];
#pragma unroll
        for (int ks = 0; ks < 4; ++ks) { const int k0 = ks * 32 + quad * 8; const float* wp = sws + ((size_t)h * 128 + irow) * 128 + k0; const f32x4 a0 = *(const f32x4*)wp, a1 = *(const f32x4*)(wp + 4);
            float f[8] = {a0.x, a0.y, a0.z, a0.w, a1.x, a1.y, a1.z, a1.w};
#pragma unroll
            for (int i = 0; i < 8; ++i) if (k0 + i > irow) f[i] = 0.f;
            const u32x4 pw = pack8(f); af[ks] = __builtin_bit_cast(bf16x8, pw); }
        const float bias = sb[h * 128 + irow];
#pragma unroll 2
        for (int nt = 0; nt < 16; ++nt) {
            f32x4 acc = (f32x4){0.f, 0.f, 0.f, 0.f};
#pragma unroll
            for (int ks = 0; ks < 4; ++ks) { const bf16x8 bfr = *(const LAS bf16x8*)(VT + (nt * 16 + l15) * 136 + ((ks * 32 + quad * 8) ^ ((((nt * 16 + l15) >> 3) & 7) << 3)));
                acc = __builtin_amdgcn_mfma_f32_16x16x32_bf16(bfr, af[ks], acc, 0, 0, 0); }
            const int c0 = h * 256 + nt * 16 + quad * 4;
            const u32x2 uw = *(const u32x2*)(uv + (size_t)(m0 + irow) * 2048 + c0);
            u32x2 ow; ow.x = cvt_pk_bf16(bf_lo(uw.x) * (acc[0] + bias), bf_hi(uw.x) * (acc[1] + bias)); ow.y = cvt_pk_bf16(bf_lo(uw.y) * (acc[2] + bias), bf_hi(uw.y) * (acc[3] + bias));
            *(u32x2*)(cat + (size_t)(m0 + irow) * 2048 + 1024 + c0) = ow;
        }
        __syncthreads();
    }
}

__device__ __forceinline__ void phase_ab(const Ctx& cx, PP P, int o) {
    const int tid = cx.tid, lane = tid & 63, l15 = lane & 15, quad = lane >> 4, wave = __builtin_amdgcn_readfirstlane(tid >> 6);
    const int gw = cx.bid * NWAVES + wave, NGW = cx.G * NWAVES;
    const bf16_t* H = (const bf16_t*)(P->ws + WS_H); float* AB = (float*)(P->ws + WS_AB);
    const bf16_t* Wt = (const bf16_t*)(P->ws + WS_WAB) + (size_t)o * 16 * 2048;
    for (int tt = NGW - 1 - gw; tt < MT / 16; tt += NGW) {
        const bf16_t* ap = H + (size_t)(16 * tt + l15) * D + quad * 8; const bf16_t* bp = Wt + (size_t)l15 * 2048 + quad * 8;
        f32x4 acc = (f32x4){0.f, 0.f, 0.f, 0.f};
#pragma unroll 16
        for (int ks = 0; ks < 64; ++ks) { const bf16x8 a = *(const bf16x8*)(ap + ks * 32), b = *(const bf16x8*)(bp + ks * 32); acc = __builtin_amdgcn_mfma_f32_16x16x32_bf16(a, b, acc, 0, 0, 0); }
#pragma unroll
        for (int j = 0; j < 4; ++j) AB[(size_t)(16 * tt + quad * 4 + j) * 16 + l15] = acc[j];
    }
}

__device__ __forceinline__ void phase_odd_prep(const Ctx& cx, PP P, int o, LAS unsigned char* lds) {
    const int tid = cx.tid, lane = tid & 63, wave = __builtin_amdgcn_readfirstlane(tid >> 6);
    const int gw = cx.bid * NWAVES + wave, NGW = cx.G * NWAVES;
    unsigned char* ws = P->ws;
    const bf16_t* glu = (const bf16_t*)(ws + WS_ABUF); const bf16_t* qkv = (const bf16_t*)(ws + WS_UV);
    bf16_t* qkvc = (bf16_t*)(ws + WS_MIX); bf16_t* cat = (bf16_t*)(ws + WS_CAT);
    const float* AB = (const float*)(ws + WS_AB); float* Gg = (float*)(ws + WS_G); float* Bt = (float*)(ws + WS_BETA);
    const float* sconv = P->in[3] + (size_t)o * BS * 30 * 1024; const float* sdn = P->in[4] + (size_t)o * BS * 3 * 3072;
    const float* dw = P->in[18] + (size_t)o * 31 * 1024; const float* db = P->in[19] + o * 1024; const float* lng = P->in[20] + o * 1024; const float* lnb = P->in[21] + o * 1024;
    const float* cw = P->in[22] + (size_t)o * 4 * 3072; const float* alog = P->in[23] + o * 8; const float* dtb = P->in[24] + o * 8;
    float* out = P->out;
    LAS float* dwl = (LAS float*)lds;
    constexpr int GPS = (SEQ + 4) / 5;
#pragma unroll 8
    for (int i = tid; i < 31 * 256; i += NTHR) ((LAS f32x4*)dwl)[i] = ((const f32x4*)dw)[i];
    __syncthreads();
    for (int task = gw; task < BP * GPS + BS; task += NGW) {
      if (task >= BP * GPS) {
        const int m = MPR + task - BP * GPS; const bool prompt = false; const int b = m - MPR, t = 0;
        float y[2][8]; float sm = 0.f;
#pragma unroll
        for (int jj = 0; jj < 2; ++jj) {
            const int ch0 = (lane + 64 * jj) * 8;
            { const f32x4 d0 = *(const f32x4*)(db + ch0), d1 = *(const f32x4*)(db + ch0 + 4); y[jj][0] = d0.x; y[jj][1] = d0.y; y[jj][2] = d0.z; y[jj][3] = d0.w; y[jj][4] = d1.x; y[jj][5] = d1.y; y[jj][6] = d1.z; y[jj][7] = d1.w; }
            float cur[8];
            { const u32x4 r = *(const u32x4*)(glu + (size_t)m * 1024 + ch0); unpack8(r, cur); }
            { const f32x4 w0 = *(const LAS f32x4*)(dwl + 30 * 1024 + ch0), w1 = *(const LAS f32x4*)(dwl + 30 * 1024 + ch0 + 4);
              y[jj][0] += w0.x * cur[0]; y[jj][1] += w0.y * cur[1]; y[jj][2] += w0.z * cur[2]; y[jj][3] += w0.w * cur[3]; y[jj][4] += w1.x * cur[4]; y[jj][5] += w1.y * cur[5]; y[jj][6] += w1.z * cur[6]; y[jj][7] += w1.w * cur[7]; }
            if (prompt) {
                const int j0 = t >= 30 ? 0 : 30 - t;
#pragma unroll
                for (int hh = 0; hh < 2; ++hh) {
                    u32x4 rr[15];
#pragma unroll
                    for (int jx = 0; jx < 15; ++jx) { const int j = hh * 15 + jx; const int jm = (j >= j0) ? (m - 30 + j) : m; rr[jx] = *(const u32x4*)(glu + (size_t)jm * 1024 + ch0); }
#pragma unroll
                    for (int jx = 0; jx < 15; ++jx) { const int j = hh * 15 + jx; if (j >= j0) { float x[8]; unpack8(rr[jx], x);
                        const f32x4 w0 = *(const LAS f32x4*)(dwl + j * 1024 + ch0), w1 = *(const LAS f32x4*)(dwl + j * 1024 + ch0 + 4);
                        y[jj][0] += w0.x * x[0]; y[jj][1] += w0.y * x[1]; y[jj][2] += w0.z * x[2]; y[jj][3] += w0.w * x[3]; y[jj][4] += w1.x * x[4]; y[jj][5] += w1.y * x[5]; y[jj][6] += w1.z * x[6]; y[jj][7] += w1.w * x[7]; } }
                    asm volatile("" ::: "memory");
                }
            } else {
#pragma unroll 10
                for (int j = 0; j < 30; ++j) { const float* hp = sconv + ((size_t)b * 30 + j) * 1024 + ch0; const f32x4 h0 = *(const f32x4*)hp, h1 = *(const f32x4*)(hp + 4);
                    const f32x4 w0 = *(const LAS f32x4*)(dwl + j * 1024 + ch0), w1 = *(const LAS f32x4*)(dwl + j * 1024 + ch0 + 4);
                    y[jj][0] += w0.x * h0.x; y[jj][1] += w0.y * h0.y; y[jj][2] += w0.z * h0.z; y[jj][3] += w0.w * h0.w; y[jj][4] += w1.x * h1.x; y[jj][5] += w1.y * h1.y; y[jj][6] += w1.z * h1.z; y[jj][7] += w1.w * h1.w; }
            }
#pragma unroll
            for (int i = 0; i < 8; ++i) sm += y[jj][i];
            if (prompt) { if (t >= SEQ - 30) { float* op = out + O_CP + (((size_t)o * BP + b) * 30 + (t - (SEQ - 30))) * 1024 + ch0;
                    *(f32x4*)op = (f32x4){cur[0], cur[1], cur[2], cur[3]}; *(f32x4*)(op + 4) = (f32x4){cur[4], cur[5], cur[6], cur[7]}; } }
            else { float* ob = out + O_CS + ((size_t)o * BS + b) * 30 * 1024 + ch0;
                *(f32x4*)(ob + 29 * 1024) = (f32x4){cur[0], cur[1], cur[2], cur[3]}; *(f32x4*)(ob + 29 * 1024 + 4) = (f32x4){cur[4], cur[5], cur[6], cur[7]}; }
        }
        const float mu = wave_sum(sm) * (1.0f / 1024.f); float sq = 0.f;
#pragma unroll
        for (int jj = 0; jj < 2; ++jj)
#pragma unroll
            for (int i = 0; i < 8; ++i) { y[jj][i] -= mu; sq += y[jj][i] * y[jj][i]; }
        const float rstd = rsqrtf(wave_sum(sq) * (1.0f / 1024.f) + EPS);
#pragma unroll
        for (int jj = 0; jj < 2; ++jj) { const int ch0 = (lane + 64 * jj) * 8; float c[8];
#pragma unroll
            for (int i = 0; i < 8; ++i) c[i] = siluf_(y[jj][i] * rstd * lng[ch0 + i] + lnb[ch0 + i]);
            *(u32x4*)(cat + (size_t)m * 2048 + ch0) = pack8(c); }
          }
      else {
        const int b = task / GPS, gi = task - b * GPS, t0 = gi * 5, R = (SEQ - t0) < 5 ? (SEQ - t0) : 5, mbase = b * SEQ + t0;
        float y[2][5][8];
#pragma unroll
        for (int jj = 0; jj < 2; ++jj) { const int ch0 = (lane + 64 * jj) * 8; const f32x4 d0 = *(const f32x4*)(db + ch0), d1 = *(const f32x4*)(db + ch0 + 4);
#pragma unroll
            for (int r = 0; r < 5; ++r) { y[jj][r][0] = d0.x; y[jj][r][1] = d0.y; y[jj][r][2] = d0.z; y[jj][r][3] = d0.w; y[jj][r][4] = d1.x; y[jj][r][5] = d1.y; y[jj][r][6] = d1.z; y[jj][r][7] = d1.w; } }
#pragma unroll 1
        for (int bt = 0; bt < 5; ++bt) {
            u32x4 rg[2][7];
#pragma unroll
            for (int jj = 0; jj < 2; ++jj)
#pragma unroll
                for (int k = 0; k < 7; ++k) { const int rr = bt * 7 + k; const bool valid = (t0 - 30 + rr >= 0) && (rr < 30 + R);
                    const u32x4 v = *(const u32x4*)(glu + (size_t)(valid ? mbase - 30 + rr : mbase) * 1024 + (lane + 64 * jj) * 8); rg[jj][k] = valid ? v : (u32x4){0u, 0u, 0u, 0u}; }
#pragma unroll
            for (int jj = 0; jj < 2; ++jj) { const int ch0 = (lane + 64 * jj) * 8;
#pragma unroll
                for (int k = 0; k < 7; ++k) { const int rr = bt * 7 + k; float x[8]; unpack8(rg[jj][k], x);
#pragma unroll
                    for (int r = 0; r < 5; ++r) { const int j = rr - r; if (j >= 0 && j <= 30) {
                        const LAS float* wp = dwl + j * 1024 + ch0; const f32x4 w0 = *(const LAS f32x4*)wp, w1 = *(const LAS f32x4*)(wp + 4);
                        y[jj][r][0] += w0.x * x[0]; y[jj][r][1] += w0.y * x[1]; y[jj][r][2] += w0.z * x[2]; y[jj][r][3] += w0.w * x[3]; y[jj][r][4] += w1.x * x[4]; y[jj][r][5] += w1.y * x[5]; y[jj][r][6] += w1.z * x[6]; y[jj][r][7] += w1.w * x[7]; } } } }
        }
        if (t0 + R > SEQ - 30) {
#pragma unroll
            for (int jj = 0; jj < 2; ++jj) { const int ch0 = (lane + 64 * jj) * 8;
                for (int r = 0; r < R; ++r) if (t0 + r >= SEQ - 30) { float c8[8]; const u32x4 v = *(const u32x4*)(glu + (size_t)(mbase + r) * 1024 + ch0); unpack8(v, c8);
                    float* op = out + O_CP + (((size_t)o * BP + b) * 30 + (t0 + r - (SEQ - 30))) * 1024 + ch0;
                    *(f32x4*)op = (f32x4){c8[0], c8[1], c8[2], c8[3]}; *(f32x4*)(op + 4) = (f32x4){c8[4], c8[5], c8[6], c8[7]}; } } }
        float sm[5], sq[5];
#pragma unroll
        for (int r = 0; r < 5; ++r) { float a = 0.f;
#pragma unroll
            for (int jj = 0; jj < 2; ++jj)
#pragma unroll
                for (int i = 0; i < 8; ++i) a += y[jj][r][i];
            sm[r] = a; }
#pragma unroll
        for (int of = 1; of < 64; of <<= 1) {
#pragma unroll
            for (int r = 0; r < 5; ++r) sm[r] += __shfl_xor(sm[r], of); }
#pragma unroll
        for (int r = 0; r < 5; ++r) { const float mu = sm[r] * (1.0f / 1024.f); float a = 0.f;
#pragma unroll
            for (int jj = 0; jj < 2; ++jj)
#pragma unroll
                for (int i = 0; i < 8; ++i) { y[jj][r][i] -= mu; a += y[jj][r][i] * y[jj][r][i]; }
            sq[r] = a; }
#pragma unroll
        for (int of = 1; of < 64; of <<= 1) {
#pragma unroll
            for (int r = 0; r < 5; ++r) sq[r] += __shfl_xor(sq[r], of); }
#pragma unroll
        for (int jj = 0; jj < 2; ++jj) { const int ch0 = (lane + 64 * jj) * 8;
            const f32x4 g0 = *(const f32x4*)(lng + ch0), g1 = *(const f32x4*)(lng + ch0 + 4), b0 = *(const f32x4*)(lnb + ch0), b1 = *(const f32x4*)(lnb + ch0 + 4);
            const float gg[8] = {g0.x, g0.y, g0.z, g0.w, g1.x, g1.y, g1.z, g1.w}, bb[8] = {b0.x, b0.y, b0.z, b0.w, b1.x, b1.y, b1.z, b1.w};
#pragma unroll
            for (int r = 0; r < 5; ++r) if (r < R) { const float rstd = rsqrtf(sq[r] * (1.0f / 1024.f) + EPS); float c[8];
#pragma unroll
                for (int i = 0; i < 8; ++i) c[i] = siluf_(y[jj][r][i] * rstd * gg[i] + bb[i]);
                *(u32x4*)(cat + (size_t)(mbase + r) * 2048 + ch0) = pack8(c); } }
      }
    }
    asm volatile("" ::: "memory"); __builtin_amdgcn_sched_barrier(0);
    for (int task = gw; task < BP * GPS + BS; task += NGW) {
      if (task >= BP * GPS) {
        const int m = MPR + task - BP * GPS; const bool prompt = false; const int b = m - MPR, t = 0;
#pragma unroll
        for (int jj = 0; jj < 6; ++jj) {
            const int ch0 = (lane + 64 * jj) * 8; float a[8], cur[8];
#pragma unroll
            for (int i = 0; i < 8; ++i) a[i] = 0.f;
#pragma unroll
            for (int j = 0; j < 4; ++j) {
                float x[8]; bool have = true;
                if (j == 3 || prompt) { const int tt = t - 3 + j; if (tt >= 0) { const u32x4 r = *(const u32x4*)(qkv + (size_t)(m - 3 + j) * 3072 + ch0); unpack8(r, x); } else have = false; }
                else { const float* hp = sdn + ((size_t)b * 3 + j) * 3072 + ch0; const f32x4 h0 = *(const f32x4*)hp, h1 = *(const f32x4*)(hp + 4); x[0] = h0.x; x[1] = h0.y; x[2] = h0.z; x[3] = h0.w; x[4] = h1.x; x[5] = h1.y; x[6] = h1.z; x[7] = h1.w; }
                if (have) { const f32x4 w0 = *(const f32x4*)(cw + j * 3072 + ch0), w1 = *(const f32x4*)(cw + j * 3072 + ch0 + 4);
                    a[0] += w0.x * x[0]; a[1] += w0.y * x[1]; a[2] += w0.z * x[2]; a[3] += w0.w * x[3]; a[4] += w1.x * x[4]; a[5] += w1.y * x[5]; a[6] += w1.z * x[6]; a[7] += w1.w * x[7];
                    if (j == 3) {
#pragma unroll
                        for (int i = 0; i < 8; ++i) cur[i] = x[i]; } }
            }
            float ss = 0.f;
#pragma unroll
            for (int i = 0; i < 8; ++i) { a[i] = siluf_(a[i]); ss += a[i] * a[i]; }
            if (jj < 4) { ss = grp16_sum(ss); float r = rsqrtf(ss + EPS); if (jj < 2) r *= 0.08838834764831845f;
#pragma unroll
                for (int i = 0; i < 8; ++i) a[i] *= r; }
            *(u32x4*)(qkvc + (size_t)m * 3072 + ch0) = pack8(a);
            if (prompt) { if (t >= SEQ - 3) { float* op = out + O_DCP + (((size_t)o * BP + b) * 3 + (t - (SEQ - 3))) * 3072 + ch0;
                    *(f32x4*)op = (f32x4){cur[0], cur[1], cur[2], cur[3]}; *(f32x4*)(op + 4) = (f32x4){cur[4], cur[5], cur[6], cur[7]}; } }
            else { float* ob = out + O_DCS + ((size_t)o * BS + b) * 3 * 3072 + ch0;
                *(f32x4*)(ob + 2 * 3072) = (f32x4){cur[0], cur[1], cur[2], cur[3]}; *(f32x4*)(ob + 2 * 3072 + 4) = (f32x4){cur[4], cur[5], cur[6], cur[7]}; }
        }
        if (lane < 8) { const float av = AB[(size_t)m * 16 + lane] + dtb[lane], bv = AB[(size_t)m * 16 + 8 + lane];
            const float sp = av > 20.f ? av : log1pf(expf(av));
            Gg[(size_t)m * 8 + lane] = -expf(alog[lane]) * sp; Bt[(size_t)m * 8 + lane] = 1.0f / (1.0f + expf(-bv)); }
      }
      else {
        const int b = task / GPS, gi = task - b * GPS, t0 = gi * 5, R = (SEQ - t0) < 5 ? (SEQ - t0) : 5, mbase = b * SEQ + t0;
#pragma unroll 1
        for (int jj = 0; jj < 6; ++jj) {
            const int ch0 = (lane + 64 * jj) * 8;
            f32x4 w[4][2];
#pragma unroll
            for (int j = 0; j < 4; ++j) { w[j][0] = *(const f32x4*)(cw + j * 3072 + ch0); w[j][1] = *(const f32x4*)(cw + j * 3072 + ch0 + 4); }
            u32x4 rg[8];
#pragma unroll
            for (int rr = 0; rr < 8; ++rr) { const bool valid = (t0 - 3 + rr >= 0) && (rr < 3 + R);
                const u32x4 v = *(const u32x4*)(qkv + (size_t)(valid ? mbase - 3 + rr : mbase) * 3072 + ch0); rg[rr] = valid ? v : (u32x4){0u, 0u, 0u, 0u}; }
            float a[5][8];
#pragma unroll
            for (int r = 0; r < 5; ++r)
#pragma unroll
                for (int i = 0; i < 8; ++i) a[r][i] = 0.f;
#pragma unroll
            for (int rr = 0; rr < 8; ++rr) { float x[8]; unpack8(rg[rr], x);
#pragma unroll
                for (int r = 0; r < 5; ++r) { const int j = rr - r; if (j >= 0 && j <= 3) {
                    a[r][0] += w[j][0].x * x[0]; a[r][1] += w[j][0].y * x[1]; a[r][2] += w[j][0].z * x[2]; a[r][3] += w[j][0].w * x[3];
                    a[r][4] += w[j][1].x * x[4]; a[r][5] += w[j][1].y * x[5]; a[r][6] += w[j][1].z * x[6]; a[r][7] += w[j][1].w * x[7]; } } }
            float ss[5];
#pragma unroll
            for (int r = 0; r < 5; ++r) { float q = 0.f;
#pragma unroll
                for (int i = 0; i < 8; ++i) { a[r][i] = siluf_(a[r][i]); q += a[r][i] * a[r][i]; }
                ss[r] = q; }
            if (jj < 4) {
#pragma unroll
                for (int of = 1; of < 16; of <<= 1) {
#pragma unroll
                    for (int r = 0; r < 5; ++r) ss[r] += __shfl_xor(ss[r], of); }
#pragma unroll
                for (int r = 0; r < 5; ++r) { float sc = rsqrtf(ss[r] + EPS); if (jj < 2) sc *= 0.08838834764831845f;
#pragma unroll
                    for (int i = 0; i < 8; ++i) a[r][i] *= sc; } }
#pragma unroll
            for (int r = 0; r < 5; ++r) if (r < R) *(u32x4*)(qkvc + (size_t)(mbase + r) * 3072 + ch0) = pack8(a[r]);
            if (t0 + R > SEQ - 3) {
#pragma unroll
                for (int r = 0; r < 5; ++r) if (r < R && t0 + r >= SEQ - 3) { float c8[8]; unpack8(rg[r + 3], c8);
                    float* op = out + O_DCP + (((size_t)o * BP + b) * 3 + (t0 + r - (SEQ - 3))) * 3072 + ch0;
                    *(f32x4*)op = (f32x4){c8[0], c8[1], c8[2], c8[3]}; *(f32x4*)(op + 4) = (f32x4){c8[4], c8[5], c8[6], c8[7]}; } }
        }
        if (lane < 40) { const int r = lane >> 3, hh = lane & 7; if (r < R) { const int m = mbase + r;
            const float av = AB[(size_t)m * 16 + hh] + dtb[hh], bv = AB[(size_t)m * 16 + 8 + hh];
            const float sp = av > 20.f ? av : log1pf(expf(av));
            Gg[(size_t)m * 8 + hh] = -expf(alog[hh]) * sp; Bt[(size_t)m * 8 + hh] = 1.0f / (1.0f + expf(-bv)); } }
      }
    }
}

__device__ __forceinline__ void phase_dn_intra(const Ctx& cx, PP P, int o, LAS unsigned char* lds) {
    const int tid = cx.tid, lane = tid & 63, l15 = lane & 15, quad = lane >> 4;
    const int hb = __builtin_amdgcn_readfirstlane(tid >> 8), htid = tid & 255, hw = __builtin_amdgcn_readfirstlane((tid >> 6) & 3);
    const int G = cx.G;
    unsigned char* ws = P->ws;
    const bf16_t* qkvc = (const bf16_t*)(ws + WS_MIX); const float* Gg = (const float*)(ws + WS_G); const float* Bt = (const float*)(ws + WS_BETA);
    float* CU = (float*)(ws + WS_CU); bf16_t* CW = (bf16_t*)(ws + WS_CW); bf16_t* CQD = (bf16_t*)(ws + WS_CQD); bf16_t* CKDT = (bf16_t*)(ws + WS_CKDT); bf16_t* CQK = (bf16_t*)(ws + WS_CQK); float* CGL = (float*)(ws + WS_CGL);
    LAS float* L = (LAS float*)lds + hb * 4352; LAS float* gcs = L + 4096; LAS float* bet = L + 4096 + 64;
    for (int p = cx.bid; p < 512; p += G) {
        const int ci = 2 * p + hb, bh = ci >> 5, n = ci & 31, b = bh >> 3, h = bh & 7, m0 = b * SEQ + n * 64;
        if (hw == 0) { float g = Gg[(size_t)(m0 + lane) * 8 + h];
#pragma unroll
            for (int off = 1; off < 64; off <<= 1) { const float tv = __shfl_up(g, off); if (lane >= off) g += tv; }
            gcs[lane] = g; bet[lane] = Bt[(size_t)(m0 + lane) * 8 + h]; }
        __syncthreads();
        {
            const int mt = hw; const bf16_t* rp = qkvc + (size_t)(m0 + 16 * mt + l15) * 3072 + h * 128;
            bf16x8 ak[4], aq[4];
#pragma unroll
            for (int ks = 0; ks < 4; ++ks) { aq[ks] = *(const bf16x8*)(rp + ks * 32 + quad * 8); ak[ks] = *(const bf16x8*)(rp + 1024 + ks * 32 + quad * 8); }
#pragma unroll
            for (int nt = 0; nt < 4; ++nt) {
                f32x4 accK = (f32x4){0.f, 0.f, 0.f, 0.f}, accQ = (f32x4){0.f, 0.f, 0.f, 0.f};
                if (nt <= mt) { const bf16_t* bp = qkvc + (size_t)(m0 + 16 * nt + l15) * 3072 + 1024 + h * 128;
#pragma unroll
                    for (int ks = 0; ks < 4; ++ks) { const bf16x8 bk = *(const bf16x8*)(bp + ks * 32 + quad * 8);
                        accK = __builtin_amdgcn_mfma_f32_16x16x32_bf16(ak[ks], bk, accK, 0, 0, 0); accQ = __builtin_amdgcn_mfma_f32_16x16x32_bf16(aq[ks], bk, accQ, 0, 0, 0); } }
                const int j = 16 * nt + l15; const float gj = gcs[j];
#pragma unroll
                for (int jj = 0; jj < 4; ++jj) { const int i = 16 * mt + quad * 4 + jj; const float dec = (j <= i) ? __expf(gcs[i] - gj) : 0.f;
                    L[i * 64 + j] = (j < i) ? bet[i] * accK[jj] * dec : 0.f;
                    CQK[(size_t)ci * 4096 + i * 64 + j] = (bf16_t)(cvt_pk_bf16(accQ[jj] * dec, 0.f) & 0xffff); }
            }
        }
        __syncthreads();
        asm volatile("" ::: "memory"); __builtin_amdgcn_sched_barrier(0);
        {
            const int c = htid; float x[64];
            const bf16_t* vp = qkvc + (size_t)m0 * 3072 + (c < 128 ? 2048 + h * 128 + c : 1024 + h * 128 + (c - 128));
#pragma unroll
            for (int i = 0; i < 64; ++i) { const float r = bf1(*vp); vp += 3072; asm volatile("" : "+v"(vp)); const float sc = c < 128 ? bet[i] : bet[i] * __expf(gcs[i]); x[i] = r * sc; }
#pragma unroll
            for (int i = 1; i < 64; ++i) { float a0 = 0.f, a1 = 0.f, a2 = 0.f, a3 = 0.f;
#pragma unroll
                for (int j4 = 0; j4 < (i + 3) / 4; ++j4) { const f32x4 l = *(const LAS f32x4*)(L + i * 64 + j4 * 4);
                    a0 += l.x * x[j4 * 4 + 0]; if (j4 * 4 + 1 < i) a1 += l.y * x[j4 * 4 + 1]; if (j4 * 4 + 2 < i) a2 += l.z * x[j4 * 4 + 2]; if (j4 * 4 + 3 < i) a3 += l.w * x[j4 * 4 + 3];
                    if (j4 == 7) asm volatile("" ::: "memory"); }
                x[i] = x[i] - ((a0 + a1) + (a2 + a3)); asm volatile("" ::: "memory"); }
            if (c < 128) { float* up = CU + (size_t)ci * 8192 + c;
#pragma unroll
                for (int i = 0; i < 64; ++i) { *up = x[i]; up += 128; asm volatile("" : "+v"(up)); } }
            else { bf16_t* wp = CW + (size_t)ci * 8192 + (c - 128);
#pragma unroll
                for (int i = 0; i < 64; ++i) { *wp = (bf16_t)(cvt_pk_bf16(x[i], 0.f) & 0xffff); wp += 128; asm volatile("" : "+v"(wp)); } }
        }
        asm volatile("" ::: "memory"); __builtin_amdgcn_sched_barrier(0);
        {
            const float glast = gcs[63];
#pragma unroll
            for (int it = 0; it < 4; ++it) { const int idx = htid + 256 * it, i = idx >> 4, dq = idx & 15; float f[8];
                const u32x4 r = *(const u32x4*)(qkvc + (size_t)(m0 + i) * 3072 + h * 128 + dq * 8); unpack8(r, f); const float eg = __expf(gcs[i]);
#pragma unroll
                for (int k = 0; k < 8; ++k) f[k] *= eg;
                *(u32x4*)(CQD + (size_t)ci * 8192 + i * 128 + dq * 8) = pack8(f); }
#pragma unroll
            for (int it = 0; it < 4; ++it) { const int idx = htid + 256 * it, d = idx & 127, ig = idx >> 7; float f[8];
#pragma unroll
                for (int ii = 0; ii < 8; ++ii) { const int i = ig * 8 + ii; f[ii] = bf1(qkvc[(size_t)(m0 + i) * 3072 + 1024 + h * 128 + d]) * __expf(glast - gcs[i]); }
                *(u32x4*)(CKDT + (size_t)ci * 8192 + d * 64 + ig * 8) = pack8(f); }
            if (htid == 0) CGL[ci] = __expf(glast);
        }
        __syncthreads();
    }
}
__device__ __forceinline__ void phase_dn_sample(const Ctx& cx, PP P, int o, LAS unsigned char* lds) {
    const int tid = cx.tid; const int G = cx.G; unsigned char* ws = P->ws;
    const bf16_t* qkvc = (const bf16_t*)(ws + WS_MIX); const float* Gg = (const float*)(ws + WS_G); const float* Bt = (const float*)(ws + WS_BETA);
    const float* S0 = P->in[5] + (size_t)o * BS * 8 * 16384; float* Sout = P->out + O_SS + (size_t)o * BS * 8 * 16384; float* O = (float*)(ws + WS_O);
    LAS float* sq = (LAS float*)lds; LAS float* sk = sq + 128; LAS float* sv = sk + 128; LAS float* red = sv + 128;
    const bf16_t* zgp = (const bf16_t*)(ws + WS_ZG); bf16_t* catp = (bf16_t*)(ws + WS_CAT); const float* ngp = P->in[25] + o * 128;
    for (int task = cx.bid; task < BS * 8; task += G) {
        const int b = task >> 3, h = task & 7, m = MPR + b;
        if (tid < 384) { const int which = tid >> 7, d = tid & 127; sq[which * 128 + d] = bf1(qkvc[(size_t)m * 3072 + which * 1024 + h * 128 + d]); }
        __syncthreads();
        const int e = tid & 127, part = tid >> 7;
        const float* sp = S0 + (size_t)task * 16384 + (size_t)(part * 32) * 128 + e;
        float s[32]; float ks = 0.f, qs = 0.f, qk = 0.f;
#pragma unroll
        for (int d = 0; d < 32; ++d) { s[d] = *sp; sp += 128; asm volatile("" : "+v"(sp)); }
#pragma unroll
        for (int d = 0; d < 32; ++d) { ks += sk[part * 32 + d] * s[d]; qs += sq[part * 32 + d] * s[d]; }
        if (tid < 64) { const float pq = wave_sum(sq[tid] * sk[tid] + sq[tid + 64] * sk[tid + 64]); if (tid == 0) red[1024] = pq; }
        red[part * 128 + e] = ks; red[512 + part * 128 + e] = qs;
        __syncthreads();
        qk = red[1024];
        const float ksum = red[e] + red[128 + e] + red[256 + e] + red[384 + e], qsum = red[512 + e] + red[640 + e] + red[768 + e] + red[896 + e];
        const float g = Gg[(size_t)m * 8 + h], beta = Bt[(size_t)m * 8 + h], eg = __expf(g);
        const float vnew = beta * (sv[e] - eg * ksum);
        float* op = Sout + (size_t)task * 16384 + (size_t)(part * 32) * 128 + e;
#pragma unroll
        for (int d = 0; d < 32; ++d) { *op = eg * s[d] + sk[part * 32 + d] * vnew; op += 128; asm volatile("" : "+v"(op)); }
        const float oval = eg * qsum + qk * vnew;
        if (part == 0) { const float p2 = wave_sum(oval * oval); if ((tid & 63) == 0) red[1032 + (tid >> 6)] = p2; }
        __syncthreads();
        if (part == 0) { const float rs = rsqrtf((red[1032] + red[1033]) * (1.0f / 128.f) + EPS);
            const float z = bf1(zgp[(size_t)m * 1024 + h * 128 + e]);
            catp[(size_t)m * 2048 + 1024 + h * 128 + e] = (bf16_t)(cvt_pk_bf16(oval * rs * ngp[e] * siluf_(z), 0.f) & 0xffff); }
        __syncthreads();
    }
}

struct ScanOps { bf16x8 a1[4], a2[2], a3[2]; f32x4 u; float gl; };
__device__ __forceinline__ void scan_load(ScanOps& o, int ci, int w, int l15, int quad, int e0, const float* CU, const bf16_t* CW, const bf16_t* CQD, const bf16_t* CKDT, const bf16_t* CQK, const float* CGL) {
    const int mt = w & 3;
    { const bf16_t* ap = (w < 4 ? CW : CQD) + (size_t)ci * 8192 + (16 * mt + l15) * 128;
#pragma unroll
      for (int ks = 0; ks < 4; ++ks) o.a1[ks] = *(const bf16x8*)(ap + ks * 32 + quad * 8); }
    o.u = (f32x4){0.f, 0.f, 0.f, 0.f};
#pragma unroll
    for (int ks = 0; ks < 2; ++ks) o.a2[ks] = (bf16x8){0, 0, 0, 0, 0, 0, 0, 0};
    if (w < 4) {
#pragma unroll
        for (int j = 0; j < 4; ++j) o.u[j] = CU[(size_t)ci * 8192 + (16 * mt + quad * 4 + j) * 128 + e0 + l15]; }
    else { const bf16_t* qp = CQK + (size_t)ci * 4096 + (16 * mt + l15) * 64;
#pragma unroll
        for (int ks = 0; ks < 2; ++ks) o.a2[ks] = *(const bf16x8*)(qp + ks * 32 + quad * 8); }
    { const bf16_t* kp = CKDT + (size_t)ci * 8192 + (16 * w + l15) * 64;
#pragma unroll
      for (int ks = 0; ks < 2; ++ks) o.a3[ks] = *(const bf16x8*)(kp + ks * 32 + quad * 8); }
    o.gl = CGL[ci];
}
#define SCAN_BAR() do { asm volatile("s_waitcnt lgkmcnt(0)" ::: "memory"); __builtin_amdgcn_s_barrier(); asm volatile("" ::: "memory"); } while (0)
__device__ __forceinline__ void phase_dn_scan(const Ctx& cx, PP P, int o, LAS unsigned char* lds) {
    const int tid = cx.tid, lane = tid & 63, l15 = lane & 15, quad = lane >> 4, w = __builtin_amdgcn_readfirstlane(tid >> 6);
    const int G = cx.G;
    unsigned char* ws = P->ws;
    const float* CU = (const float*)(ws + WS_CU); const bf16_t* CW = (const bf16_t*)(ws + WS_CW); const bf16_t* CQD = (const bf16_t*)(ws + WS_CQD); const bf16_t* CKDT = (const bf16_t*)(ws + WS_CKDT); const bf16_t* CQK = (const bf16_t*)(ws + WS_CQK); const float* CGL = (const float*)(ws + WS_CGL);
    float* O = (float*)(ws + WS_O);
    LAS bf16_t* ST = (LAS bf16_t*)lds;
    LAS bf16_t* VT = ST + 16 * 136;
    for (int task0 = cx.bid; task0 < 256; task0 += G) {
        const int task = (G == 256) ? ((task0 & 7) * 32 + (task0 >> 3)) : task0;
        const int bh = task >> 3, es = task & 7, e0 = es * 16, b = bh >> 3, h = bh & 7;
        const int mt = w & 3;
        f32x4 S = (f32x4){0.f, 0.f, 0.f, 0.f};
        f32x4 oacc = (f32x4){0.f, 0.f, 0.f, 0.f};
        ScanOps cur, nxt;
        scan_load(cur, bh * 32, w, l15, quad, e0, CU, CW, CQD, CKDT, CQK, CGL);
        for (int n = 0; n < 32; ++n) {
            const int m0 = b * SEQ + n * 64;
            scan_load(nxt, bh * 32 + (n < 31 ? n + 1 : n), w, l15, quad, e0, CU, CW, CQD, CKDT, CQK, CGL);
            { u32x2 sw; sw.x = cvt_pk_bf16(S[0], S[1]); sw.y = cvt_pk_bf16(S[2], S[3]); *(LAS u32x2*)(ST + l15 * 136 + 16 * w + quad * 4) = sw; }
            SCAN_BAR();
            { f32x4 acc = (f32x4){0.f, 0.f, 0.f, 0.f};
#pragma unroll
              for (int ks = 0; ks < 4; ++ks) { const bf16x8 bs = *(const LAS bf16x8*)(ST + l15 * 136 + ks * 32 + quad * 8); acc = __builtin_amdgcn_mfma_f32_16x16x32_bf16(cur.a1[ks], bs, acc, 0, 0, 0); }
              if (w < 4) { const f32x4 vn = cur.u - acc; u32x2 vw; vw.x = cvt_pk_bf16(vn[0], vn[1]); vw.y = cvt_pk_bf16(vn[2], vn[3]); *(LAS u32x2*)(VT + l15 * 72 + 16 * mt + quad * 4) = vw; }
              else oacc = acc; }
            SCAN_BAR();
            bf16x8 bv[2];
#pragma unroll
            for (int ks = 0; ks < 2; ++ks) bv[ks] = *(const LAS bf16x8*)(VT + l15 * 72 + ks * 32 + quad * 8);
            if (w >= 4) {
#pragma unroll
                for (int ks = 0; ks < 2; ++ks) oacc = __builtin_amdgcn_mfma_f32_16x16x32_bf16(cur.a2[ks], bv[ks], oacc, 0, 0, 0);
#pragma unroll
                for (int j = 0; j < 4; ++j) O[(size_t)(m0 + 16 * mt + quad * 4 + j) * 1024 + h * 128 + e0 + l15] = oacc[j]; }
            S = S * cur.gl;
#pragma unroll
            for (int ks = 0; ks < 2; ++ks) S = __builtin_amdgcn_mfma_f32_16x16x32_bf16(cur.a3[ks], bv[ks], S, 0, 0, 0);
            cur = nxt;
        }
        float* sp = P->out + O_SP + (((size_t)o * BP + b) * 8 + h) * 16384;
#pragma unroll
        for (int j = 0; j < 4; ++j) sp[(size_t)(16 * w + quad * 4 + j) * 128 + e0 + l15] = S[j];
        __syncthreads();
    }
}

__device__ __forceinline__ void phase_dn_gate(const Ctx& cx, PP P, int o) {
    const int tid = cx.tid, lane = tid & 63, wave = __builtin_amdgcn_readfirstlane(tid >> 6);
    const int gw = cx.bid * NWAVES + wave, NGW = cx.G * NWAVES;
    const float* O = (const float*)(P->ws + WS_O); const bf16_t* zg = (const bf16_t*)(P->ws + WS_ZG); bf16_t* cat = (bf16_t*)(P->ws + WS_CAT);
    const float* ng = P->in[25] + o * 128;
    for (int m = gw; m < MPR; m += 4 * NGW) {
        f32x4 ov[4][2][2]; u32x4 zv[4][2]; int mr[4]; bool ok[4];
#pragma unroll
        for (int k = 0; k < 4; ++k) { const int mk = m + k * NGW; ok[k] = mk < MPR; mr[k] = ok[k] ? mk : m;
#pragma unroll
            for (int jj = 0; jj < 2; ++jj) { const int ch0 = (lane + 64 * jj) * 8; ov[k][jj][0] = *(const f32x4*)(O + (size_t)mr[k] * 1024 + ch0); ov[k][jj][1] = *(const f32x4*)(O + (size_t)mr[k] * 1024 + ch0 + 4);
                zv[k][jj] = *(const u32x4*)(zg + (size_t)mr[k] * 1024 + ch0); } }
#pragma unroll
        for (int k = 0; k < 4; ++k)
#pragma unroll
            for (int jj = 0; jj < 2; ++jj) { const int ch0 = (lane + 64 * jj) * 8; const f32x4 o0 = ov[k][jj][0], o1 = ov[k][jj][1];
                float f[8] = {o0.x, o0.y, o0.z, o0.w, o1.x, o1.y, o1.z, o1.w}; float ss = 0.f;
#pragma unroll
                for (int i = 0; i < 8; ++i) ss += f[i] * f[i];
                const float rs = rsqrtf(grp16_sum(ss) * (1.0f / 128.f) + EPS);
                float z[8]; unpack8(zv[k][jj], z);
#pragma unroll
                for (int i = 0; i < 8; ++i) f[i] = f[i] * rs * ng[(ch0 & 127) + i] * siluf_(z[i]);
                if (ok[k]) *(u32x4*)(cat + (size_t)mr[k] * 2048 + 1024 + ch0) = pack8(f); }
    }
}

#define XB_TMO      128
#define XB_XCNT(j)  (256  + 64 * (j))
#define XB_XSUB(j)  (1280 + 64 * (j))
#define XB_XGEN(j)  (2304 + 64 * (j))
#define XB_TOP      3328
#define XB_TOPGEN   3392
#define XCD_BAR_WORDS 3456
#define XB_SPIN_CAP (1u << 20)
__device__ __forceinline__ unsigned xb_ld(unsigned* p)              { return __hip_atomic_load(p, __ATOMIC_RELAXED, __HIP_MEMORY_SCOPE_AGENT); }
__device__ __forceinline__ unsigned xb_add(unsigned* p, unsigned v) { return __hip_atomic_fetch_add(p, v, __ATOMIC_RELAXED, __HIP_MEMORY_SCOPE_AGENT); }
__device__ __forceinline__ unsigned xb_xcc_id() { return (unsigned)__builtin_amdgcn_s_getreg((3 << 11) | 20) & 0xFu; }
#define XB_SPIN(cond, bar) do { unsigned _sp = 0; while (cond) { __builtin_amdgcn_s_sleep(1); \
    if ((++_sp & 255u) == 0u) { if (xb_ld(&(bar)[XB_TMO])) break; if (_sp > XB_SPIN_CAP) { atomicAdd(&(bar)[XB_TMO], 1u); break; } } } } while (0)
struct XcdBarrier { unsigned* bar; unsigned x; volatile LAS unsigned* st; };
__device__ __forceinline__ XcdBarrier xcd_barrier_post(unsigned* bar, volatile LAS unsigned* st) {
    XcdBarrier b; b.bar = bar; b.x = xb_xcc_id(); b.st = st;
    if (threadIdx.x == 0) (void)xb_add(&bar[XB_XCNT(b.x)], 1u);
    return b;
}
__device__ __forceinline__ void xcd_barrier_complete(unsigned* bar, unsigned x, unsigned& nloc, unsigned& nx) {
    const unsigned G = gridDim.x * gridDim.y * gridDim.z;
    unsigned sum, cnt, mine, sp = 0u;
    for (;;) {
        sum = 0u; cnt = 0u; mine = 0u;
#pragma unroll
        for (unsigned j = 0; j < 16; ++j) { const unsigned c = xb_ld(&bar[XB_XCNT(j)]); sum += c; cnt += (c > 0u) ? 1u : 0u; mine = (j == x) ? c : mine; }
        if (sum == G) break;
        __builtin_amdgcn_s_sleep(1);
        if ((++sp & 255u) == 0u) { if (xb_ld(&bar[XB_TMO])) break; if (sp > XB_SPIN_CAP) { atomicAdd(&bar[XB_TMO], 1u); break; } }
    }
    nloc = mine > 0u ? mine : 1u; nx = cnt > 0u ? cnt : 1u;
}
__device__ __forceinline__ void xcd_barrier(const XcdBarrier& b) {
    asm volatile("s_waitcnt vmcnt(0)" ::: "memory");
    __syncthreads();
    if (threadIdx.x == 0) {
        unsigned* bar = b.bar;
        __builtin_amdgcn_s_waitcnt(0);
        unsigned nloc = b.st[0], nx = b.st[1];
        if (nloc == 0u) { xcd_barrier_complete(bar, b.x, nloc, nx); b.st[0] = nloc; b.st[1] = nx; }
        const unsigned old = xb_add(&bar[XB_XSUB(b.x)], 1u);
        const unsigned gen = old / nloc;
        if (old + 1u == (gen + 1u) * nloc) {
            __builtin_amdgcn_fence(__ATOMIC_RELEASE, "agent");
            asm volatile("s_waitcnt vmcnt(0)" ::: "memory");
            const unsigned og = xb_add(&bar[XB_TOP], 1u);
            const unsigned tg = og / nx;
            if (og + 1u == (tg + 1u) * nx) xb_add(&bar[XB_TOPGEN], 1u);
            else XB_SPIN(xb_ld(&bar[XB_TOPGEN]) == tg, bar);
            __builtin_amdgcn_fence(__ATOMIC_ACQUIRE, "agent");
            xb_add(&bar[XB_XGEN(b.x)], 1u);
            asm volatile("s_waitcnt vmcnt(0)" ::: "memory");
        } else {
            XB_SPIN(xb_ld(&bar[XB_XGEN(b.x)]) == gen, bar);
            __builtin_amdgcn_fence(__ATOMIC_ACQUIRE, "agent");
            asm volatile("s_waitcnt vmcnt(0)" ::: "memory");
        }
    }
    __syncthreads();
}

__device__ __forceinline__ void copy_rows_shift(const Ctx& cx, const float* src, float* dst, int nb, int rows_in, int rows_copy, int width4) {
    const int per_b = rows_copy * width4, total = nb * per_b;
    for (int i = (cx.G - 1 - cx.bid) * NTHR + cx.tid; i < total; i += cx.G * NTHR) { const int b = i / per_b, r = i - b * per_b;
        ((f32x4*)dst)[(size_t)b * rows_in * width4 + r] = ((const f32x4*)src)[(size_t)b * rows_in * width4 + width4 + r]; }
}
constexpr int NPHASES = 1 + 8 + 10 + 8 + 10 + 1;
__global__ void __launch_bounds__(NTHR, 2) mega_fwd(Params Pin) {
    extern __shared__ __attribute__((aligned(16))) unsigned char lds_raw[];
    LAS unsigned char* lds = (LAS unsigned char*)lds_raw;
    const __attribute__((address_space(4))) unsigned char* kp = (const __attribute__((address_space(4))) unsigned char*)__builtin_amdgcn_kernarg_segment_ptr();
    constexpr int nM = MPAD / 256;
    volatile LAS unsigned* bst = (volatile LAS unsigned*)(lds + 131072);
    if (threadIdx.x < 2) bst[threadIdx.x] = 0u;
    __syncthreads();
    XcdBarrier gbar; gbar.bar = nullptr; gbar.x = 0; gbar.st = bst;
    if (((PP)kp)->coop) gbar = xcd_barrier_post((unsigned*)(((PP)kp)->ws + WS_BAR), bst);
    const int ph_lo = ((PP)kp)->ph_lo, ph_hi = ((PP)kp)->ph_hi;
#ifdef EXTRA_SYNCS
    for (int i = 0; i < EXTRA_SYNCS; ++i) xcd_barrier(gbar);
#endif
    int did_rep = 0;
    for (int ph = ph_lo; ph < ph_hi; ++ph) {
        asm volatile("" : "+s"(kp));
        Ctx cx; cx.tid = threadIdx.x; cx.bid = blockIdx.x; cx.G = gridDim.x;
        asm volatile("" : "+v"(cx.tid)); asm volatile("" : "+s"(cx.bid)); asm volatile("" : "+s"(cx.G));
        PP P = (PP)kp;
        unsigned char* ws = P->ws;
        float* X = (float*)(ws + WS_X); bf16_t* H = (bf16_t*)(ws + WS_H); bf16_t* ACT = (bf16_t*)(ws + WS_ACT); bf16_t* CAT = (bf16_t*)(ws + WS_CAT);
        float* PX = (float*)(ws + WS_PARTX);
        int l, op;
        if (ph == 0) { l = 0; op = 10; }
        else if (ph == NPHASES - 1) { l = 0; op = 11; }
        else { int r = ph - 1; const int pair = r / 18; r %= 18;
            if (r < 8) { l = 2 * pair; op = r < 4 ? r : r + 2; }
            else { l = 2 * pair + 1; op = r - 8; } }
        const bool even = (l & 1) == 0; const int e = l >> 1;
#ifndef OPMASK
#define OPMASK 0xfff
#endif
#ifndef REPMASK
#define REPMASK 0
#endif
        if (!(((OPMASK) >> op) & 1)) continue;
        const bool dry = REPMASK && ((REPMASK >> op) & 1) && !did_rep;
        switch (op) {
        case 10: phase_prep(cx, P, lds); phase_first_norm(cx, P, X, P->in[6], H); break;
        case 11: phase_rmsnorm<true>(cx, X, P->in[8], nullptr, P->out + O_YP, PX, 44, dry, lds); break;
        case 0: if (l > 0) phase_rmsnorm<false>(cx, X, P->in[6] + (size_t)l * D, H, nullptr, PX, l > 0 ? 44 : 0, dry, lds); break;
        case 7: phase_rmsnorm<false>(cx, X, P->in[7] + (size_t)l * D, H, nullptr, PX, 16, dry, lds); break;
        case 1:
            if (even) { pg8::StaticSched S; S.init(cx, H, (bf16_t*)(ws + WS_WEVIN) + (size_t)e * EV_IN * 2048, 2048, 2048, nM, EV_IN / 256, 2048, 0);
                pg8::EpiEvenIn E{(bf16_t*)(ws + WS_ABUF), (bf16_t*)(ws + WS_UV)}; pg8::gemm_phase(cx, lds, S, E);
                copy_rows_shift(cx, P->in[2] + (size_t)e * BS * 15 * 1024, P->out + O_PS + (size_t)e * BS * 15 * 1024, BS, 15, 14, 256);
                if (l == 0) convert_slot(cx, P, lds, 1, 0, DEF1_A, 140, 116); else convert_slot(cx, P, lds, 3, 0, DEF3_A, 140, 116); }
            else { pg8::StaticSched S; S.init(cx, H, (bf16_t*)(ws + WS_WODIN) + (size_t)e * OD_INM * 2048, 2048, 2048, nM, OD_INM / 256, 2048, 0);
                pg8::EpiOddIn E{(bf16_t*)(ws + WS_ABUF), (bf16_t*)(ws + WS_UV), (bf16_t*)(ws + WS_ZG)}; pg8::gemm_phase(cx, lds, S, E);
                phase_ab(cx, P, e);
                copy_rows_shift(cx, P->in[3] + (size_t)e * BS * 30 * 1024, P->out + O_CS + (size_t)e * BS * 30 * 1024, BS, 30, 29, 256);
                copy_rows_shift(cx, P->in[4] + (size_t)e * BS * 3 * 3072, P->out + O_DCS + (size_t)e * BS * 3 * 3072, BS, 3, 2, 768);
                if (l == 1) convert_slot(cx, P, lds, 2, 0, DEF2_A, 24, 166); }
            break;
        case 2: if (even) phase_even_prep(cx, P, e); else phase_odd_prep(cx, P, e, lds); break;
        case 3:
            if (even) {
#ifndef DBG_NO_POOL
                pg8::StaticSched S; S.init(cx, ws + WS_MIX, (bf16_t*)(ws + WS_WPOOL) + (size_t)e * 1024 * 256, 1024, 256, nM, 4, 256, 512);
                pg8::EpiPool E{CAT, P->in[11] + e * 1024}; pg8::gemm_phase(cx, lds, S, E);
                __syncthreads();
#endif
#ifndef DBG_NO_SGU
                phase_sgu(cx, P, e, lds);
#endif
            }
#ifndef DBG_NO_DNI
            else phase_dn_intra(cx, P, e, lds);
#endif
            break;
        case 4: phase_dn_sample(cx, P, e, lds); __syncthreads(); phase_dn_scan(cx, P, e, lds); break;
        case 5: phase_dn_gate(cx, P, e); break;
        case 6: { const bf16_t* Wt = (even ? (bf16_t*)(ws + WS_WEVOUT) : (bf16_t*)(ws + WS_WODOUT)) + (size_t)e * 2048 * 2048;
                pg8::ResidSched S; S.init(cx, CAT, Wt, 2048, 2048); pg8::EpiResidX E{{X, dry}, {PX, dry}}; pg8::gemm_phase(cx, lds, S, E); } break;
        case 8: { pg8::StaticSched S; S.init(cx, H, (bf16_t*)(ws + WS_WUP) + (size_t)l * 2 * DFF * 2048, 2048, 2048, nM, 2 * DFF / 256, 2048, 0);
                pg8::EpiUp E{ACT}; pg8::gemm_phase(cx, lds, S, E);
                if (l == 0) convert_slot(cx, P, lds, 1, DEF1_A, DEF1_B, 172, 84); else if (l == 1) convert_slot(cx, P, lds, 2, DEF2_A, DEF2_B, 172, 84); else if (l == 2) convert_slot(cx, P, lds, 3, DEF3_A, DEF3_B, 172, 84); } break;
        case 9: { const bf16_t* Wt = (bf16_t*)(ws + WS_WDOWN) + (size_t)l * 2048 * DFF;
                pg8::ResidSched S; S.init(cx, ACT, Wt, DFF, DFF); pg8::EpiResidX E{{X, dry}, {PX, dry}}; pg8::gemm_phase(cx, lds, S, E); } break;
        default: break;
        }
        if (REPMASK) { if (((REPMASK >> op) & 1) && !did_rep) { did_rep = 1; --ph; } else did_rep = 0; }
        if (ph + 1 < ph_hi && !(op == 0 && l == 0)) { if (P->coop) { if (ph == 0) cg::this_grid().sync(); else xcd_barrier(gbar); } }
    }
}

#ifndef MK_COOP
#define MK_COOP 1
#endif
extern "C" void kernel_launch(void* const* d_in, const int* in_sizes, int n_in, void* d_out, int out_size, void* d_ws, size_t ws_size, hipStream_t stream) {
    static int grid = 0;
    if (grid == 0) {
        if (n_in != 29 || (size_t)out_size != O_END || ws_size < WS_END) { fprintf(stderr, "kernel_launch: unexpected shapes n_in %d out %d ws %zu (need %zu)\n", n_in, out_size, ws_size, (size_t)WS_END); grid = -1; return; }
        int dev = 0, cus = 0, per_cu = 0;
        hipGetDevice(&dev); hipDeviceGetAttribute(&cus, hipDeviceAttributeMultiprocessorCount, dev);
        if (hipFuncSetAttribute((const void*)mega_fwd, hipFuncAttributeMaxDynamicSharedMemorySize, LDS_BYTES) != hipSuccess) { fprintf(stderr, "kernel_launch: hipFuncSetAttribute failed\n"); grid = -1; return; }
        if (hipOccupancyMaxActiveBlocksPerMultiprocessor(&per_cu, (const void*)mega_fwd, NTHR, LDS_BYTES) != hipSuccess || per_cu < 1) { fprintf(stderr, "kernel_launch: occupancy query says %d\n", per_cu); per_cu = 1; }
        (void)hipGetLastError();
        grid = cus < 256 ? cus : 256;
        if (grid <= 0) grid = 256;
    }
    if (grid < 0) return;
    Params p{};
    for (int i = 0; i < 29; ++i) p.in[i] = (const float*)d_in[i];
    p.out = (float*)d_out; p.ws = (unsigned char*)d_ws; p.pad = 0;
#if MK_COOP
    p.ph_lo = 0; p.ph_hi = NPHASES; p.coop = 1;
    if (hipMemsetAsync((char*)d_ws + WS_BAR, 0, WS_BAR_BYTES, stream) != hipSuccess) { fprintf(stderr, "kernel_launch: memset of barrier words failed\n"); return; }
    void* args[] = {&p};
    hipError_t e = hipLaunchCooperativeKernel((const void*)mega_fwd, dim3(grid), dim3(NTHR), args, LDS_BYTES, stream);
    if (e != hipSuccess) fprintf(stderr, "cooperative launch failed: %s (grid %d)\n", hipGetErrorString(e), grid);
#else
    p.coop = 0;
    for (int ph = 0; ph < NPHASES; ++ph) { p.ph_lo = ph; p.ph_hi = ph + 1; hipLaunchKernelGGL(mega_fwd, dim3(grid), dim3(NTHR), LDS_BYTES, stream, p); }
#endif
}
```

```cpp
#include <hip/hip_runtime.h>
#include <hip/hip_cooperative_groups.h>
#include <cstdio>
namespace cg = cooperative_groups;

#define LAS __attribute__((address_space(3)))
typedef unsigned short bf16_t;
typedef short bf16x8 __attribute__((ext_vector_type(8)));
typedef float f32x4 __attribute__((ext_vector_type(4)));
typedef float f32x2 __attribute__((ext_vector_type(2)));
typedef unsigned u32x4 __attribute__((ext_vector_type(4)));
typedef unsigned u32x2 __attribute__((ext_vector_type(2)));

constexpr int D = 2048, SEQ = 2048, BP = 4, MPR = BP * SEQ, BS = 128, MT = MPR + BS, MPAD = 8448;
constexpr int DFF = 5632, EV_IN = 3072, OD_IN = 6160, OD_INM = 6144;
constexpr float EPS = 1e-6f;
constexpr int NTHR = 512, NWAVES = 8;
constexpr int LDS_BYTES = 131072 + 1024;

constexpr size_t O_YP = 0;
constexpr size_t O_YS = O_YP + (size_t)MPR * D;
constexpr size_t O_PP = O_YS + (size_t)BS * D;
constexpr size_t O_PS = O_PP + (size_t)2 * BP * 15 * 1024;
constexpr size_t O_SV = O_PS + (size_t)2 * BS * 15 * 1024;
constexpr size_t O_CP = O_SV + (size_t)2 * BS * 1024;
constexpr size_t O_CS = O_CP + (size_t)2 * BP * 30 * 1024;
constexpr size_t O_DCP = O_CS + (size_t)2 * BS * 30 * 1024;
constexpr size_t O_DCS = O_DCP + (size_t)2 * BP * 3 * 3072;
constexpr size_t O_SP = O_DCS + (size_t)2 * BS * 3 * 3072;
constexpr size_t O_SS = O_SP + (size_t)2 * BP * 8 * 128 * 128;
constexpr size_t O_END = O_SS + (size_t)2 * BS * 8 * 128 * 128;

constexpr size_t al(size_t x) { return (x + 4095) & ~(size_t)4095; }
constexpr size_t WS_X = 0;
constexpr size_t WS_H = WS_X + al((size_t)MPAD * D * 4);
constexpr size_t WS_ACT = WS_H + al((size_t)MPAD * D * 2);
constexpr size_t WS_CAT = WS_ACT + al((size_t)MPAD * DFF * 2);
constexpr size_t WS_ABUF = WS_CAT + al((size_t)MPAD * D * 2);
constexpr size_t WS_UV = WS_ABUF + al((size_t)MPAD * 1024 * 2);
constexpr size_t WS_ZG = WS_UV + al((size_t)MPAD * 3072 * 2);
constexpr size_t WS_MIX = WS_ZG + al((size_t)MPAD * 1024 * 2);
constexpr size_t WS_VN = WS_MIX + al((size_t)MPAD * 3072 * 2);
constexpr size_t WS_AB = WS_VN + al((size_t)MPAD * 1024 * 2);
constexpr size_t WS_G = WS_AB + al((size_t)MPAD * 16 * 4);
constexpr size_t WS_BETA = WS_G + al((size_t)MPAD * 8 * 4);
constexpr size_t WS_O = WS_BETA + al((size_t)MPAD * 8 * 4);
constexpr size_t WS_CU = WS_O + al((size_t)MPAD * 1024 * 4);
constexpr size_t WS_CW = WS_CU + al((size_t)1024 * 8192 * 4);
constexpr size_t WS_CQD = WS_CW + al((size_t)1024 * 8192 * 2);
constexpr size_t WS_CKDT = WS_CQD + al((size_t)1024 * 8192 * 2);
constexpr size_t WS_CQK = WS_CKDT + al((size_t)1024 * 8192 * 2);
constexpr size_t WS_CGL = WS_CQK + al((size_t)1024 * 4096 * 2);
constexpr size_t WS_WEVIN = WS_CGL + al(4096);
constexpr size_t WS_WEVOUT = WS_WEVIN + al((size_t)2 * 3072 * 2048 * 2);
constexpr size_t WS_WODIN = WS_WEVOUT + al((size_t)2 * 2048 * 2048 * 2);
constexpr size_t WS_WODOUT = WS_WODIN + al((size_t)2 * 6144 * 2048 * 2);
constexpr size_t WS_WUP = WS_WODOUT + al((size_t)2 * 2048 * 2048 * 2);
constexpr size_t WS_WDOWN = WS_WUP + al((size_t)4 * 11264 * 2048 * 2);
constexpr size_t WS_WPOOL = WS_WDOWN + al((size_t)4 * 2048 * 5632 * 2);
constexpr size_t WS_PARTX = WS_WPOOL + al((size_t)2 * 1024 * 256 * 2);
constexpr size_t WS_WAB = WS_PARTX + al((size_t)256 * 32768 * 4);
constexpr size_t WS_BAR = WS_WAB + al((size_t)2 * 16 * 2048 * 2);
constexpr size_t WS_BAR_BYTES = 16384;
constexpr size_t WS_END = WS_BAR + WS_BAR_BYTES;

struct Params { const float* in[29]; float* out; unsigned char* ws; int ph_lo, ph_hi, coop, pad; };
typedef const __attribute__((address_space(4))) Params* PP;
struct Ctx { int tid, bid, G; };

__device__ __forceinline__ unsigned cvt_pk_bf16(float lo, float hi) { unsigned r; asm volatile("v_cvt_pk_bf16_f32 %0, %1, %2" : "=v"(r) : "v"(lo), "v"(hi)); return r; }
__device__ __forceinline__ float bf_lo(unsigned w) { return __uint_as_float(w << 16); }
__device__ __forceinline__ float bf_hi(unsigned w) { return __uint_as_float(w & 0xffff0000u); }
__device__ __forceinline__ float bf1(bf16_t h) { return __uint_as_float(((unsigned)h) << 16); }
__device__ __forceinline__ void unpack8(const u32x4 w, float (&f)[8]) { f[0] = bf_lo(w.x); f[1] = bf_hi(w.x); f[2] = bf_lo(w.y); f[3] = bf_hi(w.y); f[4] = bf_lo(w.z); f[5] = bf_hi(w.z); f[6] = bf_lo(w.w); f[7] = bf_hi(w.w); }
__device__ __forceinline__ u32x4 pack8(const float (&f)[8]) { u32x4 w; w.x = cvt_pk_bf16(f[0], f[1]); w.y = cvt_pk_bf16(f[2], f[3]); w.z = cvt_pk_bf16(f[4], f[5]); w.w = cvt_pk_bf16(f[6], f[7]); return w; }
__device__ __forceinline__ float sigmoidf_(float x) { return __builtin_amdgcn_rcpf(1.0f + __expf(-x)); }
__device__ __forceinline__ float siluf_(float x) { return x * sigmoidf_(x); }
__device__ __forceinline__ float wave_sum(float v) {
#pragma unroll
    for (int o = 1; o < 64; o <<= 1) v += __shfl_xor(v, o);
    return v;
}
__device__ __forceinline__ float grp16_sum(float v) {
#pragma unroll
    for (int o = 1; o < 16; o <<= 1) v += __shfl_xor(v, o);
    return v;
}
__device__ __forceinline__ f32x2 gelu_pk(f32x2 v) {
    const f32x2 av = __builtin_elementwise_abs(v), d = av * 0.2316418882f + 1.0f;
    f32x2 t; t.x = __builtin_amdgcn_rcpf(d.x); t.y = __builtin_amdgcn_rcpf(d.y);
    f32x2 q = t * 0.5307027145f + (-0.7265760135f); q = q * t + 0.7107068705f; q = q * t + (-0.142248368f); q = q * t + 0.127414796f; q = q * t;
    const f32x2 s = (v * v) * (-0.72134752044f);
    f32x2 e; e.x = __builtin_amdgcn_exp2f(s.x); e.y = __builtin_amdgcn_exp2f(s.y);
    const f32x2 m = v * (q * e), r = v - m;
    f32x2 o; o.x = v.x < 0.f ? m.x : r.x; o.y = v.y < 0.f ? m.y : r.y; return o;
}

namespace pg8 {
constexpr int BM = 256, BK = 64, HALF = 128, HTB = HALF * BK * 2, STAGE_BYTES = 8 * HTB, NXCD = 8, WGM = 4;
__device__ __forceinline__ int lds_byte(int r, int c) { const int st = (r >> 4) * 2 + (c >> 5), rr = r & 15, cc = c & 31, ob = rr * 64 + cc * 2; return st * 1024 + (ob ^ (((ob >> 9) & 1) << 5)); }
__device__ __forceinline__ void stage_rc(int b, int& R, int& C) { const int st = b / 1024, sb = b % 1024, swz = sb ^ (((sb >> 9) & 1) << 5); R = (st >> 1) * 16 + swz / 64; C = (st & 1) * 32 + (swz % 64) / 2; }
__device__ __forceinline__ int perm32(int rho) { const int n = rho >> 4, i = rho & 15; return 8 * (i >> 2) + 4 * n + (i & 3); }

struct Unit { int pm, pn, nt, pad; const char* A; const char* B; };

__device__ __forceinline__ void unit_pmpn(int wgid, int nM, int nN, int& pm, int& pn) {
    const int nig = WGM * nN, gid = wgid / nig, fm = gid * WGM, gsz = (nM - fm) < WGM ? (nM - fm) : WGM;
    pm = fm + ((wgid % nig) % gsz); pn = (wgid % nig) / gsz;
}
struct StaticSched {
    const char* A; const char* B; int lda, ldb, nM, nN, nwg, G, c, nt; size_t a_pn_stride;
    __device__ __forceinline__ void init(const Ctx& cx, const void* A_, const void* B_, int lda_, int ldb_, int nM_, int nN_, int K, size_t apn) {
        A = (const char*)A_; B = (const char*)B_; lda = lda_; ldb = ldb_; nM = nM_; nN = nN_; nwg = nM * nN; G = cx.G; c = cx.bid; nt = K / BK; a_pn_stride = apn; }
    __device__ __forceinline__ bool next(int i, Unit& u) const {
        const long L = (long)i * G + c; if (L >= nwg) return false;
        int wgid = (int)L; { const int q = nwg / NXCD, r = nwg % NXCD, xcd = wgid % NXCD, off = wgid / NXCD; wgid = (xcd < r ? xcd * (q + 1) : r * (q + 1) + (xcd - r) * q) + off; }
        unit_pmpn(wgid, nM, nN, u.pm, u.pn); u.nt = nt; u.pad = 0;
        u.A = A + (size_t)u.pm * BM * lda * 2 + (size_t)u.pn * a_pn_stride; u.B = B + (size_t)u.pn * BM * ldb * 2; return true;
    }
};
struct StreamKSched {
    const char* A; const char* B; int lda, ldb, pm_base, nN, ppu, p0, p1, u0, vc;
    __device__ __forceinline__ void init(const Ctx& cx, const void* A_, const void* B_, int lda_, int ldb_, int pm_base_, int nN_, int K) {
        A = (const char*)A_; B = (const char*)B_; lda = lda_; ldb = ldb_; pm_base = pm_base_; nN = nN_; ppu = K / (2 * BK);
        const int G = cx.G, bx = cx.bid; vc = (G % 8 == 0) ? (bx % 8) * (G / 8) + bx / 8 : bx;
        const long P = (long)nN * ppu; p0 = (int)((vc * P) / G); p1 = (int)(((vc + 1) * P) / G); u0 = p0 / ppu; }
    __device__ __forceinline__ bool next(int i, Unit& u) const {
        const int ui = u0 + i; const long lo = (long)ui * ppu; if (lo >= p1) return false;
        const int s = (int)(lo > p0 ? lo : p0), e = (int)((lo + ppu) < p1 ? (lo + ppu) : p1);
        u.pm = pm_base; u.pn = ui; u.nt = 2 * (e - s); u.pad = vc;
        const size_t koff = (size_t)(s - (int)lo) * 2 * BK * 2;
        u.A = A + (size_t)u.pm * BM * lda * 2 + koff; u.B = B + (size_t)u.pn * BM * ldb * 2 + koff; return true;
    }
};

struct ResidSched {
    StaticSched a; StreamKSched b; int na, lda, ldb;
    __device__ __forceinline__ void init(const Ctx& cx, const void* A_, const void* B_, int ld, int K) {
        a.init(cx, A_, B_, ld, ld, MPR / 256, 8, K, 0); b.init(cx, A_, B_, ld, ld, MPR / 256, 8, K); lda = ld; ldb = ld;
        na = (a.nwg - a.c + a.G - 1) / a.G; if (na < 0) na = 0; }
    __device__ __forceinline__ bool next(int i, Unit& u) const { if (i < na) return a.next(i, u); return b.next(i - na, u); }
};
template <class Epi, class Sched>
__device__ __forceinline__ void gemm_phase(const Ctx& cx, LAS unsigned char* lds, const Sched& S, const Epi& E) {
    const int tid = cx.tid, wid = __builtin_amdgcn_readfirstlane(tid >> 6), lane = tid & 63, wr = wid >> 2, wc = wid & 3, fr = lane & 15, fq = lane >> 4;
    const int lda = S.lda, ldb = S.ldb;
    unsigned voffA[2], voffB[2];
#pragma unroll
    for (int i = 0; i < 2; ++i) { int R, C; stage_rc(tid * 16 + i * 8192, R, C); const int Rb = Epi::PERM ? ((R & ~31) + perm32(R & 31)) : R;
        voffA[i] = (unsigned)(R * lda + C) * 2u; voffB[i] = (unsigned)(Rb * ldb + C) * 2u; }
    const size_t kstep = (size_t)(BK * 2);
    const size_t hstepA = (size_t)HALF * lda * 2, hstepB = (size_t)HALF * ldb * 2;
    const unsigned ldsw = (unsigned)wid * 1024u;
    const int aoff = lds_byte(wr * 64 + fr, fq * 8), boff = lds_byte(wc * 32 + fr, fq * 8);
#define PG8_SA(b, h) (((b) * 2 + (h)) * HTB)
#define PG8_SB(b, h) ((4 + (b) * 2 + (h)) * HTB)
#define PG8_STAGE(bufoff, gbase, voff) do { _Pragma("unroll") for (int _i = 0; _i < 2; ++_i) \
        __builtin_amdgcn_global_load_lds((const unsigned*)((const char*)(gbase) + (voff)[_i]), (LAS unsigned*)(lds + (bufoff) + ldsw + _i * 8192), 16, 0, 0); } while (0)
#define PG8_LDA(dst, b, h) do { _Pragma("unroll") for (int m = 0; m < 4; ++m) _Pragma("unroll") for (int k = 0; k < 2; ++k) dst[m][k] = *(const LAS bf16x8*)(lds + PG8_SA(b, h) + aoff + m * 2048 + k * 1024); } while (0)
#define PG8_LDB(dst, b, h) do { _Pragma("unroll") for (int n = 0; n < 2; ++n) _Pragma("unroll") for (int k = 0; k < 2; ++k) dst[n][k] = *(const LAS bf16x8*)(lds + PG8_SB(b, h) + boff + n * 2048 + k * 1024); } while (0)
#define PG8_MMA(ai, bj, At, Bt) do { __builtin_amdgcn_s_setprio(1); _Pragma("unroll") for (int m = 0; m < 4; ++m) _Pragma("unroll") for (int n = 0; n < 2; ++n) _Pragma("unroll") for (int k = 0; k < 2; ++k) \
        acc[ai][bj][m][n] = __builtin_amdgcn_mfma_f32_16x16x32_bf16(Bt[n][k], At[m][k], acc[ai][bj][m][n], 0, 0, 0); __builtin_amdgcn_s_setprio(0); } while (0)
#define PG8_WAIT_V(n) asm volatile("s_waitcnt vmcnt(" #n ")" ::: "memory")
#define PG8_WAIT_L(n) asm volatile("s_waitcnt lgkmcnt(" #n ")" ::: "memory")
#define PG8_BAR __builtin_amdgcn_s_barrier()
#define PG8_SCHED __builtin_amdgcn_sched_barrier(0)
    Unit cur, nxt; int ui = 0;
    if (!S.next(0, cur)) return;
    f32x4 acc[2][2][4][2];
#pragma unroll
    for (int a = 0; a < 2; ++a)
#pragma unroll
        for (int b = 0; b < 2; ++b)
#pragma unroll
            for (int m = 0; m < 4; ++m)
#pragma unroll
                for (int n = 0; n < 2; ++n) acc[a][b][m][n] = (f32x4){0.f, 0.f, 0.f, 0.f};
    bf16x8 At[4][2], B0[2][2], B1[2][2];
    const char* cA = cur.A; const char* cB = cur.B;
    PG8_STAGE(PG8_SB(0, 0), cB, voffB); PG8_STAGE(PG8_SA(0, 0), cA, voffA); PG8_STAGE(PG8_SB(0, 1), cB + hstepB, voffB); PG8_STAGE(PG8_SA(0, 1), cA + hstepA, voffA);
    if (wr == 1) PG8_BAR;
    PG8_WAIT_V(4); PG8_BAR;
    PG8_STAGE(PG8_SB(1, 0), cB + kstep, voffB); PG8_STAGE(PG8_SA(1, 0), cA + kstep, voffA); PG8_STAGE(PG8_SB(1, 1), cB + hstepB + kstep, voffB);
    PG8_WAIT_V(6); PG8_BAR;
    for (;;) {
        const bool has_next = S.next(ui + 1, nxt);
        const char* nA = has_next ? nxt.A : cA; const char* nB = has_next ? nxt.B : cB;
        const int nt = cur.nt;
        for (int t = 0; t < nt; t += 2) {
            const bool last = (t == nt - 2);
            const char* a1 = cA + (size_t)(t + 1) * kstep;
            const char* a2 = last ? nA : cA + (size_t)(t + 2) * kstep; const char* b2 = last ? nB : cB + (size_t)(t + 2) * kstep;
            const char* a3 = a2 + kstep; const char* b3 = b2 + kstep;
            PG8_LDB(B0, 0, 0); PG8_SCHED; PG8_LDA(At, 0, 0); PG8_STAGE(PG8_SA(1, 1), a1 + hstepA, voffA);
            PG8_WAIT_L(8); PG8_BAR; PG8_WAIT_L(0); PG8_MMA(0, 0, At, B0); PG8_BAR; PG8_SCHED;
            PG8_LDB(B1, 0, 1); PG8_STAGE(PG8_SB(0, 0), b2, voffB);
            PG8_BAR; PG8_WAIT_L(0); PG8_MMA(0, 1, At, B1); PG8_BAR;
            PG8_LDA(At, 0, 1); PG8_STAGE(PG8_SA(0, 0), a2, voffA);
            PG8_BAR; PG8_WAIT_L(0); PG8_MMA(1, 0, At, B0); PG8_BAR; PG8_SCHED;
            PG8_STAGE(PG8_SB(0, 1), b2 + hstepB, voffB);
            PG8_WAIT_V(6); PG8_BAR; PG8_MMA(1, 1, At, B1); PG8_BAR;
            PG8_LDB(B0, 1, 0); PG8_SCHED; PG8_LDA(At, 1, 0); PG8_STAGE(PG8_SA(0, 1), a2 + hstepA, voffA);
            PG8_WAIT_L(8); PG8_BAR; PG8_WAIT_L(0); PG8_MMA(0, 0, At, B0); PG8_BAR; PG8_SCHED;
            PG8_LDB(B1, 1, 1); PG8_STAGE(PG8_SB(1, 0), b3, voffB);
            PG8_BAR; PG8_WAIT_L(0); PG8_MMA(0, 1, At, B1); PG8_BAR;
            PG8_LDA(At, 1, 1); PG8_STAGE(PG8_SA(1, 0), a3, voffA);
            PG8_BAR; PG8_WAIT_L(0); PG8_MMA(1, 0, At, B0); PG8_BAR; PG8_SCHED;
            PG8_STAGE(PG8_SB(1, 1), b3 + hstepB, voffB);
            PG8_WAIT_V(6); PG8_BAR; PG8_MMA(1, 1, At, B1); PG8_BAR;
        }
        E(acc, cur, wr, wc, fr, fq);
        if (!has_next) break;
#pragma unroll
        for (int a = 0; a < 2; ++a)
#pragma unroll
            for (int b = 0; b < 2; ++b)
#pragma unroll
                for (int m = 0; m < 4; ++m)
#pragma unroll
                    for (int n = 0; n < 2; ++n) acc[a][b][m][n] = (f32x4){0.f, 0.f, 0.f, 0.f};
        cur = nxt; cA = nA; cB = nB; ++ui;
    }
    PG8_WAIT_V(0);
    if (wr == 0) PG8_BAR;
    PG8_BAR;
#undef PG8_SA
#undef PG8_SB
#undef PG8_STAGE
#undef PG8_LDA
#undef PG8_LDB
#undef PG8_MMA
#undef PG8_WAIT_V
#undef PG8_WAIT_L
#undef PG8_BAR
#undef PG8_SCHED
}
typedef f32x4 Acc[2][2][4][2];

__device__ __forceinline__ void store8(bf16_t* p, f32x4 v0, f32x4 v1) {
    u32x4 w; w.x = cvt_pk_bf16(v0[0], v0[1]); w.y = cvt_pk_bf16(v0[2], v0[3]); w.z = cvt_pk_bf16(v1[0], v1[1]); w.w = cvt_pk_bf16(v1[2], v1[3]); *(u32x4*)p = w; }
__device__ __forceinline__ f32x4 gelu4(f32x4 v) { f32x2 a = gelu_pk((f32x2){v[0], v[1]}), b = gelu_pk((f32x2){v[2], v[3]}); return (f32x4){a.x, a.y, b.x, b.y}; }
__device__ __forceinline__ f32x4 silu4(f32x4 v) { return (f32x4){siluf_(v[0]), siluf_(v[1]), siluf_(v[2]), siluf_(v[3])}; }
__device__ __forceinline__ f32x4 sigm4(f32x4 v) { return (f32x4){sigmoidf_(v[0]), sigmoidf_(v[1]), sigmoidf_(v[2]), sigmoidf_(v[3])}; }

struct EpiEvenIn {
    static constexpr bool PERM = true;
    bf16_t* abuf; bf16_t* uv;
    __device__ __forceinline__ void operator()(const Acc& acc, const Unit& u, int wr, int wc, int fr, int fq) const {
        const int row0 = u.pm * BM + wr * 64 + fr; const bool act = u.pn >= 4;
        bf16_t* base = act ? uv : abuf; const int ldc = act ? 2048 : 1024; const int col0 = (act ? (u.pn - 4) : u.pn) * BM + wc * 32 + 8 * fq;
#pragma unroll
        for (int ai = 0; ai < 2; ++ai)
#pragma unroll
            for (int m = 0; m < 4; ++m) { bf16_t* rowp = base + (size_t)(row0 + ai * HALF + m * 16) * ldc + col0;
#pragma unroll
                for (int bj = 0; bj < 2; ++bj) { f32x4 v0 = acc[ai][bj][m][0], v1 = acc[ai][bj][m][1];
                    if (act) { v0 = gelu4(v0); v1 = gelu4(v1); }
                    store8(rowp + bj * HALF, v0, v1); }
                asm volatile("" ::: "memory"); }
    }
};
struct EpiOddIn {
    static constexpr bool PERM = true;
    bf16_t* glu; bf16_t* qkv; bf16_t* zg;
    __device__ __forceinline__ void operator()(const Acc& acc, const Unit& u, int wr, int wc, int fr, int fq) const {
        const int row0 = u.pm * BM + wr * 64 + fr;
        if (u.pn < 8) {
            const int col0 = u.pn * 128 + wc * 32 + 8 * fq;
#pragma unroll
            for (int ai = 0; ai < 2; ++ai)
#pragma unroll
                for (int m = 0; m < 4; ++m) { bf16_t* rowp = glu + (size_t)(row0 + ai * HALF + m * 16) * 1024 + col0;
                    store8(rowp, acc[ai][0][m][0] * sigm4(acc[ai][1][m][0]), acc[ai][0][m][1] * sigm4(acc[ai][1][m][1])); asm volatile("" ::: "memory"); }
        } else {
            const bool isq = u.pn < 20; bf16_t* base = isq ? qkv : zg; const int ldc = isq ? 3072 : 1024; const int col0 = (isq ? (u.pn - 8) : (u.pn - 20)) * BM + wc * 32 + 8 * fq;
#pragma unroll
            for (int ai = 0; ai < 2; ++ai)
#pragma unroll
                for (int m = 0; m < 4; ++m) { bf16_t* rowp = base + (size_t)(row0 + ai * HALF + m * 16) * ldc + col0;
#pragma unroll
                    for (int bj = 0; bj < 2; ++bj) store8(rowp + bj * HALF, acc[ai][bj][m][0], acc[ai][bj][m][1]);
                    asm volatile("" ::: "memory"); }
        }
    }
};
struct EpiUp {
    static constexpr bool PERM = true;
    bf16_t* act;
    __device__ __forceinline__ void operator()(const Acc& acc, const Unit& u, int wr, int wc, int fr, int fq) const {
        const int row0 = u.pm * BM + wr * 64 + fr, col0 = u.pn * 128 + wc * 32 + 8 * fq;
#pragma unroll
        for (int ai = 0; ai < 2; ++ai)
#pragma unroll
            for (int m = 0; m < 4; ++m) { bf16_t* rowp = act + (size_t)(row0 + ai * HALF + m * 16) * DFF + col0;
                store8(rowp, silu4(acc[ai][0][m][0]) * acc[ai][1][m][0], silu4(acc[ai][0][m][1]) * acc[ai][1][m][1]); asm volatile("" ::: "memory"); }
    }
};
struct EpiPool {
    static constexpr bool PERM = true;
    bf16_t* cat; const float* scale;
    __device__ __forceinline__ void operator()(const Acc& acc, const Unit& u, int wr, int wc, int fr, int fq) const {
        const int row0 = u.pm * BM + wr * 64 + fr, col0 = u.pn * BM + wc * 32 + 8 * fq;
#pragma unroll
        for (int ai = 0; ai < 2; ++ai)
#pragma unroll
            for (int m = 0; m < 4; ++m) { bf16_t* rowp = cat + (size_t)(row0 + ai * HALF + m * 16) * 2048 + col0;
#pragma unroll
                for (int bj = 0; bj < 2; ++bj) { const f32x4 s0 = *(const f32x4*)(scale + col0 + bj * HALF), s1 = *(const f32x4*)(scale + col0 + bj * HALF + 4);
                    store8(rowp + bj * HALF, acc[ai][bj][m][0] * s0, acc[ai][bj][m][1] * s1); }
                asm volatile("" ::: "memory"); }
    }
};
struct EpiResid {
    static constexpr bool PERM = false;
    float* x; bool dry;
    __device__ __forceinline__ void operator()(const Acc& acc, const Unit& u, int wr, int wc, int fr, int fq) const {
        if (dry) return;
        const int row0 = u.pm * BM + wr * 64 + fr, col0 = u.pn * BM + wc * 32 + 4 * fq;
#pragma unroll
        for (int ai = 0; ai < 2; ++ai) {
            f32x4 t[4][2][2];
#pragma unroll
            for (int m = 0; m < 4; ++m) { const float* rowp = x + (size_t)(row0 + ai * HALF + m * 16) * 2048 + col0;
#pragma unroll
                for (int bj = 0; bj < 2; ++bj)
#pragma unroll
                    for (int n = 0; n < 2; ++n) t[m][bj][n] = *(const f32x4*)(rowp + bj * HALF + n * 16); }
#pragma unroll
            for (int m = 0; m < 4; ++m) { float* rowp = x + (size_t)(row0 + ai * HALF + m * 16) * 2048 + col0;
#pragma unroll
                for (int bj = 0; bj < 2; ++bj)
#pragma unroll
                    for (int n = 0; n < 2; ++n) *(f32x4*)(rowp + bj * HALF + n * 16) = t[m][bj][n] + acc[ai][bj][m][n]; }
            asm volatile("" ::: "memory"); }
    }
};
struct EpiPartX {
    static constexpr bool PERM = false;
    float* px; bool dry;
    __device__ __forceinline__ void operator()(const Acc& acc, const Unit& u, int wr, int wc, int fr, int fq) const {
        if (dry) return;
        float* base = px + (size_t)u.pad * 32768 + (size_t)(wr * 64 + fr) * 256 + wc * 32 + 4 * fq;
#pragma unroll
        for (int m = 0; m < 4; ++m)
#pragma unroll
            for (int bj = 0; bj < 2; ++bj)
#pragma unroll
                for (int n = 0; n < 2; ++n) *(f32x4*)(base + (size_t)(m * 16) * 256 + bj * HALF + n * 16) = acc[0][bj][m][n];
    }
};
struct EpiResidX {
    static constexpr bool PERM = false;
    EpiResid r; EpiPartX p;
    __device__ __forceinline__ void operator()(const Acc& acc, const Unit& u, int wr, int wc, int fr, int fq) const { if (u.pm < MPR / 256) r(acc, u, wr, wc, fr, fq); else p(acc, u, wr, wc, fr, fq); }
};
}

struct TItem { const float* src; bf16_t* dst; int ldw, K; };
__device__ __forceinline__ TItem titem_locate(PP P, unsigned char* ws, int it) {
    const float* W; bf16_t* WT; int ldw, K, Nd, pairLimit = 0, Hh = 0, r = it;
    if (r < 6144) { const int j = r / 3072; r -= j * 3072; W = P->in[9] + (size_t)j * 2048 * 3072; WT = (bf16_t*)(ws + WS_WEVIN) + (size_t)j * 3072 * 2048; ldw = 3072; K = 2048; Nd = 3072; }
    else if ((r -= 6144) < 4096) { const int e = r / 2048; r -= e * 2048; W = P->in[16] + (size_t)e * 2048 * 2048; WT = (bf16_t*)(ws + WS_WEVOUT) + (size_t)e * 2048 * 2048; ldw = 2048; K = 2048; Nd = 2048; }
    else if ((r -= 4096) < 12288) { const int o = r / 6144; r -= o * 6144; W = P->in[17] + (size_t)o * 2048 * OD_IN; WT = (bf16_t*)(ws + WS_WODIN) + (size_t)o * OD_INM * 2048; ldw = OD_IN; K = 2048; Nd = OD_INM; pairLimit = 2048; Hh = 1024; }
    else if ((r -= 12288) < 4096) { const int o = r / 2048; r -= o * 2048; W = P->in[26] + (size_t)o * 2048 * 2048; WT = (bf16_t*)(ws + WS_WODOUT) + (size_t)o * 2048 * 2048; ldw = 2048; K = 2048; Nd = 2048; }
    else if ((r -= 4096) < 45056) { const int l = r / 11264; r -= l * 11264; W = P->in[27] + (size_t)l * 2048 * 2 * DFF; WT = (bf16_t*)(ws + WS_WUP) + (size_t)l * 2 * DFF * 2048; ldw = 2 * DFF; K = 2048; Nd = 2 * DFF; pairLimit = 2 * DFF; Hh = DFF; }
    else if ((r -= 45056) < 22528) { const int l = r / 5632; r -= l * 5632; W = P->in[28] + (size_t)l * DFF * 2048; WT = (bf16_t*)(ws + WS_WDOWN) + (size_t)l * 2048 * DFF; ldw = 2048; K = DFF; Nd = 2048; }
    else { r -= 22528; const int eg = r / 32; r -= eg * 32; W = P->in[10] + (size_t)eg * 65536; WT = (bf16_t*)(ws + WS_WPOOL) + (size_t)eg * 65536; ldw = 256; K = 256; Nd = 256; }
    const int nblk = Nd / 32, kb = r / nblk, nb = r - kb * nblk, n0 = nb * 32; int src = n0;
    if (n0 < pairLimit) { const int pn = n0 >> 8, c = n0 & 255; src = c < 128 ? pn * 128 + c : Hh + pn * 128 + (c - 128); }
    TItem t; t.src = W + (size_t)(kb * 64) * ldw + src; t.dst = WT + (size_t)n0 * K + kb * 64; t.ldw = ldw; t.K = K; return t;
}
constexpr int T_ITEMS = 6144 + 4096 + 12288 + 4096 + 45056 + 22528 + 256;
__device__ __forceinline__ void titem_load(const TItem& t, float (&r)[32], int lane) {
    const float* p = t.src + (size_t)(lane >> 5) * t.ldw + (lane & 31);
#pragma unroll
    for (int i = 0; i < 32; ++i) r[i] = p[(size_t)(2 * i) * t.ldw];
}
__device__ __forceinline__ void titem_store(const TItem& t, const float (&r)[32], LAS float* scr, int lane) {
#pragma unroll
    for (int i = 0; i < 32; ++i) scr[(2 * i + (lane >> 5)) * 33 + (lane & 31)] = r[i];
    asm volatile("s_waitcnt lgkmcnt(0)" ::: "memory");
    const int c = lane & 7;
#pragma unroll
    for (int j = 0; j < 4; ++j) { const int n = (lane >> 3) + 8 * j; const LAS float* s = scr + (8 * c) * 33 + n;
        u32x4 o; o.x = cvt_pk_bf16(s[0 * 33], s[1 * 33]); o.y = cvt_pk_bf16(s[2 * 33], s[3 * 33]); o.z = cvt_pk_bf16(s[4 * 33], s[5 * 33]); o.w = cvt_pk_bf16(s[6 * 33], s[7 * 33]);
        *(u32x4*)(t.dst + (size_t)n * t.K + 8 * c) = o; }
    asm volatile("s_waitcnt lgkmcnt(0)" ::: "memory");
}
constexpr int L_EVEN_ITEMS = 3072 + 2048 + 128 + 11264 + 5632, L_ODD_ITEMS = 6144 + 2048 + 11264 + 5632;
__device__ __forceinline__ int layer_item(int l, int i) {
    const int h = l >> 1;
    if ((l & 1) == 0) { if (i < 3072) return h * 3072 + i; i -= 3072; if (i < 2048) return 6144 + h * 2048 + i; i -= 2048; if (i < 128) return 94208 + h * 128 + i; i -= 128; }
    else { if (i < 6144) return 10240 + h * 6144 + i; i -= 6144; if (i < 2048) return 22528 + h * 2048 + i; i -= 2048; }
    if (i < 11264) return 26624 + l * 11264 + i; i -= 11264; return 71680 + l * 5632 + i;
}
constexpr int DEF1_A = 5568, DEF1_B = 4032, DEF2_A = 7968, DEF2_B = 4032, DEF3_A = 5568, DEF3_B = 4032;
constexpr int PREP_L1 = L_ODD_ITEMS - DEF1_A - DEF1_B, PREP_L2 = L_EVEN_ITEMS - DEF2_A - DEF2_B, PREP_L3 = L_ODD_ITEMS - DEF3_A - DEF3_B;
constexpr int PREP_ITEMS = L_EVEN_ITEMS + PREP_L1 + PREP_L2 + PREP_L3;
__device__ __forceinline__ int prep_item(int p) {
    if (p < L_EVEN_ITEMS) return layer_item(0, p); p -= L_EVEN_ITEMS;
    if (p < PREP_L1) return layer_item(1, DEF1_A + DEF1_B + p); p -= PREP_L1;
    if (p < PREP_L2) return layer_item(2, DEF2_A + DEF2_B + p); p -= PREP_L2;
    return layer_item(3, DEF3_A + DEF3_B + p);
}
__device__ __forceinline__ void convert_span(PP P, LAS unsigned char* lds, int tid, int wv, int nwv, int count, int mode, int layer, int first) {
    const int lane = tid & 63, wave = tid >> 6;
    LAS float* scr = (LAS float*)(lds + wave * 8448);
    unsigned char* ws = P->ws;
    int it = wv; TItem dA, dB; float ra[32], rb[32];
#define CONV_MAP(j) (mode == 0 ? prep_item(j) : (mode == 2 ? (j) : layer_item(layer, first + (j))))
    if (it < count) { dA = titem_locate(P, ws, CONV_MAP(it)); titem_load(dA, ra, lane); }
    while (it < count) {
        const int itB = it + nwv; const bool hb = itB < count;
        if (hb) { dB = titem_locate(P, ws, CONV_MAP(itB)); titem_load(dB, rb, lane); }
        titem_store(dA, ra, scr, lane);
        if (!hb) break;
        const int itA = itB + nwv; const bool ha = itA < count;
        if (ha) { dA = titem_locate(P, ws, CONV_MAP(itA)); titem_load(dA, ra, lane); }
        titem_store(dB, rb, scr, lane);
        if (!ha) break;
        it = itA;
    }
#undef CONV_MAP
}
__device__ __forceinline__ void convert_slot(const Ctx& cx, PP P, LAS unsigned char* lds, int layer, int first, int count, int thr, int ncu) {
    if (cx.G != 256 || cx.bid < thr || cx.bid >= thr + ncu) return;
    __syncthreads();
    convert_span(P, lds, cx.tid, (cx.bid - thr) * NWAVES + (cx.tid >> 6), ncu * NWAVES, count, 1, layer, first);
}
__device__ __forceinline__ void phase_prep(const Ctx& cx, PP P, LAS unsigned char* lds) {
    const int tid = cx.tid;
    const int G = cx.G;
    unsigned char* ws = P->ws;
    if (G == 256) convert_span(P, lds, tid, cx.bid * NWAVES + (tid >> 6), G * NWAVES, PREP_ITEMS, 0, 0, 0);
    else convert_span(P, lds, tid, cx.bid * NWAVES + (tid >> 6), G * NWAVES, T_ITEMS, 2, 0, 0);
    {
        bf16_t* wab = (bf16_t*)(ws + WS_WAB);
        for (int i = cx.bid * NTHR + tid; i < 2 * 16 * 2048; i += G * NTHR) { const int o = i >> 15, c = (i >> 11) & 15, k = i & 2047;
            wab[i] = (bf16_t)(cvt_pk_bf16(P->in[17][(size_t)o * 2048 * OD_IN + (size_t)k * OD_IN + OD_INM + c], 0.f) & 0xffff); }
    }
}

template <bool F32OUT>
__device__ __forceinline__ void phase_rmsnorm(const Ctx& cx, float* X, const float* g, bf16_t* Hout, float* Fout, const float* px, int ppu, bool dry, LAS unsigned char* lds) {
    const int tid = cx.tid, lane = tid & 63, wave = __builtin_amdgcn_readfirstlane(tid >> 6);
    const int gw = cx.bid * NWAVES + wave, NGW = cx.G * NWAVES;
    if (ppu > 0) {
        LAS float* red = (LAS float*)lds;
        for (int r = cx.bid; r < BS; r += cx.G) {
            const int m = MPR + r, col = 256 * wave + lane * 4, P8 = 8 * ppu;
            f32x4 a = *(const f32x4*)(X + (size_t)m * D + col);
            const float* pr = px + (size_t)r * 256 + lane * 4 + (size_t)(32 * wave) * 32768;
#pragma unroll
            for (int i = 0; i < 32; ++i) { const int vc = 32 * wave + i; if (((vc + 1) * P8) / 256 > (vc * P8) / 256) a = a + *(const f32x4*)(pr + (size_t)i * 32768); }
            if (!dry) *(f32x4*)(X + (size_t)m * D + col) = a;
            const float ss = wave_sum((a.x * a.x + a.y * a.y) + (a.z * a.z + a.w * a.w));
            if (lane == 0) red[wave] = ss;
            __syncthreads();
            float tot = 0.f;
#pragma unroll
            for (int i = 0; i < 8; ++i) tot += red[i];
            const float rs = rsqrtf(tot * (1.0f / D) + EPS);
            const f32x4 g4 = *(const f32x4*)(g + col); const f32x4 o = a * rs * g4;
            if (F32OUT) *(f32x4*)(Fout + (size_t)m * D + col) = o;
            else { u32x2 w; w.x = cvt_pk_bf16(o.x, o.y); w.y = cvt_pk_bf16(o.z, o.w); *(u32x2*)(Hout + (size_t)m * D + col) = w; }
            __syncthreads();
        }
    }
    const int mend = ppu > 0 ? MPR : MT;
    for (int m = gw; m < mend; m += 4 * NGW) {
        f32x4 v[4][8]; float ss[4]; int mr[4]; bool ok[4];
#pragma unroll
        for (int k = 0; k < 4; ++k) { const int mk = m + k * NGW; ok[k] = mk < mend; mr[k] = ok[k] ? mk : m; const f32x4* xr = (const f32x4*)(X + (size_t)mr[k] * D) + lane;
#pragma unroll
            for (int j = 0; j < 8; ++j) v[k][j] = xr[64 * j]; }
#pragma unroll
        for (int k = 0; k < 4; ++k) { float a = 0.f;
#pragma unroll
            for (int j = 0; j < 8; ++j) a += (v[k][j].x * v[k][j].x + v[k][j].y * v[k][j].y) + (v[k][j].z * v[k][j].z + v[k][j].w * v[k][j].w);
            ss[k] = a; }
#pragma unroll
        for (int o = 1; o < 64; o <<= 1) {
#pragma unroll
            for (int k = 0; k < 4; ++k) ss[k] += __shfl_xor(ss[k], o); }
#pragma unroll
        for (int j = 0; j < 8; ++j) { const f32x4 g4 = ((const f32x4*)g)[lane + 64 * j];
#pragma unroll
            for (int k = 0; k < 4; ++k) if (ok[k]) { const float rs = rsqrtf(ss[k] * (1.0f / D) + EPS); const f32x4 o = v[k][j] * rs * g4;
                if (F32OUT) ((f32x4*)(Fout + (size_t)mr[k] * D))[lane + 64 * j] = o;
                else { u32x2 w; w.x = cvt_pk_bf16(o.x, o.y); w.y = cvt_pk_bf16(o.z, o.w); ((u32x2*)(Hout + (size_t)mr[k] * D))[lane + 64 * j] = w; } } }
    }
}

__device__ __forceinline__ void phase_first_norm(const Ctx& cx, PP P, float* X, const float* g, bf16_t* Hout) {
    const int tid = cx.tid, lane = tid & 63, wave = __builtin_amdgcn_readfirstlane(tid >> 6);
    const int gw = cx.bid * NWAVES + wave, NGW = cx.G * NWAVES;
    for (int m = gw; m < MT; m += NGW) {
        const float* src = m < MPR ? P->in[0] + (size_t)m * D : P->in[1] + (size_t)(m - MPR) * D;
        const f32x4* xr = (const f32x4*)src + lane; f32x4 v[8]; float ss = 0.f;
#pragma unroll
        for (int j = 0; j < 8; ++j) { v[j] = xr[64 * j]; ss += (v[j].x * v[j].x + v[j].y * v[j].y) + (v[j].z * v[j].z + v[j].w * v[j].w); }
        const float rs = rsqrtf(wave_sum(ss) * (1.0f / D) + EPS);
#pragma unroll
        for (int j = 0; j < 8; ++j) { ((f32x4*)(X + (size_t)m * D))[lane + 64 * j] = v[j]; const f32x4 g4 = ((const f32x4*)g)[lane + 64 * j]; const f32x4 o = v[j] * rs * g4;
            u32x2 w; w.x = cvt_pk_bf16(o.x, o.y); w.y = cvt_pk_bf16(o.z, o.w); ((u32x2*)(Hout + (size_t)m * D))[lane + 64 * j] = w; }
    }
}

__device__ __forceinline__ void phase_even_prep(const Ctx& cx, PP P, int e) {
    const int tid = cx.tid, lane = tid & 63, wave = __builtin_amdgcn_readfirstlane(tid >> 6);
    const int gw = cx.bid * NWAVES + wave, NGW = cx.G * NWAVES;
    unsigned char* ws = P->ws;
    const bf16_t* abuf = (const bf16_t*)(ws + WS_ABUF); const bf16_t* uv = (const bf16_t*)(ws + WS_UV);
    bf16_t* pooled = (bf16_t*)(ws + WS_MIX); bf16_t* vn = (bf16_t*)(ws + WS_VN); bf16_t* cat = (bf16_t*)(ws + WS_CAT);
    const float* spool = P->in[2] + (size_t)e * BS * 15 * 1024;
    const float* lng = P->in[12] + e * 1024; const float* lnb = P->in[13] + e * 1024;
    const float* sws = P->in[14] + (size_t)e * 4 * 128 * 128; const float* sb = P->in[15] + e * 4 * 128;
    float* out = P->out;
    constexpr int GPS = (SEQ + 4) / 5;
    for (int task = gw; task < BP * GPS + BS; task += NGW) {
      if (task >= BP * GPS) {
        const int m = MPR + task - BP * GPS; const bool prompt = false; const int b = m - MPR, t = 0;
#pragma unroll
        for (int p = 0; p < 4; ++p) {
            const int w = 2 << p, ch0 = p * 256 + lane * 4;
            float cur[4], sacc[4];
            { const u32x2 r = *(const u32x2*)(abuf + (size_t)m * 1024 + ch0); cur[0] = bf_lo(r.x); cur[1] = bf_hi(r.x); cur[2] = bf_lo(r.y); cur[3] = bf_hi(r.y); }
#pragma unroll
            for (int i = 0; i < 4; ++i) sacc[i] = cur[i];
            float cnt;
            if (prompt) {
#pragma unroll
                for (int d = 1; d < w; ++d) if (t - d >= 0) { const u32x2 r = *(const u32x2*)(abuf + (size_t)(m - d) * 1024 + ch0);
                    sacc[0] += bf_lo(r.x); sacc[1] += bf_hi(r.x); sacc[2] += bf_lo(r.y); sacc[3] += bf_hi(r.y); }
                cnt = (float)(w < t + 1 ? w : t + 1);
            } else {
#pragma unroll
                for (int d = 1; d < w; ++d) { const f32x4 h0 = *(const f32x4*)(spool + ((size_t)b * 15 + (15 - d)) * 1024 + ch0);
                    sacc[0] += h0.x; sacc[1] += h0.y; sacc[2] += h0.z; sacc[3] += h0.w; }
                cnt = (float)w;
            }
            const float ic = 1.0f / cnt;
            u32x2 pw; pw.x = cvt_pk_bf16(sacc[0] * ic - cur[0], sacc[1] * ic - cur[1]); pw.y = cvt_pk_bf16(sacc[2] * ic - cur[2], sacc[3] * ic - cur[3]);
            *(u32x2*)(pooled + (size_t)m * 1024 + ch0) = pw;
            const f32x4 c4 = (f32x4){cur[0], cur[1], cur[2], cur[3]};
            if (prompt) { if (t >= SEQ - 15) *(f32x4*)(out + O_PP + (((size_t)e * BP + b) * 15 + (t - (SEQ - 15))) * 1024 + ch0) = c4; }
            else { float* ob = out + O_PS + ((size_t)e * BS + b) * 15 * 1024 + ch0;
                *(f32x4*)(ob + 14 * 1024) = c4; }
        }
        float v[2][8]; float sm = 0.f;
#pragma unroll
        for (int jj = 0; jj < 2; ++jj) { const int ch0 = (lane + 64 * jj) * 8; const u32x4 r = *(const u32x4*)(uv + (size_t)m * 2048 + 1024 + ch0); unpack8(r, v[jj]);
#pragma unroll
            for (int i = 0; i < 8; ++i) sm += v[jj][i]; }
        const float mu = wave_sum(sm) * (1.0f / 1024.f); float sq = 0.f;
#pragma unroll
        for (int jj = 0; jj < 2; ++jj)
#pragma unroll
            for (int i = 0; i < 8; ++i) { v[jj][i] -= mu; sq += v[jj][i] * v[jj][i]; }
        const float rstd = rsqrtf(wave_sum(sq) * (1.0f / 1024.f) + EPS);
#pragma unroll
        for (int jj = 0; jj < 2; ++jj) { const int ch0 = (lane + 64 * jj) * 8; float o[8];
#pragma unroll
            for (int i = 0; i < 8; ++i) o[i] = v[jj][i] * rstd * lng[ch0 + i] + lnb[ch0 + i];
            *(u32x4*)(vn + (size_t)m * 1024 + ch0) = pack8(o);
            if (!prompt) {
                float* op = out + O_SV + ((size_t)e * BS + b) * 1024 + ch0;
                *(f32x4*)op = (f32x4){o[0], o[1], o[2], o[3]}; *(f32x4*)(op + 4) = (f32x4){o[4], o[5], o[6], o[7]};
                const int h = ch0 >> 8; const float w00 = sws[(size_t)h * 128 * 128], b0 = sb[h * 128];
                float uu[8]; const u32x4 r = *(const u32x4*)(uv + (size_t)m * 2048 + ch0); unpack8(r, uu);
                float c[8];
#pragma unroll
                for (int i = 0; i < 8; ++i) c[i] = uu[i] * (w00 * o[i] + b0);
                *(u32x4*)(cat + (size_t)m * 2048 + 1024 + ch0) = pack8(c);
            } }
      }
      else {
        const int b = task / GPS, gi = task - b * GPS, t0 = gi * 5, R = (SEQ - t0) < 5 ? (SEQ - t0) : 5, mbase = b * SEQ + t0;
#pragma unroll
        for (int p = 0; p < 4; ++p) {
            constexpr int dummy = 0; (void)dummy;
            const int w = 2 << p, ch0 = p * 256 + lane * 4;
            float x[20][4];
#pragma unroll
            for (int i = 0; i < 20; ++i) if (i < w + 4) { const int ti = t0 - (w - 1) + i; const bool valid = (ti >= 0) && (i < w - 1 + R);
                const u32x2 r = *(const u32x2*)(abuf + (size_t)(valid ? mbase - (w - 1) + i : mbase) * 1024 + ch0);
                x[i][0] = valid ? bf_lo(r.x) : 0.f; x[i][1] = valid ? bf_hi(r.x) : 0.f; x[i][2] = valid ? bf_lo(r.y) : 0.f; x[i][3] = valid ? bf_hi(r.y) : 0.f; }
            float sacc[4] = {0.f, 0.f, 0.f, 0.f};
#pragma unroll
            for (int i = 0; i < 16; ++i) if (i < w) {
#pragma unroll
                for (int c = 0; c < 4; ++c) sacc[c] += x[i][c]; }
#pragma unroll
            for (int r = 0; r < 5; ++r) {
                if (r > 0) {
#pragma unroll
                    for (int c = 0; c < 4; ++c) sacc[c] += x[r + w - 1][c] - x[r - 1][c]; }
                const int t = t0 + r; const float ic = 1.0f / (float)(w < t + 1 ? w : t + 1);
                const float* cur = x[r + w - 1];
                if (r < R) { u32x2 pw; pw.x = cvt_pk_bf16(sacc[0] * ic - cur[0], sacc[1] * ic - cur[1]); pw.y = cvt_pk_bf16(sacc[2] * ic - cur[2], sacc[3] * ic - cur[3]);
                    *(u32x2*)(pooled + (size_t)(mbase + r) * 1024 + ch0) = pw;
                    if (t >= SEQ - 15) *(f32x4*)(out + O_PP + (((size_t)e * BP + b) * 15 + (t - (SEQ - 15))) * 1024 + ch0) = (f32x4){cur[0], cur[1], cur[2], cur[3]}; }
            }
        }
        float v[5][2][8]; float sm[5], sq[5];
#pragma unroll
        for (int r = 0; r < 5; ++r) { const int mr = mbase + (r < R ? r : 0); float a = 0.f;
#pragma unroll
            for (int jj = 0; jj < 2; ++jj) { const int ch0 = (lane + 64 * jj) * 8; const u32x4 q = *(const u32x4*)(uv + (size_t)mr * 2048 + 1024 + ch0); unpack8(q, v[r][jj]);
#pragma unroll
                for (int i = 0; i < 8; ++i) a += v[r][jj][i]; }
            sm[r] = a; }
#pragma unroll
        for (int of = 1; of < 64; of <<= 1) {
#pragma unroll
            for (int r = 0; r < 5; ++r) sm[r] += __shfl_xor(sm[r], of); }
#pragma unroll
        for (int r = 0; r < 5; ++r) { const float mu = sm[r] * (1.0f / 1024.f); float a = 0.f;
#pragma unroll
            for (int jj = 0; jj < 2; ++jj)
#pragma unroll
                for (int i = 0; i < 8; ++i) { v[r][jj][i] -= mu; a += v[r][jj][i] * v[r][jj][i]; }
            sq[r] = a; }
#pragma unroll
        for (int of = 1; of < 64; of <<= 1) {
#pragma unroll
            for (int r = 0; r < 5; ++r) sq[r] += __shfl_xor(sq[r], of); }
#pragma unroll
        for (int jj = 0; jj < 2; ++jj) { const int ch0 = (lane + 64 * jj) * 8;
            const f32x4 g0 = *(const f32x4*)(lng + ch0), g1 = *(const f32x4*)(lng + ch0 + 4), b0 = *(const f32x4*)(lnb + ch0), b1 = *(const f32x4*)(lnb + ch0 + 4);
            const float gg[8] = {g0.x, g0.y, g0.z, g0.w, g1.x, g1.y, g1.z, g1.w}, bb[8] = {b0.x, b0.y, b0.z, b0.w, b1.x, b1.y, b1.z, b1.w};
#pragma unroll
            for (int r = 0; r < 5; ++r) if (r < R) { const float rstd = rsqrtf(sq[r] * (1.0f / 1024.f) + EPS); float o8[8];
#pragma unroll
                for (int i = 0; i < 8; ++i) o8[i] = v[r][jj][i] * rstd * gg[i] + bb[i];
                *(u32x4*)(vn + (size_t)(mbase + r) * 1024 + ch0) = pack8(o8); } }
      }
    }
}

__device__ __forceinline__ void phase_sgu(const Ctx& cx, PP P, int e, LAS unsigned char* lds) {
    const int tid = cx.tid, lane = tid & 63, wave = __builtin_amdgcn_readfirstlane(tid >> 6), l15 = lane & 15, quad = lane >> 4;
    const int G = cx.G;
    unsigned char* ws = P->ws;
    const bf16_t* uv = (const bf16_t*)(ws + WS_UV); const bf16_t* vn = (const bf16_t*)(ws + WS_VN); bf16_t* cat = (bf16_t*)(ws + WS_CAT);
    const float* sws = P->in[14] + (size_t)e * 4 * 128 * 128; const float* sb = P->in[15] + e * 4 * 128;
    LAS bf16_t* VT = (LAS bf16_t*)lds;
    for (int task = (G - 1 - cx.bid); task < 256; task += G) {
        const int b = task >> 6, n = (task >> 2) & 15, h = task & 3; const int m0 = b * SEQ + n * 128;
        for (int idx = tid; idx < 128 * 32; idx += NTHR) { const int r = idx >> 5, cq = idx & 31;
            const u32x4 w = *(const u32x4*)(vn + (size_t)(m0 + r) * 1024 + h * 256 + cq * 8);
            LAS bf16_t* d = VT + (cq * 8) * 136 + (r ^ ((cq & 7) << 3));
            d[0 * 136] = (bf16_t)(w.x & 0xffff); d[1 * 136] = (bf16_t)(w.x >> 16); d[2 * 136] = (bf16_t)(w.y & 0xffff); d[3 * 136] = (bf16_t)(w.y >> 16);
            d[4 * 136] = (bf16_t)(w.z & 0xffff); d[5 * 136] = (bf16_t)(w.z >> 16); d[6 * 136] = (bf16_t)(w.w & 0xffff); d[7 * 136] = (bf16_t)(w.w >> 16); }
        __syncthreads();
        const int irow = 16 * wave + l15;
        bf16x8 af[4];
#pragma unroll
        for (int ks = 0; ks < 4; ++ks) { const int k0 = ks * 32 + quad * 8; const float* wp = sws + ((size_t)h * 128 + irow) * 128 + k0; const f32x4 a0 = *(const f32x4*)wp, a1 = *(const f32x4*)(wp + 4);
            float f[8] = {a0.x, a0.y, a0.z, a0.w, a1.x, a1.y, a1.z, a1.w};
#pragma unroll
            for (int i = 0; i < 8; ++i) if (k0 + i > irow) f[i] = 0.f;
            const u32x4 pw = pack8(f); af[ks] = __builtin_bit_cast(bf16x8, pw); }
        const float bias = sb[h * 128 + irow];
#pragma unroll 2
        for (int nt = 0; nt < 16; ++nt) {
            f32x4 acc = (f32x4){0.f, 0.f, 0.f, 0.f};
#pragma unroll
            for (int ks = 0; ks < 4; ++ks) { const bf16x8 bfr = *(const LAS bf16x8*)(VT + (nt * 16 + l15) * 136 + ((ks * 32 + quad * 8) ^ ((((nt * 16 + l15) >> 3) & 7) << 3)));
                acc = __builtin_amdgcn_mfma_f32_16x16x32_bf16(bfr, af[ks], acc, 0, 0, 0); }
            const int c0 = h * 256 + nt * 16 + quad * 4;
            const u32x2 uw = *(const u32x2*)(uv + (size_t)(m0 + irow) * 2048 + c0);
            u32x2 ow; ow.x = cvt_pk_bf16(bf_lo(uw.x) * (acc[0] + bias), bf_hi(uw.x) * (acc[1] + bias)); ow.y = cvt_pk_bf16(bf_lo(uw.y) * (acc[2] + bias), bf_hi(uw.y) * (acc[3] + bias));
            *(u32x2*)(cat + (size_t)(m0 + irow) * 2048 + 1024 + c0) = ow;
        }
        __syncthreads();
    }
}

__device__ __forceinline__ void phase_ab(const Ctx& cx, PP P, int o) {
    const int tid = cx.tid, lane = tid & 63, l15 = lane & 15, quad = lane >> 4, wave = __builtin_amdgcn_readfirstlane(tid >> 6);
    const int gw = cx.bid * NWAVES + wave, NGW = cx.G * NWAVES;
    const bf16_t* H = (const bf16_t*)(P->ws + WS_H); float* AB = (float*)(P->ws + WS_AB);
    const bf16_t* Wt = (const bf16_t*)(P->ws + WS_WAB) + (size_t)o * 16 * 2048;
    for (int tt = NGW - 1 - gw; tt < MT / 16; tt += NGW) {
        const bf16_t* ap = H + (size_t)(16 * tt + l15) * D + quad * 8; const bf16_t* bp = Wt + (size_t)l15 * 2048 + quad * 8;
        f32x4 acc = (f32x4){0.f, 0.f, 0.f, 0.f};
#pragma unroll 16
        for (int ks = 0; ks < 64; ++ks) { const bf16x8 a = *(const bf16x8*)(ap + ks * 32), b = *(const bf16x8*)(bp + ks * 32); acc = __builtin_amdgcn_mfma_f32_16x16x32_bf16(a, b, acc, 0, 0, 0); }
#pragma unroll
        for (int j = 0; j < 4; ++j) AB[(size_t)(16 * tt + quad * 4 + j) * 16 + l15] = acc[j];
    }
}

__device__ __forceinline__ void phase_odd_prep(const Ctx& cx, PP P, int o, LAS unsigned char* lds) {
    const int tid = cx.tid, lane = tid & 63, wave = __builtin_amdgcn_readfirstlane(tid >> 6);
    const int gw = cx.bid * NWAVES + wave, NGW = cx.G * NWAVES;
    unsigned char* ws = P->ws;
    const bf16_t* glu = (const bf16_t*)(ws + WS_ABUF); const bf16_t* qkv = (const bf16_t*)(ws + WS_UV);
    bf16_t* qkvc = (bf16_t*)(ws + WS_MIX); bf16_t* cat = (bf16_t*)(ws + WS_CAT);
    const float* AB = (const float*)(ws + WS_AB); float* Gg = (float*)(ws + WS_G); float* Bt = (float*)(ws + WS_BETA);
    const float* sconv = P->in[3] + (size_t)o * BS * 30 * 1024; const float* sdn = P->in[4] + (size_t)o * BS * 3 * 3072;
    const float* dw = P->in[18] + (size_t)o * 31 * 1024; const float* db = P->in[19] + o * 1024; const float* lng = P->in[20] + o * 1024; const float* lnb = P->in[21] + o * 1024;
    const float* cw = P->in[22] + (size_t)o * 4 * 3072; const float* alog = P->in[23] + o * 8; const float* dtb = P->in[24] + o * 8;
    float* out = P->out;
    LAS float* dwl = (LAS float*)lds;
    constexpr int GPS = (SEQ + 4) / 5;
#pragma unroll 8
    for (int i = tid; i < 31 * 256; i += NTHR) ((LAS f32x4*)dwl)[i] = ((const f32x4*)dw)[i];
    __syncthreads();
    for (int task = gw; task < BP * GPS + BS; task += NGW) {
      if (task >= BP * GPS) {
        const int m = MPR + task - BP * GPS; const bool prompt = false; const int b = m - MPR, t = 0;
        float y[2][8]; float sm = 0.f;
#pragma unroll
        for (int jj = 0; jj < 2; ++jj) {
            const int ch0 = (lane + 64 * jj) * 8;
            { const f32x4 d0 = *(const f32x4*)(db + ch0), d1 = *(const f32x4*)(db + ch0 + 4); y[jj][0] = d0.x; y[jj][1] = d0.y; y[jj][2] = d0.z; y[jj][3] = d0.w; y[jj][4] = d1.x; y[jj][5] = d1.y; y[jj][6] = d1.z; y[jj][7] = d1.w; }
            float cur[8];
            { const u32x4 r = *(const u32x4*)(glu + (size_t)m * 1024 + ch0); unpack8(r, cur); }
            { const f32x4 w0 = *(const LAS f32x4*)(dwl + 30 * 1024 + ch0), w1 = *(const LAS f32x4*)(dwl + 30 * 1024 + ch0 + 4);
              y[jj][0] += w0.x * cur[0]; y[jj][1] += w0.y * cur[1]; y[jj][2] += w0.z * cur[2]; y[jj][3] += w0.w * cur[3]; y[jj][4] += w1.x * cur[4]; y[jj][5] += w1.y * cur[5]; y[jj][6] += w1.z * cur[6]; y[jj][7] += w1.w * cur[7]; }
            if (prompt) {
                const int j0 = t >= 30 ? 0 : 30 - t;
#pragma unroll
                for (int hh = 0; hh < 2; ++hh) {
                    u32x4 rr[15];
#pragma unroll
                    for (int jx = 0; jx < 15; ++jx) { const int j = hh * 15 + jx; const int jm = (j >= j0) ? (m - 30 + j) : m; rr[jx] = *(const u32x4*)(glu + (size_t)jm * 1024 + ch0); }
#pragma unroll
                    for (int jx = 0; jx < 15; ++jx) { const int j = hh * 15 + jx; if (j >= j0) { float x[8]; unpack8(rr[jx], x);
                        const f32x4 w0 = *(const LAS f32x4*)(dwl + j * 1024 + ch0), w1 = *(const LAS f32x4*)(dwl + j * 1024 + ch0 + 4);
                        y[jj][0] += w0.x * x[0]; y[jj][1] += w0.y * x[1]; y[jj][2] += w0.z * x[2]; y[jj][3] += w0.w * x[3]; y[jj][4] += w1.x * x[4]; y[jj][5] += w1.y * x[5]; y[jj][6] += w1.z * x[6]; y[jj][7] += w1.w * x[7]; } }
                    asm volatile("" ::: "memory");
                }
            } else {
#pragma unroll 10
                for (int j = 0; j < 30; ++j) { const float* hp = sconv + ((size_t)b * 30 + j) * 1024 + ch0; const f32x4 h0 = *(const f32x4*)hp, h1 = *(const f32x4*)(hp + 4);
                    const f32x4 w0 = *(const LAS f32x4*)(dwl + j * 1024 + ch0), w1 = *(const LAS f32x4*)(dwl + j * 1024 + ch0 + 4);
                    y[jj][0] += w0.x * h0.x; y[jj][1] += w0.y * h0.y; y[jj][2] += w0.z * h0.z; y[jj][3] += w0.w * h0.w; y[jj][4] += w1.x * h1.x; y[jj][5] += w1.y * h1.y; y[jj][6] += w1.z * h1.z; y[jj][7] += w1.w * h1.w; }
            }
#pragma unroll
            for (int i = 0; i < 8; ++i) sm += y[jj][i];
            if (prompt) { if (t >= SEQ - 30) { float* op = out + O_CP + (((size_t)o * BP + b) * 30 + (t - (SEQ - 30))) * 1024 + ch0;
                    *(f32x4*)op = (f32x4){cur[0], cur[1], cur[2], cur[3]}; *(f32x4*)(op + 4) = (f32x4){cur[4], cur[5], cur[6], cur[7]}; } }
            else { float* ob = out + O_CS + ((size_t)o * BS + b) * 30 * 1024 + ch0;
                *(f32x4*)(ob + 29 * 1024) = (f32x4){cur[0], cur[1], cur[2], cur[3]}; *(f32x4*)(ob + 29 * 1024 + 4) = (f32x4){cur[4], cur[5], cur[6], cur[7]}; }
        }
        const float mu = wave_sum(sm) * (1.0f / 1024.f); float sq = 0.f;
#pragma unroll
        for (int jj = 0; jj < 2; ++jj)
#pragma unroll
            for (int i = 0; i < 8; ++i) { y[jj][i] -= mu; sq += y[jj][i] * y[jj][i]; }
        const float rstd = rsqrtf(wave_sum(sq) * (1.0f / 1024.f) + EPS);
#pragma unroll
        for (int jj = 0; jj < 2; ++jj) { const int ch0 = (lane + 64 * jj) * 8; float c[8];
#pragma unroll
            for (int i = 0; i < 8; ++i) c[i] = siluf_(y[jj][i] * rstd * lng[ch0 + i] + lnb[ch0 + i]);
            *(u32x4*)(cat + (size_t)m * 2048 + ch0) = pack8(c); }
          }
      else {
        const int b = task / GPS, gi = task - b * GPS, t0 = gi * 5, R = (SEQ - t0) < 5 ? (SEQ - t0) : 5, mbase = b * SEQ + t0;
        float y[2][5][8];
#pragma unroll
        for (int jj = 0; jj < 2; ++jj) { const int ch0 = (lane + 64 * jj) * 8; const f32x4 d0 = *(const f32x4*)(db + ch0), d1 = *(const f32x4*)(db + ch0 + 4);
#pragma unroll
            for (int r = 0; r < 5; ++r) { y[jj][r][0] = d0.x; y[jj][r][1] = d0.y; y[jj][r][2] = d0.z; y[jj][r][3] = d0.w; y[jj][r][4] = d1.x; y[jj][r][5] = d1.y; y[jj][r][6] = d1.z; y[jj][r][7] = d1.w; } }
#pragma unroll 1
        for (int bt = 0; bt < 5; ++bt) {
            u32x4 rg[2][7];
#pragma unroll
            for (int jj = 0; jj < 2; ++jj)
#pragma unroll
                for (int k = 0; k < 7; ++k) { const int rr = bt * 7 + k; const bool valid = (t0 - 30 + rr >= 0) && (rr < 30 + R);
                    const u32x4 v = *(const u32x4*)(glu + (size_t)(valid ? mbase - 30 + rr : mbase) * 1024 + (lane + 64 * jj) * 8); rg[jj][k] = valid ? v : (u32x4){0u, 0u, 0u, 0u}; }
#pragma unroll
            for (int jj = 0; jj < 2; ++jj) { const int ch0 = (lane + 64 * jj) * 8;
#pragma unroll
                for (int k = 0; k < 7; ++k) { const int rr = bt * 7 + k; float x[8]; unpack8(rg[jj][k], x);
#pragma unroll
                    for (int r = 0; r < 5; ++r) { const int j = rr - r; if (j >= 0 && j <= 30) {
                        const LAS float* wp = dwl + j * 1024 + ch0; const f32x4 w0 = *(const LAS f32x4*)wp, w1 = *(const LAS f32x4*)(wp + 4);
                        y[jj][r][0] += w0.x * x[0]; y[jj][r][1] += w0.y * x[1]; y[jj][r][2] += w0.z * x[2]; y[jj][r][3] += w0.w * x[3]; y[jj][r][4] += w1.x * x[4]; y[jj][r][5] += w1.y * x[5]; y[jj][r][6] += w1.z * x[6]; y[jj][r][7] += w1.w * x[7]; } } } }
        }
        if (t0 + R > SEQ - 30) {
#pragma unroll
            for (int jj = 0; jj < 2; ++jj) { const int ch0 = (lane + 64 * jj) * 8;
                for (int r = 0; r < R; ++r) if (t0 + r >= SEQ - 30) { float c8[8]; const u32x4 v = *(const u32x4*)(glu + (size_t)(mbase + r) * 1024 + ch0); unpack8(v, c8);
                    float* op = out + O_CP + (((size_t)o * BP + b) * 30 + (t0 + r - (SEQ - 30))) * 1024 + ch0;
                    *(f32x4*)op = (f32x4){c8[0], c8[1], c8[2], c8[3]}; *(f32x4*)(op + 4) = (f32x4){c8[4], c8[5], c8[6], c8[7]}; } } }
        float sm[5], sq[5];
#pragma unroll
        for (int r = 0; r < 5; ++r) { float a = 0.f;
#pragma unroll
            for (int jj = 0; jj < 2; ++jj)
#pragma unroll
                for (int i = 0; i < 8; ++i) a += y[jj][r][i];
            sm[r] = a; }
#pragma unroll
        for (int of = 1; of < 64; of <<= 1) {
#pragma unroll
            for (int r = 0; r < 5; ++r) sm[r] += __shfl_xor(sm[r], of); }
#pragma unroll
        for (int r = 0; r < 5; ++r) { const float mu = sm[r] * (1.0f / 1024.f); float a = 0.f;
#pragma unroll
            for (int jj = 0; jj < 2; ++jj)
#pragma unroll
                for (int i = 0; i < 8; ++i) { y[jj][r][i] -= mu; a += y[jj][r][i] * y[jj][r][i]; }
            sq[r] = a; }
#pragma unroll
        for (int of = 1; of < 64; of <<= 1) {
#pragma unroll
            for (int r = 0; r < 5; ++r) sq[r] += __shfl_xor(sq[r], of); }
#pragma unroll
        for (int jj = 0; jj < 2; ++jj) { const int ch0 = (lane + 64 * jj) * 8;
            const f32x4 g0 = *(const f32x4*)(lng + ch0), g1 = *(const f32x4*)(lng + ch0 + 4), b0 = *(const f32x4*)(lnb + ch0), b1 = *(const f32x4*)(lnb + ch0 + 4);
            const float gg[8] = {g0.x, g0.y, g0.z, g0.w, g1.x, g1.y, g1.z, g1.w}, bb[8] = {b0.x, b0.y, b0.z, b0.w, b1.x, b1.y, b1.z, b1.w};
#pragma unroll
            for (int r = 0; r < 5; ++r) if (r < R) { const float rstd = rsqrtf(sq[r] * (1.0f / 1024.f) + EPS); float c[8];
#pragma unroll
                for (int i = 0; i < 8; ++i) c[i] = siluf_(y[jj][r][i] * rstd * gg[i] + bb[i]);
                *(u32x4*)(cat + (size_t)(mbase + r) * 2048 + ch0) = pack8(c); } }
      }
    }
    asm volatile("" ::: "memory"); __builtin_amdgcn_sched_barrier(0);
    for (int task = gw; task < BP * GPS + BS; task += NGW) {
      if (task >= BP * GPS) {
        const int m = MPR + task - BP * GPS; const bool prompt = false; const int b = m - MPR, t = 0;
#pragma unroll
        for (int jj = 0; jj < 6; ++jj) {
            const int ch0 = (lane + 64 * jj) * 8; float a[8], cur[8];
#pragma unroll
            for (int i = 0; i < 8; ++i) a[i] = 0.f;
#pragma unroll
            for (int j = 0; j < 4; ++j) {
                float x[8]; bool have = true;
                if (j == 3 || prompt) { const int tt = t - 3 + j; if (tt >= 0) { const u32x4 r = *(const u32x4*)(qkv + (size_t)(m - 3 + j) * 3072 + ch0); unpack8(r, x); } else have = false; }
                else { const float* hp = sdn + ((size_t)b * 3 + j) * 3072 + ch0; const f32x4 h0 = *(const f32x4*)hp, h1 = *(const f32x4*)(hp + 4); x[0] = h0.x; x[1] = h0.y; x[2] = h0.z; x[3] = h0.w; x[4] = h1.x; x[5] = h1.y; x[6] = h1.z; x[7] = h1.w; }
                if (have) { const f32x4 w0 = *(const f32x4*)(cw + j * 3072 + ch0), w1 = *(const f32x4*)(cw + j * 3072 + ch0 + 4);
                    a[0] += w0.x * x[0]; a[1] += w0.y * x[1]; a[2] += w0.z * x[2]; a[3] += w0.w * x[3]; a[4] += w1.x * x[4]; a[5] += w1.y * x[5]; a[6] += w1.z * x[6]; a[7] += w1.w * x[7];
                    if (j == 3) {
#pragma unroll
                        for (int i = 0; i < 8; ++i) cur[i] = x[i]; } }
            }
            float ss = 0.f;
#pragma unroll
            for (int i = 0; i < 8; ++i) { a[i] = siluf_(a[i]); ss += a[i] * a[i]; }
            if (jj < 4) { ss = grp16_sum(ss); float r = rsqrtf(ss + EPS); if (jj < 2) r *= 0.08838834764831845f;
#pragma unroll
                for (int i = 0; i < 8; ++i) a[i] *= r; }
            *(u32x4*)(qkvc + (size_t)m * 3072 + ch0) = pack8(a);
            if (prompt) { if (t >= SEQ - 3) { float* op = out + O_DCP + (((size_t)o * BP + b) * 3 + (t - (SEQ - 3))) * 3072 + ch0;
                    *(f32x4*)op = (f32x4){cur[0], cur[1], cur[2], cur[3]}; *(f32x4*)(op + 4) = (f32x4){cur[4], cur[5], cur[6], cur[7]}; } }
            else { float* ob = out + O_DCS + ((size_t)o * BS + b) * 3 * 3072 + ch0;
                *(f32x4*)(ob + 2 * 3072) = (f32x4){cur[0], cur[1], cur[2], cur[3]}; *(f32x4*)(ob + 2 * 3072 + 4) = (f32x4){cur[4], cur[5], cur[6], cur[7]}; }
        }
        if (lane < 8) { const float av = AB[(size_t)m * 16 + lane] + dtb[lane], bv = AB[(size_t)m * 16 + 8 + lane];
            const float sp = av > 20.f ? av : log1pf(expf(av));
            Gg[(size_t)m * 8 + lane] = -expf(alog[lane]) * sp; Bt[(size_t)m * 8 + lane] = 1.0f / (1.0f + expf(-bv)); }
      }
      else {
        const int b = task / GPS, gi = task - b * GPS, t0 = gi * 5, R = (SEQ - t0) < 5 ? (SEQ - t0) : 5, mbase = b * SEQ + t0;
#pragma unroll 1
        for (int jj = 0; jj < 6; ++jj) {
            const int ch0 = (lane + 64 * jj) * 8;
            f32x4 w[4][2];
#pragma unroll
            for (int j = 0; j < 4; ++j) { w[j][0] = *(const f32x4*)(cw + j * 3072 + ch0); w[j][1] = *(const f32x4*)(cw + j * 3072 + ch0 + 4); }
            u32x4 rg[8];
#pragma unroll
            for (int rr = 0; rr < 8; ++rr) { const bool valid = (t0 - 3 + rr >= 0) && (rr < 3 + R);
                const u32x4 v = *(const u32x4*)(qkv + (size_t)(valid ? mbase - 3 + rr : mbase) * 3072 + ch0); rg[rr] = valid ? v : (u32x4){0u, 0u, 0u, 0u}; }
            float a[5][8];
#pragma unroll
            for (int r = 0; r < 5; ++r)
#pragma unroll
                for (int i = 0; i < 8; ++i) a[r][i] = 0.f;
#pragma unroll
            for (int rr = 0; rr < 8; ++rr) { float x[8]; unpack8(rg[rr], x);
#pragma unroll
                for (int r = 0; r < 5; ++r) { const int j = rr - r; if (j >= 0 && j <= 3) {
                    a[r][0] += w[j][0].x * x[0]; a[r][1] += w[j][0].y * x[1]; a[r][2] += w[j][0].z * x[2]; a[r][3] += w[j][0].w * x[3];
                    a[r][4] += w[j][1].x * x[4]; a[r][5] += w[j][1].y * x[5]; a[r][6] += w[j][1].z * x[6]; a[r][7] += w[j][1].w * x[7]; } } }
            float ss[5];
#pragma unroll
            for (int r = 0; r < 5; ++r) { float q = 0.f;
#pragma unroll
                for (int i = 0; i < 8; ++i) { a[r][i] = siluf_(a[r][i]); q += a[r][i] * a[r][i]; }
                ss[r] = q; }
            if (jj < 4) {
#pragma unroll
                for (int of = 1; of < 16; of <<= 1) {
#pragma unroll
                    for (int r = 0; r < 5; ++r) ss[r] += __shfl_xor(ss[r], of); }
#pragma unroll
                for (int r = 0; r < 5; ++r) { float sc = rsqrtf(ss[r] + EPS); if (jj < 2) sc *= 0.08838834764831845f;
#pragma unroll
                    for (int i = 0; i < 8; ++i) a[r][i] *= sc; } }
#pragma unroll
            for (int r = 0; r < 5; ++r) if (r < R) *(u32x4*)(qkvc + (size_t)(mbase + r) * 3072 + ch0) = pack8(a[r]);
            if (t0 + R > SEQ - 3) {
#pragma unroll
                for (int r = 0; r < 5; ++r) if (r < R && t0 + r >= SEQ - 3) { float c8[8]; unpack8(rg[r + 3], c8);
                    float* op = out + O_DCP + (((size_t)o * BP + b) * 3 + (t0 + r - (SEQ - 3))) * 3072 + ch0;
                    *(f32x4*)op = (f32x4){c8[0], c8[1], c8[2], c8[3]}; *(f32x4*)(op + 4) = (f32x4){c8[4], c8[5], c8[6], c8[7]}; } }
        }
        if (lane < 40) { const int r = lane >> 3, hh = lane & 7; if (r < R) { const int m = mbase + r;
            const float av = AB[(size_t)m * 16 + hh] + dtb[hh], bv = AB[(size_t)m * 16 + 8 + hh];
            const float sp = av > 20.f ? av : log1pf(expf(av));
            Gg[(size_t)m * 8 + hh] = -expf(alog[hh]) * sp; Bt[(size_t)m * 8 + hh] = 1.0f / (1.0f + expf(-bv)); } }
      }
    }
}

__device__ __forceinline__ void phase_dn_intra(const Ctx& cx, PP P, int o, LAS unsigned char* lds) {
    const int tid = cx.tid, lane = tid & 63, l15 = lane & 15, quad = lane >> 4;
    const int hb = __builtin_amdgcn_readfirstlane(tid >> 8), htid = tid & 255, hw = __builtin_amdgcn_readfirstlane((tid >> 6) & 3);
    const int G = cx.G;
    unsigned char* ws = P->ws;
    const bf16_t* qkvc = (const bf16_t*)(ws + WS_MIX); const float* Gg = (const float*)(ws + WS_G); const float* Bt = (const float*)(ws + WS_BETA);
    float* CU = (float*)(ws + WS_CU); bf16_t* CW = (bf16_t*)(ws + WS_CW); bf16_t* CQD = (bf16_t*)(ws + WS_CQD); bf16_t* CKDT = (bf16_t*)(ws + WS_CKDT); bf16_t* CQK = (bf16_t*)(ws + WS_CQK); float* CGL = (float*)(ws + WS_CGL);
    LAS float* L = (LAS float*)lds + hb * 4352; LAS float* gcs = L + 4096; LAS float* bet = L + 4096 + 64;
    for (int p = cx.bid; p < 512; p += G) {
        const int ci = 2 * p + hb, bh = ci >> 5, n = ci & 31, b = bh >> 3, h = bh & 7, m0 = b * SEQ + n * 64;
        if (hw == 0) { float g = Gg[(size_t)(m0 + lane) * 8 + h];
#pragma unroll
            for (int off = 1; off < 64; off <<= 1) { const float tv = __shfl_up(g, off); if (lane >= off) g += tv; }
            gcs[lane] = g; bet[lane] = Bt[(size_t)(m0 + lane) * 8 + h]; }
        __syncthreads();
        {
            const int mt = hw; const bf16_t* rp = qkvc + (size_t)(m0 + 16 * mt + l15) * 3072 + h * 128;
            bf16x8 ak[4], aq[4];
#pragma unroll
            for (int ks = 0; ks < 4; ++ks) { aq[ks] = *(const bf16x8*)(rp + ks * 32 + quad * 8); ak[ks] = *(const bf16x8*)(rp + 1024 + ks * 32 + quad * 8); }
#pragma unroll
            for (int nt = 0; nt < 4; ++nt) {
                f32x4 accK = (f32x4){0.f, 0.f, 0.f, 0.f}, accQ = (f32x4){0.f, 0.f, 0.f, 0.f};
                if (nt <= mt) { const bf16_t* bp = qkvc + (size_t)(m0 + 16 * nt + l15) * 3072 + 1024 + h * 128;
#pragma unroll
                    for (int ks = 0; ks < 4; ++ks) { const bf16x8 bk = *(const bf16x8*)(bp + ks * 32 + quad * 8);
                        accK = __builtin_amdgcn_mfma_f32_16x16x32_bf16(ak[ks], bk, accK, 0, 0, 0); accQ = __builtin_amdgcn_mfma_f32_16x16x32_bf16(aq[ks], bk, accQ, 0, 0, 0); } }
                const int j = 16 * nt + l15; const float gj = gcs[j];
#pragma unroll
                for (int jj = 0; jj < 4; ++jj) { const int i = 16 * mt + quad * 4 + jj; const float dec = (j <= i) ? __expf(gcs[i] - gj) : 0.f;
                    L[i * 64 + j] = (j < i) ? bet[i] * accK[jj] * dec : 0.f;
                    CQK[(size_t)ci * 4096 + i * 64 + j] = (bf16_t)(cvt_pk_bf16(accQ[jj] * dec, 0.f) & 0xffff); }
            }
        }
        __syncthreads();
        asm volatile("" ::: "memory"); __builtin_amdgcn_sched_barrier(0);
        {
            const int c = htid; float x[64];
            const bf16_t* vp = qkvc + (size_t)m0 * 3072 + (c < 128 ? 2048 + h * 128 + c : 1024 + h * 128 + (c - 128));
#pragma unroll
            for (int i = 0; i < 64; ++i) { const float r = bf1(*vp); vp += 3072; asm volatile("" : "+v"(vp)); const float sc = c < 128 ? bet[i] : bet[i] * __expf(gcs[i]); x[i] = r * sc; }
#pragma unroll
            for (int i = 1; i < 64; ++i) { float a0 = 0.f, a1 = 0.f, a2 = 0.f, a3 = 0.f;
#pragma unroll
                for (int j4 = 0; j4 < (i + 3) / 4; ++j4) { const f32x4 l = *(const LAS f32x4*)(L + i * 64 + j4 * 4);
                    a0 += l.x * x[j4 * 4 + 0]; if (j4 * 4 + 1 < i) a1 += l.y * x[j4 * 4 + 1]; if (j4 * 4 + 2 < i) a2 += l.z * x[j4 * 4 + 2]; if (j4 * 4 + 3 < i) a3 += l.w * x[j4 * 4 + 3];
                    if (j4 == 7) asm volatile("" ::: "memory"); }
                x[i] = x[i] - ((a0 + a1) + (a2 + a3)); asm volatile("" ::: "memory"); }
            if (c < 128) { float* up = CU + (size_t)ci * 8192 + c;
#pragma unroll
                for (int i = 0; i < 64; ++i) { *up = x[i]; up += 128; asm volatile("" : "+v"(up)); } }
            else { bf16_t* wp = CW + (size_t)ci * 8192 + (c - 128);
#pragma unroll
                for (int i = 0; i < 64; ++i) { *wp = (bf16_t)(cvt_pk_bf16(x[i], 0.f) & 0xffff); wp += 128; asm volatile("" : "+v"(wp)); } }
        }
        asm volatile("" ::: "memory"); __builtin_amdgcn_sched_barrier(0);
        {
            const float glast = gcs[63];
#pragma unroll
            for (int it = 0; it < 4; ++it) { const int idx = htid + 256 * it, i = idx >> 4, dq = idx & 15; float f[8];
                const u32x4 r = *(const u32x4*)(qkvc + (size_t)(m0 + i) * 3072 + h * 128 + dq * 8); unpack8(r, f); const float eg = __expf(gcs[i]);
#pragma unroll
                for (int k = 0; k < 8; ++k) f[k] *= eg;
                *(u32x4*)(CQD + (size_t)ci * 8192 + i * 128 + dq * 8) = pack8(f); }
#pragma unroll
            for (int it = 0; it < 4; ++it) { const int idx = htid + 256 * it, d = idx & 127, ig = idx >> 7; float f[8];
#pragma unroll
                for (int ii = 0; ii < 8; ++ii) { const int i = ig * 8 + ii; f[ii] = bf1(qkvc[(size_t)(m0 + i) * 3072 + 1024 + h * 128 + d]) * __expf(glast - gcs[i]); }
                *(u32x4*)(CKDT + (size_t)ci * 8192 + d * 64 + ig * 8) = pack8(f); }
            if (htid == 0) CGL[ci] = __expf(glast);
        }
        __syncthreads();
    }
}
__device__ __forceinline__ void phase_dn_sample(const Ctx& cx, PP P, int o, LAS unsigned char* lds) {
    const int tid = cx.tid; const int G = cx.G; unsigned char* ws = P->ws;
    const bf16_t* qkvc = (const bf16_t*)(ws + WS_MIX); const float* Gg = (const float*)(ws + WS_G); const float* Bt = (const float*)(ws + WS_BETA);
    const float* S0 = P->in[5] + (size_t)o * BS * 8 * 16384; float* Sout = P->out + O_SS + (size_t)o * BS * 8 * 16384; float* O = (float*)(ws + WS_O);
    LAS float* sq = (LAS float*)lds; LAS float* sk = sq + 128; LAS float* sv = sk + 128; LAS float* red = sv + 128;
    const bf16_t* zgp = (const bf16_t*)(ws + WS_ZG); bf16_t* catp = (bf16_t*)(ws + WS_CAT); const float* ngp = P->in[25] + o * 128;
    for (int task = cx.bid; task < BS * 8; task += G) {
        const int b = task >> 3, h = task & 7, m = MPR + b;
        if (tid < 384) { const int which = tid >> 7, d = tid & 127; sq[which * 128 + d] = bf1(qkvc[(size_t)m * 3072 + which * 1024 + h * 128 + d]); }
        __syncthreads();
        const int e = tid & 127, part = tid >> 7;
        const float* sp = S0 + (size_t)task * 16384 + (size_t)(part * 32) * 128 + e;
        float s[32]; float ks = 0.f, qs = 0.f, qk = 0.f;
#pragma unroll
        for (int d = 0; d < 32; ++d) { s[d] = *sp; sp += 128; asm volatile("" : "+v"(sp)); }
#pragma unroll
        for (int d = 0; d < 32; ++d) { ks += sk[part * 32 + d] * s[d]; qs += sq[part * 32 + d] * s[d]; }
        if (tid < 64) { const float pq = wave_sum(sq[tid] * sk[tid] + sq[tid + 64] * sk[tid + 64]); if (tid == 0) red[1024] = pq; }
        red[part * 128 + e] = ks; red[512 + part * 128 + e] = qs;
        __syncthreads();
        qk = red[1024];
        const float ksum = red[e] + red[128 + e] + red[256 + e] + red[384 + e], qsum = red[512 + e] + red[640 + e] + red[768 + e] + red[896 + e];
        const float g = Gg[(size_t)m * 8 + h], beta = Bt[(size_t)m * 8 + h], eg = __expf(g);
        const float vnew = beta * (sv[e] - eg * ksum);
        float* op = Sout + (size_t)task * 16384 + (size_t)(part * 32) * 128 + e;
#pragma unroll
        for (int d = 0; d < 32; ++d) { *op = eg * s[d] + sk[part * 32 + d] * vnew; op += 128; asm volatile("" : "+v"(op)); }
        const float oval = eg * qsum + qk * vnew;
        if (part == 0) { const float p2 = wave_sum(oval * oval); if ((tid & 63) == 0) red[1032 + (tid >> 6)] = p2; }
        __syncthreads();
        if (part == 0) { const float rs = rsqrtf((red[1032] + red[1033]) * (1.0f / 128.f) + EPS);
            const float z = bf1(zgp[(size_t)m * 1024 + h * 128 + e]);
            catp[(size_t)m * 2048 + 1024 + h * 128 + e] = (bf16_t)(cvt_pk_bf16(oval * rs * ngp[e] * siluf_(z), 0.f) & 0xffff); }
        __syncthreads();
    }
}

struct ScanOps { bf16x8 a1[4], a2[2], a3[2]; f32x4 u; float gl; };
__device__ __forceinline__ void scan_load(ScanOps& o, int ci, int w, int l15, int quad, int e0, const float* CU, const bf16_t* CW, const bf16_t* CQD, const bf16_t* CKDT, const bf16_t* CQK, const float* CGL) {
    const int mt = w & 3;
    { const bf16_t* ap = (w < 4 ? CW : CQD) + (size_t)ci * 8192 + (16 * mt + l15) * 128;
#pragma unroll
      for (int ks = 0; ks < 4; ++ks) o.a1[ks] = *(const bf16x8*)(ap + ks * 32 + quad * 8); }
    o.u = (f32x4){0.f, 0.f, 0.f, 0.f};
#pragma unroll
    for (int ks = 0; ks < 2; ++ks) o.a2[ks] = (bf16x8){0, 0, 0, 0, 0, 0, 0, 0};
    if (w < 4) {
#pragma unroll
        for (int j = 0; j < 4; ++j) o.u[j] = CU[(size_t)ci * 8192 + (16 * mt + quad * 4 + j) * 128 + e0 + l15]; }
    else { const bf16_t* qp = CQK + (size_t)ci * 4096 + (16 * mt + l15) * 64;
#pragma unroll
        for (int ks = 0; ks < 2; ++ks) o.a2[ks] = *(const bf16x8*)(qp + ks * 32 + quad * 8); }
    { const bf16_t* kp = CKDT + (size_t)ci * 8192 + (16 * w + l15) * 64;
#pragma unroll
      for (int ks = 0; ks < 2; ++ks) o.a3[ks] = *(const bf16x8*)(kp + ks * 32 + quad * 8); }
    o.gl = CGL[ci];
}
#define SCAN_BAR() do { asm volatile("s_waitcnt lgkmcnt(0)" ::: "memory"); __builtin_amdgcn_s_barrier(); asm volatile("" ::: "memory"); } while (0)
__device__ __forceinline__ void phase_dn_scan(const Ctx& cx, PP P, int o, LAS unsigned char* lds) {
    const int tid = cx.tid, lane = tid & 63, l15 = lane & 15, quad = lane >> 4, w = __builtin_amdgcn_readfirstlane(tid >> 6);
    const int G = cx.G;
    unsigned char* ws = P->ws;
    const float* CU = (const float*)(ws + WS_CU); const bf16_t* CW = (const bf16_t*)(ws + WS_CW); const bf16_t* CQD = (const bf16_t*)(ws + WS_CQD); const bf16_t* CKDT = (const bf16_t*)(ws + WS_CKDT); const bf16_t* CQK = (const bf16_t*)(ws + WS_CQK); const float* CGL = (const float*)(ws + WS_CGL);
    float* O = (float*)(ws + WS_O);
    LAS bf16_t* ST = (LAS bf16_t*)lds;
    LAS bf16_t* VT = ST + 16 * 136;
    for (int task0 = cx.bid; task0 < 256; task0 += G) {
        const int task = (G == 256) ? ((task0 & 7) * 32 + (task0 >> 3)) : task0;
        const int bh = task >> 3, es = task & 7, e0 = es * 16, b = bh >> 3, h = bh & 7;
        const int mt = w & 3;
        f32x4 S = (f32x4){0.f, 0.f, 0.f, 0.f};
        f32x4 oacc = (f32x4){0.f, 0.f, 0.f, 0.f};
        ScanOps cur, nxt;
        scan_load(cur, bh * 32, w, l15, quad, e0, CU, CW, CQD, CKDT, CQK, CGL);
        for (int n = 0; n < 32; ++n) {
            const int m0 = b * SEQ + n * 64;
            scan_load(nxt, bh * 32 + (n < 31 ? n + 1 : n), w, l15, quad, e0, CU, CW, CQD, CKDT, CQK, CGL);
            { u32x2 sw; sw.x = cvt_pk_bf16(S[0], S[1]); sw.y = cvt_pk_bf16(S[2], S[3]); *(LAS u32x2*)(ST + l15 * 136 + 16 * w + quad * 4) = sw; }
            SCAN_BAR();
            { f32x4 acc = (f32x4){0.f, 0.f, 0.f, 0.f};
#pragma unroll
              for (int ks = 0; ks < 4; ++ks) { const bf16x8 bs = *(const LAS bf16x8*)(ST + l15 * 136 + ks * 32 + quad * 8); acc = __builtin_amdgcn_mfma_f32_16x16x32_bf16(cur.a1[ks], bs, acc, 0, 0, 0); }
              if (w < 4) { const f32x4 vn = cur.u - acc; u32x2 vw; vw.x = cvt_pk_bf16(vn[0], vn[1]); vw.y = cvt_pk_bf16(vn[2], vn[3]); *(LAS u32x2*)(VT + l15 * 72 + 16 * mt + quad * 4) = vw; }
              else oacc = acc; }
            SCAN_BAR();
            bf16x8 bv[2];
#pragma unroll
            for (int ks = 0; ks < 2; ++ks) bv[ks] = *(const LAS bf16x8*)(VT + l15 * 72 + ks * 32 + quad * 8);
            if (w >= 4) {
#pragma unroll
                for (int ks = 0; ks < 2; ++ks) oacc = __builtin_amdgcn_mfma_f32_16x16x32_bf16(cur.a2[ks], bv[ks], oacc, 0, 0, 0);
#pragma unroll
                for (int j = 0; j < 4; ++j) O[(size_t)(m0 + 16 * mt + quad * 4 + j) * 1024 + h * 128 + e0 + l15] = oacc[j]; }
            S = S * cur.gl;
#pragma unroll
            for (int ks = 0; ks < 2; ++ks) S = __builtin_amdgcn_mfma_f32_16x16x32_bf16(cur.a3[ks], bv[ks], S, 0, 0, 0);
            cur = nxt;
        }
        float* sp = P->out + O_SP + (((size_t)o * BP + b) * 8 + h) * 16384;
#pragma unroll
        for (int j = 0; j < 4; ++j) sp[(size_t)(16 * w + quad * 4 + j) * 128 + e0 + l15] = S[j];
        __syncthreads();
    }
}

__device__ __forceinline__ void phase_dn_gate(const Ctx& cx, PP P, int o) {
    const int tid = cx.tid, lane = tid & 63, wave = __builtin_amdgcn_readfirstlane(tid >> 6);
    const int gw = cx.bid * NWAVES + wave, NGW = cx.G * NWAVES;
    const float* O = (const float*)(P->ws + WS_O); const bf16_t* zg = (const bf16_t*)(P->ws + WS_ZG); bf16_t* cat = (bf16_t*)(P->ws + WS_CAT);
    const float* ng = P->in[25] + o * 128;
    for (int m = gw; m < MPR; m += 4 * NGW) {
        f32x4 ov[4][2][2]; u32x4 zv[4][2]; int mr[4]; bool ok[4];
#pragma unroll
        for (int k = 0; k < 4; ++k) { const int mk = m + k * NGW; ok[k] = mk < MPR; mr[k] = ok[k] ? mk : m;
#pragma unroll
            for (int jj = 0; jj < 2; ++jj) { const int ch0 = (lane + 64 * jj) * 8; ov[k][jj][0] = *(const f32x4*)(O + (size_t)mr[k] * 1024 + ch0); ov[k][jj][1] = *(const f32x4*)(O + (size_t)mr[k] * 1024 + ch0 + 4);
                zv[k][jj] = *(const u32x4*)(zg + (size_t)mr[k] * 1024 + ch0); } }
#pragma unroll
        for (int k = 0; k < 4; ++k)
#pragma unroll
            for (int jj = 0; jj < 2; ++jj) { const int ch0 = (lane + 64 * jj) * 8; const f32x4 o0 = ov[k][jj][0], o1 = ov[k][jj][1];
                float f[8] = {o0.x, o0.y, o0.z, o0.w, o1.x, o1.y, o1.z, o1.w}; float ss = 0.f;
#pragma unroll
                for (int i = 0; i < 8; ++i) ss += f[i] * f[i];
                const float rs = rsqrtf(grp16_sum(ss) * (1.0f / 128.f) + EPS);
                float z[8]; unpack8(zv[k][jj], z);
#pragma unroll
                for (int i = 0; i < 8; ++i) f[i] = f[i] * rs * ng[(ch0 & 127) + i] * siluf_(z[i]);
                if (ok[k]) *(u32x4*)(cat + (size_t)mr[k] * 2048 + 1024 + ch0) = pack8(f); }
    }
}

#define XB_TMO      128
#define XB_XCNT(j)  (256  + 64 * (j))
#define XB_XSUB(j)  (1280 + 64 * (j))
#define XB_XGEN(j)  (2304 + 64 * (j))
#define XB_TOP      3328
#define XB_TOPGEN   3392
#define XCD_BAR_WORDS 3456
#define XB_SPIN_CAP (1u << 20)
__device__ __forceinline__ unsigned xb_ld(unsigned* p)              { return __hip_atomic_load(p, __ATOMIC_RELAXED, __HIP_MEMORY_SCOPE_AGENT); }
__device__ __forceinline__ unsigned xb_add(unsigned* p, unsigned v) { return __hip_atomic_fetch_add(p, v, __ATOMIC_RELAXED, __HIP_MEMORY_SCOPE_AGENT); }
__device__ __forceinline__ unsigned xb_xcc_id() { return (unsigned)__builtin_amdgcn_s_getreg((3 << 11) | 20) & 0xFu; }
#define XB_SPIN(cond, bar) do { unsigned _sp = 0; while (cond) { __builtin_amdgcn_s_sleep(1); \
    if ((++_sp & 255u) == 0u) { if (xb_ld(&(bar)[XB_TMO])) break; if (_sp > XB_SPIN_CAP) { atomicAdd(&(bar)[XB_TMO], 1u); break; } } } } while (0)
struct XcdBarrier { unsigned* bar; unsigned x; volatile LAS unsigned* st; };
__device__ __forceinline__ XcdBarrier xcd_barrier_post(unsigned* bar, volatile LAS unsigned* st) {
    XcdBarrier b; b.bar = bar; b.x = xb_xcc_id(); b.st = st;
    if (threadIdx.x == 0) (void)xb_add(&bar[XB_XCNT(b.x)], 1u);
    return b;
}
__device__ __forceinline__ void xcd_barrier_complete(unsigned* bar, unsigned x, unsigned& nloc, unsigned& nx) {
    const unsigned G = gridDim.x * gridDim.y * gridDim.z;
    unsigned sum, cnt, mine, sp = 0u;
    for (;;) {
        sum = 0u; cnt = 0u; mine = 0u;
#pragma unroll
        for (unsigned j = 0; j < 16; ++j) { const unsigned c = xb_ld(&bar[XB_XCNT(j)]); sum += c; cnt += (c > 0u) ? 1u : 0u; mine = (j == x) ? c : mine; }
        if (sum == G) break;
        __builtin_amdgcn_s_sleep(1);
        if ((++sp & 255u) == 0u) { if (xb_ld(&bar[XB_TMO])) break; if (sp > XB_SPIN_CAP) { atomicAdd(&bar[XB_TMO], 1u); break; } }
    }
    nloc = mine > 0u ? mine : 1u; nx = cnt > 0u ? cnt : 1u;
}
__device__ __forceinline__ void xcd_barrier(const XcdBarrier& b) {
    asm volatile("s_waitcnt vmcnt(0)" ::: "memory");
    __syncthreads();
    if (threadIdx.x == 0) {
        unsigned* bar = b.bar;
        __builtin_amdgcn_s_waitcnt(0);
        unsigned nloc = b.st[0], nx = b.st[1];
        if (nloc == 0u) { xcd_barrier_complete(bar, b.x, nloc, nx); b.st[0] = nloc; b.st[1] = nx; }
        const unsigned old = xb_add(&bar[XB_XSUB(b.x)], 1u);
        const unsigned gen = old / nloc;
        if (old + 1u == (gen + 1u) * nloc) {
            __builtin_amdgcn_fence(__ATOMIC_RELEASE, "agent");
            asm volatile("s_waitcnt vmcnt(0)" ::: "memory");
            const unsigned og = xb_add(&bar[XB_TOP], 1u);
            const unsigned tg = og / nx;
            if (og + 1u == (tg + 1u) * nx) xb_add(&bar[XB_TOPGEN], 1u);
            else XB_SPIN(xb_ld(&bar[XB_TOPGEN]) == tg, bar);
            __builtin_amdgcn_fence(__ATOMIC_ACQUIRE, "agent");
            xb_add(&bar[XB_XGEN(b.x)], 1u);
            asm volatile("s_waitcnt vmcnt(0)" ::: "memory");
        } else {
            XB_SPIN(xb_ld(&bar[XB_XGEN(b.x)]) == gen, bar);
            __builtin_amdgcn_fence(__ATOMIC_ACQUIRE, "agent");
            asm volatile("s_waitcnt vmcnt(0)" ::: "memory");
        }
    }
    __syncthreads();
}

__device__ __forceinline__ void copy_rows_shift(const Ctx& cx, const float* src, float* dst, int nb, int rows_in, int rows_copy, int width4) {
    const int per_b = rows_copy * width4, total = nb * per_b;
    for (int i = (cx.G - 1 - cx.bid) * NTHR + cx.tid; i < total; i += cx.G * NTHR) { const int b = i / per_b, r = i - b * per_b;
        ((f32x4*)dst)[(size_t)b * rows_in * width4 + r] = ((const f32x4*)src)[(size_t)b * rows_in * width4 + width4 + r]; }
}
constexpr int NPHASES = 1 + 8 + 10 + 8 + 10 + 1;
__global__ void __launch_bounds__(NTHR, 2) mega_fwd(Params Pin) {
    extern __shared__ __attribute__((aligned(16))) unsigned char lds_raw[];
    LAS unsigned char* lds = (LAS unsigned char*)lds_raw;
    const __attribute__((address_space(4))) unsigned char* kp = (const __attribute__((address_space(4))) unsigned char*)__builtin_amdgcn_kernarg_segment_ptr();
    constexpr int nM = MPAD / 256;
    volatile LAS unsigned* bst = (volatile LAS unsigned*)(lds + 131072);
    if (threadIdx.x < 2) bst[threadIdx.x] = 0u;
    __syncthreads();
    XcdBarrier gbar; gbar.bar = nullptr; gbar.x = 0; gbar.st = bst;
    if (((PP)kp)->coop) gbar = xcd_barrier_post((unsigned*)(((PP)kp)->ws + WS_BAR), bst);
    const int ph_lo = ((PP)kp)->ph_lo, ph_hi = ((PP)kp)->ph_hi;
#ifdef EXTRA_SYNCS
    for (int i = 0; i < EXTRA_SYNCS; ++i) xcd_barrier(gbar);
#endif
    int did_rep = 0;
    for (int ph = ph_lo; ph < ph_hi; ++ph) {
        asm volatile("" : "+s"(kp));
        Ctx cx; cx.tid = threadIdx.x; cx.bid = blockIdx.x; cx.G = gridDim.x;
        asm volatile("" : "+v"(cx.tid)); asm volatile("" : "+s"(cx.bid)); asm volatile("" : "+s"(cx.G));
        PP P = (PP)kp;
        unsigned char* ws = P->ws;
        float* X = (float*)(ws + WS_X); bf16_t* H = (bf16_t*)(ws + WS_H); bf16_t* ACT = (bf16_t*)(ws + WS_ACT); bf16_t* CAT = (bf16_t*)(ws + WS_CAT);
        float* PX = (float*)(ws + WS_PARTX);
        int l, op;
        if (ph == 0) { l = 0; op = 10; }
        else if (ph == NPHASES - 1) { l = 0; op = 11; }
        else { int r = ph - 1; const int pair = r / 18; r %= 18;
            if (r < 8) { l = 2 * pair; op = r < 4 ? r : r + 2; }
            else { l = 2 * pair + 1; op = r - 8; } }
        const bool even = (l & 1) == 0; const int e = l >> 1;
#ifndef OPMASK
#define OPMASK 0xfff
#endif
#ifndef REPMASK
#define REPMASK 0
#endif
        if (!(((OPMASK) >> op) & 1)) continue;
        const bool dry = REPMASK && ((REPMASK >> op) & 1) && !did_rep;
        switch (op) {
        case 10: phase_prep(cx, P, lds); phase_first_norm(cx, P, X, P->in[6], H); break;
        case 11: phase_rmsnorm<true>(cx, X, P->in[8], nullptr, P->out + O_YP, PX, 44, dry, lds); break;
        case 0: if (l > 0) phase_rmsnorm<false>(cx, X, P->in[6] + (size_t)l * D, H, nullptr, PX, l > 0 ? 44 : 0, dry, lds); break;
        case 7: phase_rmsnorm<false>(cx, X, P->in[7] + (size_t)l * D, H, nullptr, PX, 16, dry, lds); break;
        case 1:
            if (even) { pg8::StaticSched S; S.init(cx, H, (bf16_t*)(ws + WS_WEVIN) + (size_t)e * EV_IN * 2048, 2048, 2048, nM, EV_IN / 256, 2048, 0);
                pg8::EpiEvenIn E{(bf16_t*)(ws + WS_ABUF), (bf16_t*)(ws + WS_UV)}; pg8::gemm_phase(cx, lds, S, E);
                copy_rows_shift(cx, P->in[2] + (size_t)e * BS * 15 * 1024, P->out + O_PS + (size_t)e * BS * 15 * 1024, BS, 15, 14, 256);
                if (l == 0) convert_slot(cx, P, lds, 1, 0, DEF1_A, 140, 116); else convert_slot(cx, P, lds, 3, 0, DEF3_A, 140, 116); }
            else { pg8::StaticSched S; S.init(cx, H, (bf16_t*)(ws + WS_WODIN) + (size_t)e * OD_INM * 2048, 2048, 2048, nM, OD_INM / 256, 2048, 0);
                pg8::EpiOddIn E{(bf16_t*)(ws + WS_ABUF), (bf16_t*)(ws + WS_UV), (bf16_t*)(ws + WS_ZG)}; pg8::gemm_phase(cx, lds, S, E);
                phase_ab(cx, P, e);
                copy_rows_shift(cx, P->in[3] + (size_t)e * BS * 30 * 1024, P->out + O_CS + (size_t)e * BS * 30 * 1024, BS, 30, 29, 256);
                copy_rows_shift(cx, P->in[4] + (size_t)e * BS * 3 * 3072, P->out + O_DCS + (size_t)e * BS * 3 * 3072, BS, 3, 2, 768);
                if (l == 1) convert_slot(cx, P, lds, 2, 0, DEF2_A, 24, 166); }
            break;
        case 2: if (even) phase_even_prep(cx, P, e); else phase_odd_prep(cx, P, e, lds); break;
        case 3:
            if (even) {
#ifndef DBG_NO_POOL
                pg8::StaticSched S; S.init(cx, ws + WS_MIX, (bf16_t*)(ws + WS_WPOOL) + (size_t)e * 1024 * 256, 1024, 256, nM, 4, 256, 512);
                pg8::EpiPool E{CAT, P->in[11] + e * 1024}; pg8::gemm_phase(cx, lds, S, E);
                __syncthreads();
#endif
#ifndef DBG_NO_SGU
                phase_sgu(cx, P, e, lds);
#endif
            }
#ifndef DBG_NO_DNI
            else phase_dn_intra(cx, P, e, lds);
#endif
            break;
        case 4: phase_dn_sample(cx, P, e, lds); __syncthreads(); phase_dn_scan(cx, P, e, lds); break;
        case 5: phase_dn_gate(cx, P, e); break;
        case 6: { const bf16_t* Wt = (even ? (bf16_t*)(ws + WS_WEVOUT) : (bf16_t*)(ws + WS_WODOUT)) + (size_t)e * 2048 * 2048;
                pg8::ResidSched S; S.init(cx, CAT, Wt, 2048, 2048); pg8::EpiResidX E{{X, dry}, {PX, dry}}; pg8::gemm_phase(cx, lds, S, E); } break;
        case 8: { pg8::StaticSched S; S.init(cx, H, (bf16_t*)(ws + WS_WUP) + (size_t)l * 2 * DFF * 2048, 2048, 2048, nM, 2 * DFF / 256, 2048, 0);
                pg8::EpiUp E{ACT}; pg8::gemm_phase(cx, lds, S, E);
                if (l == 0) convert_slot(cx, P, lds, 1, DEF1_A, DEF1_B, 172, 84); else if (l == 1) convert_slot(cx, P, lds, 2, DEF2_A, DEF2_B, 172, 84); else if (l == 2) convert_slot(cx, P, lds, 3, DEF3_A, DEF3_B, 172, 84); } break;
        case 9: { const bf16_t* Wt = (bf16_t*)(ws + WS_WDOWN) + (size_t)l * 2048 * DFF;
                pg8::ResidSched S; S.init(cx, ACT, Wt, DFF, DFF); pg8::EpiResidX E{{X, dry}, {PX, dry}}; pg8::gemm_phase(cx, lds, S, E); } break;
        default: break;
        }
        if (REPMASK) { if (((REPMASK >> op) & 1) && !did_rep) { did_rep = 1; --ph; } else did_rep = 0; }
        if (ph + 1 < ph_hi && !(op == 0 && l == 0)) { if (P->coop) { if (ph == 0) cg::this_grid().sync(); else xcd_barrier(gbar); } }
    }
}

#ifndef MK_COOP
#define MK_COOP 1
#endif
extern "C" void kernel_launch(void* const* d_in, const int* in_sizes, int n_in, void* d_out, int out_size, void* d_ws, size_t ws_size, hipStream_t stream) {
    static int grid = 0;
    if (grid == 0) {
        if (n_in != 29 || (size_t)out_size != O_END || ws_size < WS_END) { fprintf(stderr, "kernel_launch: unexpected shapes n_in %d out %d ws %zu (need %zu)\n", n_in, out_size, ws_size, (size_t)WS_END); grid = -1; return; }
        int dev = 0, cus = 0, per_cu = 0;
        hipGetDevice(&dev); hipDeviceGetAttribute(&cus, hipDeviceAttributeMultiprocessorCount, dev);
        if (hipFuncSetAttribute((const void*)mega_fwd, hipFuncAttributeMaxDynamicSharedMemorySize, LDS_BYTES) != hipSuccess) { fprintf(stderr, "kernel_launch: hipFuncSetAttribute failed\n"); grid = -1; return; }
        if (hipOccupancyMaxActiveBlocksPerMultiprocessor(&per_cu, (const void*)mega_fwd, NTHR, LDS_BYTES) != hipSuccess || per_cu < 1) { fprintf(stderr, "kernel_launch: occupancy query says %d\n", per_cu); per_cu = 1; }
        (void)hipGetLastError();
        grid = cus < 256 ? cus : 256;
        if (grid <= 0) grid = 256;
    }
    if (grid < 0) return;
    Params p{};
    for (int i = 0; i < 29; ++i) p.in[i] = (const float*)d_in[i];
    p.out = (float*)d_out; p.ws = (unsigned char*)d_ws; p.pad = 0;
#if MK_COOP
    p.ph_lo = 0; p.ph_hi = NPHASES; p.coop = 1;
    if (hipMemsetAsync((char*)d_ws + WS_BAR, 0, WS_BAR_BYTES, stream) != hipSuccess) { fprintf(stderr, "kernel_launch: memset of barrier words failed\n"); return; }
    void* args[] = {&p};
    hipError_t e = hipLaunchCooperativeKernel((const void*)mega_fwd, dim3(grid), dim3(NTHR), args, LDS_BYTES, stream);
    if (e != hipSuccess) fprintf(stderr, "cooperative launch failed: %s (grid %d)\n", hipGetErrorString(e), grid);
#else
    p.coop = 0;
    for (int ph = 0; ph < NPHASES; ++ph) { p.ph_lo = ph; p.ph_hi = ph + 1; hipLaunchKernelGGL(mega_fwd, dim3(grid), dim3(NTHR), LDS_BYTES, stream, p); }
#endif
}
```

```cpp
#include <hip/hip_runtime.h>
#include <hip/hip_cooperative_groups.h>
#include <cstdio>
namespace cg = cooperative_groups;

#define LAS __attribute__((address_space(3)))
typedef unsigned short bf16_t;
typedef short bf16x8 __attribute__((ext_vector_type(8)));
typedef float f32x4 __attribute__((ext_vector_type(4)));
typedef float f32x2 __attribute__((ext_vector_type(2)));
typedef unsigned u32x4 __attribute__((ext_vector_type(4)));
typedef unsigned u32x2 __attribute__((ext_vector_type(2)));

constexpr int D = 2048, SEQ = 2048, BP = 4, MPR = BP * SEQ, BS = 128, MT = MPR + BS, MPAD = 8448;
constexpr int DFF = 5632, EV_IN = 3072, OD_IN = 6160, OD_INM = 6144;
constexpr float EPS = 1e-6f;
constexpr int NTHR = 512, NWAVES = 8;
constexpr int LDS_BYTES = 131072 + 1024;

constexpr size_t O_YP = 0;
constexpr size_t O_YS = O_YP + (size_t)MPR * D;
constexpr size_t O_PP = O_YS + (size_t)BS * D;
constexpr size_t O_PS = O_PP + (size_t)2 * BP * 15 * 1024;
constexpr size_t O_SV = O_PS + (size_t)2 * BS * 15 * 1024;
constexpr size_t O_CP = O_SV + (size_t)2 * BS * 1024;
constexpr size_t O_CS = O_CP + (size_t)2 * BP * 30 * 1024;
constexpr size_t O_DCP = O_CS + (size_t)2 * BS * 30 * 1024;
constexpr size_t O_DCS = O_DCP + (size_t)2 * BP * 3 * 3072;
constexpr size_t O_SP = O_DCS + (size_t)2 * BS * 3 * 3072;
constexpr size_t O_SS = O_SP + (size_t)2 * BP * 8 * 128 * 128;
constexpr size_t O_END = O_SS + (size_t)2 * BS * 8 * 128 * 128;

constexpr size_t al(size_t x) { return (x + 4095) & ~(size_t)4095; }
constexpr size_t WS_X = 0;
constexpr size_t WS_H = WS_X + al((size_t)MPAD * D * 4);
constexpr size_t WS_ACT = WS_H + al((size_t)MPAD * D * 2);
constexpr size_t WS_CAT = WS_ACT + al((size_t)MPAD * DFF * 2);
constexpr size_t WS_ABUF = WS_CAT + al((size_t)MPAD * D * 2);
constexpr size_t WS_UV = WS_ABUF + al((size_t)MPAD * 1024 * 2);
constexpr size_t WS_ZG = WS_UV + al((size_t)MPAD * 3072 * 2);
constexpr size_t WS_MIX = WS_ZG + al((size_t)MPAD * 1024 * 2);
constexpr size_t WS_VN = WS_MIX + al((size_t)MPAD * 3072 * 2);
constexpr size_t WS_AB = WS_VN + al((size_t)MPAD * 1024 * 2);
constexpr size_t WS_G = WS_AB + al((size_t)MPAD * 16 * 4);
constexpr size_t WS_BETA = WS_G + al((size_t)MPAD * 8 * 4);
constexpr size_t WS_O = WS_BETA + al((size_t)MPAD * 8 * 4);
constexpr size_t WS_CU = WS_O + al((size_t)MPAD * 1024 * 4);
constexpr size_t WS_CW = WS_CU + al((size_t)1024 * 8192 * 4);
constexpr size_t WS_CQD = WS_CW + al((size_t)1024 * 8192 * 2);
constexpr size_t WS_CKDT = WS_CQD + al((size_t)1024 * 8192 * 2);
constexpr size_t WS_CQK = WS_CKDT + al((size_t)1024 * 8192 * 2);
constexpr size_t WS_CGL = WS_CQK + al((size_t)1024 * 4096 * 2);
constexpr size_t WS_WEVIN = WS_CGL + al(4096);
constexpr size_t WS_WEVOUT = WS_WEVIN + al((size_t)2 * 3072 * 2048 * 2);
constexpr size_t WS_WODIN = WS_WEVOUT + al((size_t)2 * 2048 * 2048 * 2);
constexpr size_t WS_WODOUT = WS_WODIN + al((size_t)2 * 6144 * 2048 * 2);
constexpr size_t WS_WUP = WS_WODOUT + al((size_t)2 * 2048 * 2048 * 2);
constexpr size_t WS_WDOWN = WS_WUP + al((size_t)4 * 11264 * 2048 * 2);
constexpr size_t WS_WPOOL = WS_WDOWN + al((size_t)4 * 2048 * 5632 * 2);
constexpr size_t WS_PARTX = WS_WPOOL + al((size_t)2 * 1024 * 256 * 2);
constexpr size_t WS_WAB = WS_PARTX + al((size_t)256 * 32768 * 4);
constexpr size_t WS_BAR = WS_WAB + al((size_t)2 * 16 * 2048 * 2);
constexpr size_t WS_BAR_BYTES = 16384;
constexpr size_t WS_END = WS_BAR + WS_BAR_BYTES;

struct Params { const float* in[29]; float* out; unsigned char* ws; int ph_lo, ph_hi, coop, pad; };
typedef const __attribute__((address_space(4))) Params* PP;
struct Ctx { int tid, bid, G; };

__device__ __forceinline__ unsigned cvt_pk_bf16(float lo, float hi) { unsigned r; asm volatile("v_cvt_pk_bf16_f32 %0, %1, %2" : "=v"(r) : "v"(lo), "v"(hi)); return r; }
__device__ __forceinline__ float bf_lo(unsigned w) { return __uint_as_float(w << 16); }
__device__ __forceinline__ float bf_hi(unsigned w) { return __uint_as_float(w & 0xffff0000u); }
__device__ __forceinline__ float bf1(bf16_t h) { return __uint_as_float(((unsigned)h) << 16); }
__device__ __forceinline__ void unpack8(const u32x4 w, float (&f)[8]) { f[0] = bf_lo(w.x); f[1] = bf_hi(w.x); f[2] = bf_lo(w.y); f[3] = bf_hi(w.y); f[4] = bf_lo(w.z); f[5] = bf_hi(w.z); f[6] = bf_lo(w.w); f[7] = bf_hi(w.w); }
__device__ __forceinline__ u32x4 pack8(const float (&f)[8]) { u32x4 w; w.x = cvt_pk_bf16(f[0], f[1]); w.y = cvt_pk_bf16(f[2], f[3]); w.z = cvt_pk_bf16(f[4], f[5]); w.w = cvt_pk_bf16(f[6], f[7]); return w; }
__device__ __forceinline__ float sigmoidf_(float x) { return __builtin_amdgcn_rcpf(1.0f + __expf(-x)); }
__device__ __forceinline__ float siluf_(float x) { return x * sigmoidf_(x); }
__device__ __forceinline__ float wave_sum(float v) {
#pragma unroll
    for (int o = 1; o < 64; o <<= 1) v += __shfl_xor(v, o);
    return v;
}
__device__ __forceinline__ float grp16_sum(float v) {
#pragma unroll
    for (int o = 1; o < 16; o <<= 1) v += __shfl_xor(v, o);
    return v;
}
__device__ __forceinline__ f32x2 gelu_pk(f32x2 v) {
    const f32x2 av = __builtin_elementwise_abs(v), d = av * 0.2316418882f + 1.0f;
    f32x2 t; t.x = __builtin_amdgcn_rcpf(d.x); t.y = __builtin_amdgcn_rcpf(d.y);
    f32x2 q = t * 0.5307027145f + (-0.7265760135f); q = q * t + 0.7107068705f; q = q * t + (-0.142248368f); q = q * t + 0.127414796f; q = q * t;
    const f32x2 s = (v * v) * (-0.72134752044f);
    f32x2 e; e.x = __builtin_amdgcn_exp2f(s.x); e.y = __builtin_amdgcn_exp2f(s.y);
    const f32x2 m = v * (q * e), r = v - m;
    f32x2 o; o.x = v.x < 0.f ? m.x : r.x; o.y = v.y < 0.f ? m.y : r.y; return o;
}

namespace pg8 {
constexpr int BM = 256, BK = 64, HALF = 128, HTB = HALF * BK * 2, STAGE_BYTES = 8 * HTB, NXCD = 8, WGM = 4;
__device__ __forceinline__ int lds_byte(int r, int c) { const int st = (r >> 4) * 2 + (c >> 5), rr = r & 15, cc = c & 31, ob = rr * 64 + cc * 2; return st * 1024 + (ob ^ (((ob >> 9) & 1) << 5)); }
__device__ __forceinline__ void stage_rc(int b, int& R, int& C) { const int st = b / 1024, sb = b % 1024, swz = sb ^ (((sb >> 9) & 1) << 5); R = (st >> 1) * 16 + swz / 64; C = (st & 1) * 32 + (swz % 64) / 2; }
__device__ __forceinline__ int perm32(int rho) { const int n = rho >> 4, i = rho & 15; return 8 * (i >> 2) + 4 * n + (i & 3); }

struct Unit { int pm, pn, nt, pad; const char* A; const char* B; };

__device__ __forceinline__ void unit_pmpn(int wgid, int nM, int nN, int& pm, int& pn) {
    const int nig = WGM * nN, gid = wgid / nig, fm = gid * WGM, gsz = (nM - fm) < WGM ? (nM - fm) : WGM;
    pm = fm + ((wgid % nig) % gsz); pn = (wgid % nig) / gsz;
}
struct StaticSched {
    const char* A; const char* B; int lda, ldb, nM, nN, nwg, G, c, nt; size_t a_pn_stride;
    __device__ __forceinline__ void init(const Ctx& cx, const void* A_, const void* B_, int lda_, int ldb_, int nM_, int nN_, int K, size_t apn) {
        A = (const char*)A_; B = (const char*)B_; lda = lda_; ldb = ldb_; nM = nM_; nN = nN_; nwg = nM * nN; G = cx.G; c = cx.bid; nt = K / BK; a_pn_stride = apn; }
    __device__ __forceinline__ bool next(int i, Unit& u) const {
        const long L = (long)i * G + c; if (L >= nwg) return false;
        int wgid = (int)L; { const int q = nwg / NXCD, r = nwg % NXCD, xcd = wgid % NXCD, off = wgid / NXCD; wgid = (xcd < r ? xcd * (q + 1) : r * (q + 1) + (xcd - r) * q) + off; }
        unit_pmpn(wgid, nM, nN, u.pm, u.pn); u.nt = nt; u.pad = 0;
        u.A = A + (size_t)u.pm * BM * lda * 2 + (size_t)u.pn * a_pn_stride; u.B = B + (size_t)u.pn * BM * ldb * 2; return true;
    }
};
struct StreamKSched {
    const char* A; const char* B; int lda, ldb, pm_base, nN, ppu, p0, p1, u0, vc;
    __device__ __forceinline__ void init(const Ctx& cx, const void* A_, const void* B_, int lda_, int ldb_, int pm_base_, int nN_, int K) {
        A = (const char*)A_; B = (const char*)B_; lda = lda_; ldb = ldb_; pm_base = pm_base_; nN = nN_; ppu = K / (2 * BK);
        const int G = cx.G, bx = cx.bid; vc = (G % 8 == 0) ? (bx % 8) * (G / 8) + bx / 8 : bx;
        const long P = (long)nN * ppu; p0 = (int)((vc * P) / G); p1 = (int)(((vc + 1) * P) / G); u0 = p0 / ppu; }
    __device__ __forceinline__ bool next(int i, Unit& u) const {
        const int ui = u0 + i; const long lo = (long)ui * ppu; if (lo >= p1) return false;
        const int s = (int)(lo > p0 ? lo : p0), e = (int)((lo + ppu) < p1 ? (lo + ppu) : p1);
        u.pm = pm_base; u.pn = ui; u.nt = 2 * (e - s); u.pad = vc;
        const size_t koff = (size_t)(s - (int)lo) * 2 * BK * 2;
        u.A = A + (size_t)u.pm * BM * lda * 2 + koff; u.B = B + (size_t)u.pn * BM * ldb * 2 + koff; return true;
    }
};

struct ResidSched {
    StaticSched a; StreamKSched b; int na, lda, ldb;
    __device__ __forceinline__ void init(const Ctx& cx, const void* A_, const void* B_, int ld, int K) {
        a.init(cx, A_, B_, ld, ld, MPR / 256, 8, K, 0); b.init(cx, A_, B_, ld, ld, MPR / 256, 8, K); lda = ld; ldb = ld;
        na = (a.nwg - a.c + a.G - 1) / a.G; if (na < 0) na = 0; }
    __device__ __forceinline__ bool next(int i, Unit& u) const { if (i < na) return a.next(i, u); return b.next(i - na, u); }
};
template <class Epi, class Sched>
__device__ __forceinline__ void gemm_phase(const Ctx& cx, LAS unsigned char* lds, const Sched& S, const Epi& E) {
    const int tid = cx.tid, wid = __builtin_amdgcn_readfirstlane(tid >> 6), lane = tid & 63, wr = wid >> 2, wc = wid & 3, fr = lane & 15, fq = lane >> 4;
    const int lda = S.lda, ldb = S.ldb;
    unsigned voffA[2], voffB[2];
#pragma unroll
    for (int i = 0; i < 2; ++i) { int R, C; stage_rc(tid * 16 + i * 8192, R, C); const int Rb = Epi::PERM ? ((R & ~31) + perm32(R & 31)) : R;
        voffA[i] = (unsigned)(R * lda + C) * 2u; voffB[i] = (unsigned)(Rb * ldb + C) * 2u; }
    const size_t kstep = (size_t)(BK * 2);
    const size_t hstepA = (size_t)HALF * lda * 2, hstepB = (size_t)HALF * ldb * 2;
    const unsigned ldsw = (unsigned)wid * 1024u;
    const int aoff = lds_byte(wr * 64 + fr, fq * 8), boff = lds_byte(wc * 32 + fr, fq * 8);
#define PG8_SA(b, h) (((b) * 2 + (h)) * HTB)
#define PG8_SB(b, h) ((4 + (b) * 2 + (h)) * HTB)
#define PG8_STAGE(bufoff, gbase, voff) do { _Pragma("unroll") for (int _i = 0; _i < 2; ++_i) \
        __builtin_amdgcn_global_load_lds((const unsigned*)((const char*)(gbase) + (voff)[_i]), (LAS unsigned*)(lds + (bufoff) + ldsw + _i * 8192), 16, 0, 0); } while (0)
#define PG8_LDA(dst, b, h) do { _Pragma("unroll") for (int m = 0; m < 4; ++m) _Pragma("unroll") for (int k = 0; k < 2; ++k) dst[m][k] = *(const LAS bf16x8*)(lds + PG8_SA(b, h) + aoff + m * 2048 + k * 1024); } while (0)
#define PG8_LDB(dst, b, h) do { _Pragma("unroll") for (int n = 0; n < 2; ++n) _Pragma("unroll") for (int k = 0; k < 2; ++k) dst[n][k] = *(const LAS bf16x8*)(lds + PG8_SB(b, h) + boff + n * 2048 + k * 1024); } while (0)
#define PG8_MMA(ai, bj, At, Bt) do { __builtin_amdgcn_s_setprio(1); _Pragma("unroll") for (int m = 0; m < 4; ++m) _Pragma("unroll") for (int n = 0; n < 2; ++n) _Pragma("unroll") for (int k = 0; k < 2; ++k) \
        acc[ai][bj][m][n] = __builtin_amdgcn_mfma_f32_16x16x32_bf16(Bt[n][k], At[m][k], acc[ai][bj][m][n], 0, 0, 0); __builtin_amdgcn_s_setprio(0); } while (0)
#define PG8_WAIT_V(n) asm volatile("s_waitcnt vmcnt(" #n ")" ::: "memory")
#define PG8_WAIT_L(n) asm volatile("s_waitcnt lgkmcnt(" #n ")" ::: "memory")
#define PG8_BAR __builtin_amdgcn_s_barrier()
#define PG8_SCHED __builtin_amdgcn_sched_barrier(0)
    Unit cur, nxt; int ui = 0;
    if (!S.next(0, cur)) return;
    f32x4 acc[2][2][4][2];
#pragma unroll
    for (int a = 0; a < 2; ++a)
#pragma unroll
        for (int b = 0; b < 2; ++b)
#pragma unroll
            for (int m = 0; m < 4; ++m)
#pragma unroll
                for (int n = 0; n < 2; ++n) acc[a][b][m][n] = (f32x4){0.f, 0.f, 0.f, 0.f};
    bf16x8 At[4][2], B0[2][2], B1[2][2];
    const char* cA = cur.A; const char* cB = cur.B;
    PG8_STAGE(PG8_SB(0, 0), cB, voffB); PG8_STAGE(PG8_SA(0, 0), cA, voffA); PG8_STAGE(PG8_SB(0, 1), cB + hstepB, voffB); PG8_STAGE(PG8_SA(0, 1), cA + hstepA, voffA);
    if (wr == 1) PG8_BAR;
    PG8_WAIT_V(4); PG8_BAR;
    PG8_STAGE(PG8_SB(1, 0), cB + kstep, voffB); PG8_STAGE(PG8_SA(1, 0), cA + kstep, voffA); PG8_STAGE(PG8_SB(1, 1), cB + hstepB + kstep, voffB);
    PG8_WAIT_V(6); PG8_BAR;
    for (;;) {
        const bool has_next = S.next(ui + 1, nxt);
        const char* nA = has_next ? nxt.A : cA; const char* nB = has_next ? nxt.B : cB;
        const int nt = cur.nt;
        for (int t = 0; t < nt; t += 2) {
            const bool last = (t == nt - 2);
            const char* a1 = cA + (size_t)(t + 1) * kstep;
            const char* a2 = last ? nA : cA + (size_t)(t + 2) * kstep; const char* b2 = last ? nB : cB + (size_t)(t + 2) * kstep;
            const char* a3 = a2 + kstep; const char* b3 = b2 + kstep;
            PG8_LDB(B0, 0, 0); PG8_SCHED; PG8_LDA(At, 0, 0); PG8_STAGE(PG8_SA(1, 1), a1 + hstepA, voffA);
            PG8_WAIT_L(8); PG8_BAR; PG8_WAIT_L(0); PG8_MMA(0, 0, At, B0); PG8_BAR; PG8_SCHED;
            PG8_LDB(B1, 0, 1); PG8_STAGE(PG8_SB(0, 0), b2, voffB);
            PG8_BAR; PG8_WAIT_L(0); PG8_MMA(0, 1, At, B1); PG8_BAR;
            PG8_LDA(At, 0, 1); PG8_STAGE(PG8_SA(0, 0), a2, voffA);
            PG8_BAR; PG8_WAIT_L(0); PG8_MMA(1, 0, At, B0); PG8_BAR; PG8_SCHED;
            PG8_STAGE(PG8_SB(0, 1), b2 + hstepB, voffB);
            PG8_WAIT_V(6); PG8_BAR; PG8_MMA(1, 1, At, B1); PG8_BAR;
            PG8_LDB(B0, 1, 0); PG8_SCHED; PG8_LDA(At, 1, 0); PG8_STAGE(PG8_SA(0, 1), a2 + hstepA, voffA);
            PG8_WAIT_L(8); PG8_BAR; PG8_WAIT_L(0); PG8_MMA(0, 0, At, B0); PG8_BAR; PG8_SCHED;
            PG8_LDB(B1, 1, 1); PG8_STAGE(PG8_SB(1, 0), b3, voffB);
            PG8_BAR; PG8_WAIT_L(0); PG8_MMA(0, 1, At, B1); PG8_BAR;
            PG8_LDA(At, 1, 1); PG8_STAGE(PG8_SA(1, 0), a3, voffA);
            PG8_BAR; PG8_WAIT_L(0); PG8_MMA(1, 0, At, B0); PG8_BAR; PG8_SCHED;
            PG8_STAGE(PG8_SB(1, 1), b3 + hstepB, voffB);
            PG8_WAIT_V(6); PG8_BAR; PG8_MMA(1, 1, At, B1); PG8_BAR;
        }
        E(acc, cur, wr, wc, fr, fq);
        if (!has_next) break;
#pragma unroll
        for (int a = 0; a < 2; ++a)
#pragma unroll
            for (int b = 0; b < 2; ++b)
#pragma unroll
                for (int m = 0; m < 4; ++m)
#pragma unroll
                    for (int n = 0; n < 2; ++n) acc[a][b][m][n] = (f32x4){0.f, 0.f, 0.f, 0.f};
        cur = nxt; cA = nA; cB = nB; ++ui;
    }
    PG8_WAIT_V(0);
    if (wr == 0) PG8_BAR;
    PG8_BAR;
#undef PG8_SA
#undef PG8_SB
#undef PG8_STAGE
#undef PG8_LDA
#undef PG8_LDB
#undef PG8_MMA
#undef PG8_WAIT_V
#undef PG8_WAIT_L
#undef PG8_BAR
#undef PG8_SCHED
}
typedef f32x4 Acc[2][2][4][2];

__device__ __forceinline__ void store8(bf16_t* p, f32x4 v0, f32x4 v1) {
    u32x4 w; w.x = cvt_pk_bf16(v0[0], v0[1]); w.y = cvt_pk_bf16(v0[2], v0[3]); w.z = cvt_pk_bf16(v1[0], v1[1]); w.w = cvt_pk_bf16(v1[2], v1[3]); *(u32x4*)p = w; }
__device__ __forceinline__ f32x4 gelu4(f32x4 v) { f32x2 a = gelu_pk((f32x2){v[0], v[1]}), b = gelu_pk((f32x2){v[2], v[3]}); return (f32x4){a.x, a.y, b.x, b.y}; }
__device__ __forceinline__ f32x4 silu4(f32x4 v) { return (f32x4){siluf_(v[0]), siluf_(v[1]), siluf_(v[2]), siluf_(v[3])}; }
__device__ __forceinline__ f32x4 sigm4(f32x4 v) { return (f32x4){sigmoidf_(v[0]), sigmoidf_(v[1]), sigmoidf_(v[2]), sigmoidf_(v[3])}; }

struct EpiEvenIn {
    static constexpr bool PERM = true;
    bf16_t* abuf; bf16_t* uv;
    __device__ __forceinline__ void operator()(const Acc& acc, const Unit& u, int wr, int wc, int fr, int fq) const {
        const int row0 = u.pm * BM + wr * 64 + fr; const bool act = u.pn >= 4;
        bf16_t* base = act ? uv : abuf; const int ldc = act ? 2048 : 1024; const int col0 = (act ? (u.pn - 4) : u.pn) * BM + wc * 32 + 8 * fq;
#pragma unroll
        for (int ai = 0; ai < 2; ++ai)
#pragma unroll
            for (int m = 0; m < 4; ++m) { bf16_t* rowp = base + (size_t)(row0 + ai * HALF + m * 16) * ldc + col0;
#pragma unroll
                for (int bj = 0; bj < 2; ++bj) { f32x4 v0 = acc[ai][bj][m][0], v1 = acc[ai][bj][m][1];
                    if (act) { v0 = gelu4(v0); v1 = gelu4(v1); }
                    store8(rowp + bj * HALF, v0, v1); }
                asm volatile("" ::: "memory"); }
    }
};
struct EpiOddIn {
    static constexpr bool PERM = true;
    bf16_t* glu; bf16_t* qkv; bf16_t* zg;
    __device__ __forceinline__ void operator()(const Acc& acc, const Unit& u, int wr, int wc, int fr, int fq) const {
        const int row0 = u.pm * BM + wr * 64 + fr;
        if (u.pn < 8) {
            const int col0 = u.pn * 128 + wc * 32 + 8 * fq;
#pragma unroll
            for (int ai = 0; ai < 2; ++ai)
#pragma unroll
                for (int m = 0; m < 4; ++m) { bf16_t* rowp = glu + (size_t)(row0 + ai * HALF + m * 16) * 1024 + col0;
                    store8(rowp, acc[ai][0][m][0] * sigm4(acc[ai][1][m][0]), acc[ai][0][m][1] * sigm4(acc[ai][1][m][1])); asm volatile("" ::: "memory"); }
        } else {
            const bool isq = u.pn < 20; bf16_t* base = isq ? qkv : zg; const int ldc = isq ? 3072 : 1024; const int col0 = (isq ? (u.pn - 8) : (u.pn - 20)) * BM + wc * 32 + 8 * fq;
#pragma unroll
            for (int ai = 0; ai < 2; ++ai)
#pragma unroll
                for (int m = 0; m < 4; ++m) { bf16_t* rowp = base + (size_t)(row0 + ai * HALF + m * 16) * ldc + col0;
#pragma unroll
                    for (int bj = 0; bj < 2; ++bj) store8(rowp + bj * HALF, acc[ai][bj][m][0], acc[ai][bj][m][1]);
                    asm volatile("" ::: "memory"); }
        }
    }
};
struct EpiUp {
    static constexpr bool PERM = true;
    bf16_t* act;
    __device__ __forceinline__ void operator()(const Acc& acc, const Unit& u, int wr, int wc, int fr, int fq) const {
        const int row0 = u.pm * BM + wr * 64 + fr, col0 = u.pn * 128 + wc * 32 + 8 * fq;
#pragma unroll
        for (int ai = 0; ai < 2; ++ai)
#pragma unroll
            for (int m = 0; m < 4; ++m) { bf16_t* rowp = act + (size_t)(row0 + ai * HALF + m * 16) * DFF + col0;
                store8(rowp, silu4(acc[ai][0][m][0]) * acc[ai][1][m][0], silu4(acc[ai][0][m][1]) * acc[ai][1][m][1]); asm volatile("" ::: "memory"); }
    }
};
struct EpiPool {
    static constexpr bool PERM = true;
    bf16_t* cat; const float* scale;
    __device__ __forceinline__ void operator()(const Acc& acc, const Unit& u, int wr, int wc, int fr, int fq) const {
        const int row0 = u.pm * BM + wr * 64 + fr, col0 = u.pn * BM + wc * 32 + 8 * fq;
#pragma unroll
        for (int ai = 0; ai < 2; ++ai)
#pragma unroll
            for (int m = 0; m < 4; ++m) { bf16_t* rowp = cat + (size_t)(row0 + ai * HALF + m * 16) * 2048 + col0;
#pragma unroll
                for (int bj = 0; bj < 2; ++bj) { const f32x4 s0 = *(const f32x4*)(scale + col0 + bj * HALF), s1 = *(const f32x4*)(scale + col0 + bj * HALF + 4);
                    store8(rowp + bj * HALF, acc[ai][bj][m][0] * s0, acc[ai][bj][m][1] * s1); }
                asm volatile("" ::: "memory"); }
    }
};
struct EpiResid {
    static constexpr bool PERM = false;
    float* x; bool dry;
    __device__ __forceinline__ void operator()(const Acc& acc, const Unit& u, int wr, int wc, int fr, int fq) const {
        if (dry) return;
        const int row0 = u.pm * BM + wr * 64 + fr, col0 = u.pn * BM + wc * 32 + 4 * fq;
#pragma unroll
        for (int ai = 0; ai < 2; ++ai) {
            f32x4 t[4][2][2];
#pragma unroll
            for (int m = 0; m < 4; ++m) { const float* rowp = x + (size_t)(row0 + ai * HALF + m * 16) * 2048 + col0;
#pragma unroll
                for (int bj = 0; bj < 2; ++bj)
#pragma unroll
                    for (int n = 0; n < 2; ++n) t[m][bj][n] = *(const f32x4*)(rowp + bj * HALF + n * 16); }
#pragma unroll
            for (int m = 0; m < 4; ++m) { float* rowp = x + (size_t)(row0 + ai * HALF + m * 16) * 2048 + col0;
#pragma unroll
                for (int bj = 0; bj < 2; ++bj)
#pragma unroll
                    for (int n = 0; n < 2; ++n) *(f32x4*)(rowp + bj * HALF + n * 16) = t[m][bj][n] + acc[ai][bj][m][n]; }
            asm volatile("" ::: "memory"); }
    }
};
struct EpiPartX {
    static constexpr bool PERM = false;
    float* px; bool dry;
    __device__ __forceinline__ void operator()(const Acc& acc, const Unit& u, int wr, int wc, int fr, int fq) const {
        if (dry) return;
        float* base = px + (size_t)u.pad * 32768 + (size_t)(wr * 64 + fr) * 256 + wc * 32 + 4 * fq;
#pragma unroll
        for (int m = 0; m < 4; ++m)
#pragma unroll
            for (int bj = 0; bj < 2; ++bj)
#pragma unroll
                for (int n = 0; n < 2; ++n) *(f32x4*)(base + (size_t)(m * 16) * 256 + bj * HALF + n * 16) = acc[0][bj][m][n];
    }
};
struct EpiResidX {
    static constexpr bool PERM = false;
    EpiResid r; EpiPartX p;
    __device__ __forceinline__ void operator()(const Acc& acc, const Unit& u, int wr, int wc, int fr, int fq) const { if (u.pm < MPR / 256) r(acc, u, wr, wc, fr, fq); else p(acc, u, wr, wc, fr, fq); }
};
}

struct TItem { const float* src; bf16_t* dst; int ldw, K; };
__device__ __forceinline__ TItem titem_locate(PP P, unsigned char* ws, int it) {
    const float* W; bf16_t* WT; int ldw, K, Nd, pairLimit = 0, Hh = 0, r = it;
    if (r < 6144) { const int j = r / 3072; r -= j * 3072; W = P->in[9] + (size_t)j * 2048 * 3072; WT = (bf16_t*)(ws + WS_WEVIN) + (size_t)j * 3072 * 2048; ldw = 3072; K = 2048; Nd = 3072; }
    else if ((r -= 6144) < 4096) { const int e = r / 2048; r -= e * 2048; W = P->in[16] + (size_t)e * 2048 * 2048; WT = (bf16_t*)(ws + WS_WEVOUT) + (size_t)e * 2048 * 2048; ldw = 2048; K = 2048; Nd = 2048; }
    else if ((r -= 4096) < 12288) { const int o = r / 6144; r -= o * 6144; W = P->in[17] + (size_t)o * 2048 * OD_IN; WT = (bf16_t*)(ws + WS_WODIN) + (size_t)o * OD_INM * 2048; ldw = OD_IN; K = 2048; Nd = OD_INM; pairLimit = 2048; Hh = 1024; }
    else if ((r -= 12288) < 4096) { const int o = r / 2048; r -= o * 2048; W = P->in[26] + (size_t)o * 2048 * 2048; WT = (bf16_t*)(ws + WS_WODOUT) + (size_t)o * 2048 * 2048; ldw = 2048; K = 2048; Nd = 2048; }
    else if ((r -= 4096) < 45056) { const int l = r / 11264; r -= l * 11264; W = P->in[27] + (size_t)l * 2048 * 2 * DFF; WT = (bf16_t*)(ws + WS_WUP) + (size_t)l * 2 * DFF * 2048; ldw = 2 * DFF; K = 2048; Nd = 2 * DFF; pairLimit = 2 * DFF; Hh = DFF; }
    else if ((r -= 45056) < 22528) { const int l = r / 5632; r -= l * 5632; W = P->in[28] + (size_t)l * DFF * 2048; WT = (bf16_t*)(ws + WS_WDOWN) + (size_t)l * 2048 * DFF; ldw = 2048; K = DFF; Nd = 2048; }
    else { r -= 22528; const int eg = r / 32; r -= eg * 32; W = P->in[10] + (size_t)eg * 65536; WT = (bf16_t*)(ws + WS_WPOOL) + (size_t)eg * 65536; ldw = 256; K = 256; Nd = 256; }
    const int nblk = Nd / 32, kb = r / nblk, nb = r - kb * nblk, n0 = nb * 32; int src = n0;
    if (n0 < pairLimit) { const int pn = n0 >> 8, c = n0 & 255; src = c < 128 ? pn * 128 + c : Hh + pn * 128 + (c - 128); }
    TItem t; t.src = W + (size_t)(kb * 64) * ldw + src; t.dst = WT + (size_t)n0 * K + kb * 64; t.ldw = ldw; t.K = K; return t;
}
constexpr int T_ITEMS = 6144 + 4096 + 12288 + 4096 + 45056 + 22528 + 256;
__device__ __forceinline__ void titem_load(const TItem& t, float (&r)[32], int lane) {
    const float* p = t.src + (size_t)(lane >> 5) * t.ldw + (lane & 31);
#pragma unroll
    for (int i = 0; i < 32; ++i) r[i] = p[(size_t)(2 * i) * t.ldw];
}
__device__ __forceinline__ void titem_store(const TItem& t, const float (&r)[32], LAS float* scr, int lane) {
#pragma unroll
    for (int i = 0; i < 32; ++i) scr[(2 * i + (lane >> 5)) * 33 + (lane & 31)] = r[i];
    asm volatile("s_waitcnt lgkmcnt(0)" ::: "memory");
    const int c = lane & 7;
#pragma unroll
    for (int j = 0; j < 4; ++j) { const int n = (lane >> 3) + 8 * j; const LAS float* s = scr + (8 * c) * 33 + n;
        u32x4 o; o.x = cvt_pk_bf16(s[0 * 33], s[1 * 33]); o.y = cvt_pk_bf16(s[2 * 33], s[3 * 33]); o.z = cvt_pk_bf16(s[4 * 33], s[5 * 33]); o.w = cvt_pk_bf16(s[6 * 33], s[7 * 33]);
        *(u32x4*)(t.dst + (size_t)n * t.K + 8 * c) = o; }
    asm volatile("s_waitcnt lgkmcnt(0)" ::: "memory");
}
constexpr int L_EVEN_ITEMS = 3072 + 2048 + 128 + 11264 + 5632, L_ODD_ITEMS = 6144 + 2048 + 11264 + 5632;
__device__ __forceinline__ int layer_item(int l, int i) {
    const int h = l >> 1;
    if ((l & 1) == 0) { if (i < 3072) return h * 3072 + i; i -= 3072; if (i < 2048) return 6144 + h * 2048 + i; i -= 2048; if (i < 128) return 94208 + h * 128 + i; i -= 128; }
    else { if (i < 6144) return 10240 + h * 6144 + i; i -= 6144; if (i < 2048) return 22528 + h * 2048 + i; i -= 2048; }
    if (i < 11264) return 26624 + l * 11264 + i; i -= 11264; return 71680 + l * 5632 + i;
}
constexpr int DEF1_A = 5568, DEF1_B = 4032, DEF2_A = 7968, DEF2_B = 4032, DEF3_A = 5568, DEF3_B = 4032;
constexpr int PREP_L1 = L_ODD_ITEMS - DEF1_A - DEF1_B, PREP_L2 = L_EVEN_ITEMS - DEF2_A - DEF2_B, PREP_L3 = L_ODD_ITEMS - DEF3_A - DEF3_B;
constexpr int PREP_ITEMS = L_EVEN_ITEMS + PREP_L1 + PREP_L2 + PREP_L3;
__device__ __forceinline__ int prep_item(int p) {
    if (p < L_EVEN_ITEMS) return layer_item(0, p); p -= L_EVEN_ITEMS;
    if (p < PREP_L1) return layer_item(1, DEF1_A + DEF1_B + p); p -= PREP_L1;
    if (p < PREP_L2) return layer_item(2, DEF2_A + DEF2_B + p); p -= PREP_L2;
    return layer_item(3, DEF3_A + DEF3_B + p);
}
__device__ __forceinline__ void convert_span(PP P, LAS unsigned char* lds, int tid, int wv, int nwv, int count, int mode, int layer, int first) {
    const int lane = tid & 63, wave = tid >> 6;
    LAS float* scr = (LAS float*)(lds + wave * 8448);
    unsigned char* ws = P->ws;
    int it = wv; TItem dA, dB; float ra[32], rb[32];
#define CONV_MAP(j) (mode == 0 ? prep_item(j) : (mode == 2 ? (j) : layer_item(layer, first + (j))))
    if (it < count) { dA = titem_locate(P, ws, CONV_MAP(it)); titem_load(dA, ra, lane); }
    while (it < count) {
        const int itB = it + nwv; const bool hb = itB < count;
        if (hb) { dB = titem_locate(P, ws, CONV_MAP(itB)); titem_load(dB, rb, lane); }
        titem_store(dA, ra, scr, lane);
        if (!hb) break;
        const int itA = itB + nwv; const bool ha = itA < count;
        if (ha) { dA = titem_locate(P, ws, CONV_MAP(itA)); titem_load(dA, ra, lane); }
        titem_store(dB, rb, scr, lane);
        if (!ha) break;
        it = itA;
    }
#undef CONV_MAP
}
__device__ __forceinline__ void convert_slot(const Ctx& cx, PP P, LAS unsigned char* lds, int layer, int first, int count, int thr, int ncu) {
    if (cx.G != 256 || cx.bid < thr || cx.bid >= thr + ncu) return;
    __syncthreads();
    convert_span(P, lds, cx.tid, (cx.bid - thr) * NWAVES + (cx.tid >> 6), ncu * NWAVES, count, 1, layer, first);
}
__device__ __forceinline__ void phase_prep(const Ctx& cx, PP P, LAS unsigned char* lds) {
    const int tid = cx.tid;
    const int G = cx.G;
    unsigned char* ws = P->ws;
    if (G == 256) convert_span(P, lds, tid, cx.bid * NWAVES + (tid >> 6), G * NWAVES, PREP_ITEMS, 0, 0, 0);
    else convert_span(P, lds, tid, cx.bid * NWAVES + (tid >> 6), G * NWAVES, T_ITEMS, 2, 0, 0);
    {
        bf16_t* wab = (bf16_t*)(ws + WS_WAB);
        for (int i = cx.bid * NTHR + tid; i < 2 * 16 * 2048; i += G * NTHR) { const int o = i >> 15, c = (i >> 11) & 15, k = i & 2047;
            wab[i] = (bf16_t)(cvt_pk_bf16(P->in[17][(size_t)o * 2048 * OD_IN + (size_t)k * OD_IN + OD_INM + c], 0.f) & 0xffff); }
    }
}

template <bool F32OUT>
__device__ __forceinline__ void phase_rmsnorm(const Ctx& cx, float* X, const float* g, bf16_t* Hout, float* Fout, const float* px, int ppu, bool dry, LAS unsigned char* lds) {
    const int tid = cx.tid, lane = tid & 63, wave = __builtin_amdgcn_readfirstlane(tid >> 6);
    const int gw = cx.bid * NWAVES + wave, NGW = cx.G * NWAVES;
    if (ppu > 0) {
        LAS float* red = (LAS float*)lds;
        for (int r = cx.bid; r < BS; r += cx.G) {
            const int m = MPR + r, col = 256 * wave + lane * 4, P8 = 8 * ppu;
            f32x4 a = *(const f32x4*)(X + (size_t)m * D + col);
            const float* pr = px + (size_t)r * 256 + lane * 4 + (size_t)(32 * wave) * 32768;
#pragma unroll
            for (int i = 0; i < 32; ++i) { const int vc = 32 * wave + i; if (((vc + 1) * P8) / 256 > (vc * P8) / 256) a = a + *(const f32x4*)(pr + (size_t)i * 32768); }
            if (!dry) *(f32x4*)(X + (size_t)m * D + col) = a;
            const float ss = wave_sum((a.x * a.x + a.y * a.y) + (a.z * a.z + a.w * a.w));
            if (lane == 0) red[wave] = ss;
            __syncthreads();
            float tot = 0.f;
#pragma unroll
            for (int i = 0; i < 8; ++i) tot += red[i];
            const float rs = rsqrtf(tot * (1.0f / D) + EPS);
            const f32x4 g4 = *(const f32x4*)(g + col); const f32x4 o = a * rs * g4;
            if (F32OUT) *(f32x4*)(Fout + (size_t)m * D + col) = o;
            else { u32x2 w; w.x = cvt_pk_bf16(o.x, o.y); w.y = cvt_pk_bf16(o.z, o.w); *(u32x2*)(Hout + (size_t)m * D + col) = w; }
            __syncthreads();
        }
    }
    const int mend = ppu > 0 ? MPR : MT;
    for (int m = gw; m < mend; m += 4 * NGW) {
        f32x4 v[4][8]; float ss[4]; int mr[4]; bool ok[4];
#pragma unroll
        for (int k = 0; k < 4; ++k) { const int mk = m + k * NGW; ok[k] = mk < mend; mr[k] = ok[k] ? mk : m; const f32x4* xr = (const f32x4*)(X + (size_t)mr[k] * D) + lane;
#pragma unroll
            for (int j = 0; j < 8; ++j) v[k][j] = xr[64 * j]; }
#pragma unroll
        for (int k = 0; k < 4; ++k) { float a = 0.f;
#pragma unroll
            for (int j = 0; j < 8; ++j) a += (v[k][j].x * v[k][j].x + v[k][j].y * v[k][j].y) + (v[k][j].z * v[k][j].z + v[k][j].w * v[k][j].w);
            ss[k] = a; }
#pragma unroll
        for (int o = 1; o < 64; o <<= 1) {
#pragma unroll
            for (int k = 0; k < 4; ++k) ss[k] += __shfl_xor(ss[k], o); }
#pragma unroll
        for (int j = 0; j < 8; ++j) { const f32x4 g4 = ((const f32x4*)g)[lane + 64 * j];
#pragma unroll
            for (int k = 0; k < 4; ++k) if (ok[k]) { const float rs = rsqrtf(ss[k] * (1.0f / D) + EPS); const f32x4 o = v[k][j] * rs * g4;
                if (F32OUT) ((f32x4*)(Fout + (size_t)mr[k] * D))[lane + 64 * j] = o;
                else { u32x2 w; w.x = cvt_pk_bf16(o.x, o.y); w.y = cvt_pk_bf16(o.z, o.w); ((u32x2*)(Hout + (size_t)mr[k] * D))[lane + 64 * j] = w; } } }
    }
}

__device__ __forceinline__ void phase_first_norm(const Ctx& cx, PP P, float* X, const float* g, bf16_t* Hout) {
    const int tid = cx.tid, lane = tid & 63, wave = __builtin_amdgcn_readfirstlane(tid >> 6);
    const int gw = cx.bid * NWAVES + wave, NGW = cx.G * NWAVES;
    for (int m = gw; m < MT; m += NGW) {
        const float* src = m < MPR ? P->in[0] + (size_t)m * D : P->in[1] + (size_t)(m - MPR) * D;
        const f32x4* xr = (const f32x4*)src + lane; f32x4 v[8]; float ss = 0.f;
#pragma unroll
        for (int j = 0; j < 8; ++j) { v[j] = xr[64 * j]; ss += (v[j].x * v[j].x + v[j].y * v[j].y) + (v[j].z * v[j].z + v[j].w * v[j].w); }
        const float rs = rsqrtf(wave_sum(ss) * (1.0f / D) + EPS);
#pragma unroll
        for (int j = 0; j < 8; ++j) { ((f32x4*)(X + (size_t)m * D))[lane + 64 * j] = v[j]; const f32x4 g4 = ((const f32x4*)g)[lane + 64 * j]; const f32x4 o = v[j] * rs * g4;
            u32x2 w; w.x = cvt_pk_bf16(o.x, o.y); w.y = cvt_pk_bf16(o.z, o.w); ((u32x2*)(Hout + (size_t)m * D))[lane + 64 * j] = w; }
    }
}

__device__ __forceinline__ void phase_even_prep(const Ctx& cx, PP P, int e) {
    const int tid = cx.tid, lane = tid & 63, wave = __builtin_amdgcn_readfirstlane(tid >> 6);
    const int gw = cx.bid * NWAVES + wave, NGW = cx.G * NWAVES;
    unsigned char* ws = P->ws;
    const bf16_t* abuf = (const bf16_t*)(ws + WS_ABUF); const bf16_t* uv = (const bf16_t*)(ws + WS_UV);
    bf16_t* pooled = (bf16_t*)(ws + WS_MIX); bf16_t* vn = (bf16_t*)(ws + WS_VN); bf16_t* cat = (bf16_t*)(ws + WS_CAT);
    const float* spool = P->in[2] + (size_t)e * BS * 15 * 1024;
    const float* lng = P->in[12] + e * 1024; const float* lnb = P->in[13] + e * 1024;
    const float* sws = P->in[14] + (size_t)e * 4 * 128 * 128; const float* sb = P->in[15] + e * 4 * 128;
    float* out = P->out;
    constexpr int GPS = (SEQ + 4) / 5;
    for (int task = gw; task < BP * GPS + BS; task += NGW) {
      if (task >= BP * GPS) {
        const int m = MPR + task - BP * GPS; const bool prompt = false; const int b = m - MPR, t = 0;
#pragma unroll
        for (int p = 0; p < 4; ++p) {
            const int w = 2 << p, ch0 = p * 256 + lane * 4;
            float cur[4], sacc[4];
            { const u32x2 r = *(const u32x2*)(abuf + (size_t)m * 1024 + ch0); cur[0] = bf_lo(r.x); cur[1] = bf_hi(r.x); cur[2] = bf_lo(r.y); cur[3] = bf_hi(r.y); }
#pragma unroll
            for (int i = 0; i < 4; ++i) sacc[i] = cur[i];
            float cnt;
            if (prompt) {
#pragma unroll
                for (int d = 1; d < w; ++d) if (t - d >= 0) { const u32x2 r = *(const u32x2*)(abuf + (size_t)(m - d) * 1024 + ch0);
                    sacc[0] += bf_lo(r.x); sacc[1] += bf_hi(r.x); sacc[2] += bf_lo(r.y); sacc[3] += bf_hi(r.y); }
                cnt = (float)(w < t + 1 ? w : t + 1);
            } else {
#pragma unroll
                for (int d = 1; d < w; ++d) { const f32x4 h0 = *(const f32x4*)(spool + ((size_t)b * 15 + (15 - d)) * 1024 + ch0);
                    sacc[0] += h0.x; sacc[1] += h0.y; sacc[2] += h0.z; sacc[3] += h0.w; }
                cnt = (float)w;
            }
            const float ic = 1.0f / cnt;
            u32x2 pw; pw.x = cvt_pk_bf16(sacc[0] * ic - cur[0], sacc[1] * ic - cur[1]); pw.y = cvt_pk_bf16(sacc[2] * ic - cur[2], sacc[3] * ic - cur[3]);
            *(u32x2*)(pooled + (size_t)m * 1024 + ch0) = pw;
            const f32x4 c4 = (f32x4){cur[0], cur[1], cur[2], cur[3]};
            if (prompt) { if (t >= SEQ - 15) *(f32x4*)(out + O_PP + (((size_t)e * BP + b) * 15 + (t - (SEQ - 15))) * 1024 + ch0) = c4; }
            else { float* ob = out + O_PS + ((size_t)e * BS + b) * 15 * 1024 + ch0;
                *(f32x4*)(ob + 14 * 1024) = c4; }
        }
        float v[2][8]; float sm = 0.f;
#pragma unroll
        for (int jj = 0; jj < 2; ++jj) { const int ch0 = (lane + 64 * jj) * 8; const u32x4 r = *(const u32x4*)(uv + (size_t)m * 2048 + 1024 + ch0); unpack8(r, v[jj]);
#pragma unroll
            for (int i = 0; i < 8; ++i) sm += v[jj][i]; }
        const float mu = wave_sum(sm) * (1.0f / 1024.f); float sq = 0.f;
#pragma unroll
        for (int jj = 0; jj < 2; ++jj)
#pragma unroll
            for (int i = 0; i < 8; ++i) { v[jj][i] -= mu; sq += v[jj][i] * v[jj][i]; }
        const float rstd = rsqrtf(wave_sum(sq) * (1.0f / 1024.f) + EPS);
#pragma unroll
        for (int jj = 0; jj < 2; ++jj) { const int ch0 = (lane + 64 * jj) * 8; float o[8];
#pragma unroll
            for (int i = 0; i < 8; ++i) o[i] = v[jj][i] * rstd * lng[ch0 + i] + lnb[ch0 + i];
            *(u32x4*)(vn + (size_t)m * 1024 + ch0) = pack8(o);
            if (!prompt) {
                float* op = out + O_SV + ((size_t)e * BS + b) * 1024 + ch0;
                *(f32x4*)op = (f32x4){o[0], o[1], o[2], o[3]}; *(f32x4*)(op + 4) = (f32x4){o[4], o[5], o[6], o[7]};
                const int h = ch0 >> 8; const float w00 = sws[(size_t)h * 128 * 128], b0 = sb[h * 128];
                float uu[8]; const u32x4 r = *(const u32x4*)(uv + (size_t)m * 2048 + ch0); unpack8(r, uu);
                float c[8];
#pragma unroll
                for (int i = 0; i < 8; ++i) c[i] = uu[i] * (w00 * o[i] + b0);
                *(u32x4*)(cat + (size_t)m * 2048 + 1024 + ch0) = pack8(c);
            } }
      }
      else {
        const int b = task / GPS, gi = task - b * GPS, t0 = gi * 5, R = (SEQ - t0) < 5 ? (SEQ - t0) : 5, mbase = b * SEQ + t0;
#pragma unroll
        for (int p = 0; p < 4; ++p) {
            constexpr int dummy = 0; (void)dummy;
            const int w = 2 << p, ch0 = p * 256 + lane * 4;
            float x[20][4];
#pragma unroll
            for (int i = 0; i < 20; ++i) if (i < w + 4) { const int ti = t0 - (w - 1) + i; const bool valid = (ti >= 0) && (i < w - 1 + R);
                const u32x2 r = *(const u32x2*)(abuf + (size_t)(valid ? mbase - (w - 1) + i : mbase) * 1024 + ch0);
                x[i][0] = valid ? bf_lo(r.x) : 0.f; x[i][1] = valid ? bf_hi(r.x) : 0.f; x[i][2] = valid ? bf_lo(r.y) : 0.f; x[i][3] = valid ? bf_hi(r.y) : 0.f; }
            float sacc[4] = {0.f, 0.f, 0.f, 0.f};
#pragma unroll
            for (int i = 0; i < 16; ++i) if (i < w) {
#pragma unroll
                for (int c = 0; c < 4; ++c) sacc[c] += x[i][c]; }
#pragma unroll
            for (int r = 0; r < 5; ++r) {
                if (r > 0) {
#pragma unroll
                    for (int c = 0; c < 4; ++c) sacc[c] += x[r + w - 1][c] - x[r - 1][c]; }
                const int t = t0 + r; const float ic = 1.0f / (float)(w < t + 1 ? w : t + 1);
                const float* cur = x[r + w - 1];
                if (r < R) { u32x2 pw; pw.x = cvt_pk_bf16(sacc[0] * ic - cur[0], sacc[1] * ic - cur[1]); pw.y = cvt_pk_bf16(sacc[2] * ic - cur[2], sacc[3] * ic - cur[3]);
                    *(u32x2*)(pooled + (size_t)(mbase + r) * 1024 + ch0) = pw;
                    if (t >= SEQ - 15) *(f32x4*)(out + O_PP + (((size_t)e * BP + b) * 15 + (t - (SEQ - 15))) * 1024 + ch0) = (f32x4){cur[0], cur[1], cur[2], cur[3]}; }
            }
        }
        float v[5][2][8]; float sm[5], sq[5];
#pragma unroll
        for (int r = 0; r < 5; ++r) { const int mr = mbase + (r < R ? r : 0); float a = 0.f;
#pragma unroll
            for (int jj = 0; jj < 2; ++jj) { const int ch0 = (lane + 64 * jj) * 8; const u32x4 q = *(const u32x4*)(uv + (size_t)mr * 2048 + 1024 + ch0); unpack8(q, v[r][jj]);
#pragma unroll
                for (int i = 0; i < 8; ++i) a += v[r][jj][i]; }
            sm[r] = a; }
#pragma unroll
        for (int of = 1; of < 64; of <<= 1) {
#pragma unroll
            for (int r = 0; r < 5; ++r) sm[r] += __shfl_xor(sm[r], of); }
#pragma unroll
        for (int r = 0; r < 5; ++r) { const float mu = sm[r] * (1.0f / 1024.f); float a = 0.f;
#pragma unroll
            for (int jj = 0; jj < 2; ++jj)
#pragma unroll
                for (int i = 0; i < 8; ++i) { v[r][jj][i] -= mu; a += v[r][jj][i] * v[r][jj][i]; }
            sq[r] = a; }
#pragma unroll
        for (int of = 1; of < 64; of <<= 1) {
#pragma unroll
            for (int r = 0; r < 5; ++r) sq[r] += __shfl_xor(sq[r], of); }
#pragma unroll
        for (int jj = 0; jj < 2; ++jj) { const int ch0 = (lane + 64 * jj) * 8;
            const f32x4 g0 = *(const f32x4*)(lng + ch0), g1 = *(const f32x4*)(lng + ch0 + 4), b0 = *(const f32x4*)(lnb + ch0), b1 = *(const f32x4*)(lnb + ch0 + 4);
            const float gg[8] = {g0.x, g0.y, g0.z, g0.w, g1.x, g1.y, g1.z, g1.w}, bb[8] = {b0.x, b0.y, b0.z, b0.w, b1.x, b1.y, b1.z, b1.w};
#pragma unroll
            for (int r = 0; r < 5; ++r) if (r < R) { const float rstd = rsqrtf(sq[r] * (1.0f / 1024.f) + EPS); float o8[8];
#pragma unroll
                for (int i = 0; i < 8; ++i) o8[i] = v[r][jj][i] * rstd * gg[i] + bb[i];
                *(u32x4*)(vn + (size_t)(mbase + r) * 1024 + ch0) = pack8(o8); } }
      }
    }
}

__device__ __forceinline__ void phase_sgu(const Ctx& cx, PP P, int e, LAS unsigned char* lds) {
    const int tid = cx.tid, lane = tid & 63, wave = __builtin_amdgcn_readfirstlane(tid >> 6), l15 = lane & 15, quad = lane >> 4;
    const int G = cx.G;
    unsigned char* ws = P->ws;
    const bf16_t* uv = (const bf16_t*)(ws + WS_UV); const bf16_t* vn = (const bf16_t*)(ws + WS_VN); bf16_t* cat = (bf16_t*)(ws + WS_CAT);
    const float* sws = P->in[14] + (size_t)e * 4 * 128 * 128; const float* sb = P->in[15] + e * 4 * 128;
    LAS bf16_t* VT = (LAS bf16_t*)lds;
    for (int task = (G - 1 - cx.bid); task < 256; task += G) {
        const int b = task >> 6, n = (task >> 2) & 15, h = task & 3; const int m0 = b * SEQ + n * 128;
        for (int idx = tid; idx < 128 * 32; idx += NTHR) { const int r = idx >> 5, cq = idx & 31;
            const u32x4 w = *(const u32x4*)(vn + (size_t)(m0 + r) * 1024 + h * 256 + cq * 8);
            LAS bf16_t* d = VT + (cq * 8) * 136 + (r ^ ((cq & 7) << 3));
            d[0 * 136] = (bf16_t)(w.x & 0xffff); d[1 * 136] = (bf16_t)(w.x >> 16); d[2 * 136] = (bf16_t)(w.y & 0xffff); d[3 * 136] = (bf16_t)(w.y >> 16);
            d[4 * 136] = (bf16_t)(w.z & 0xffff); d[5 * 136] = (bf16_t)(w.z >> 16); d[6 * 136] = (bf16_t)(w.w & 0xffff); d[7 * 136] = (bf16_t)(w.w >> 16); }
        __syncthreads();
        const int irow = 16 * wave + l15;
        bf16x8 af[4];
#pragma unroll
        for (int ks = 0; ks < 4; ++ks) { const int k0 = ks * 32 + quad * 8; const float* wp = sws + ((size_t)h * 128 + irow) * 128 + k0; const f32x4 a0 = *(const f32x4*)wp, a1 = *(const f32x4*)(wp + 4);
            float f[8] = {a0.x, a0.y, a0.z, a0.w, a1.x, a1.y, a1.z, a1.w};
#pragma unroll
            for (int i = 0; i < 8; ++i) if (k0 + i > irow) f[i] = 0.f;
            const u32x4 pw = pack8(f); af[ks] = __builtin_bit_cast(bf16x8, pw); }
        const float bias = sb[h * 128 + irow];
#pragma unroll 2
        for (int nt = 0; nt < 16; ++nt) {
            f32x4 acc = (f32x4){0.f, 0.f, 0.f, 0.f};
#pragma unroll
            for (int ks = 0; ks < 4; ++ks) { const bf16x8 bfr = *(const LAS bf16x8*)(VT + (nt * 16 + l15) * 136 + ((ks * 32 + quad * 8) ^ ((((nt * 16 + l15) >> 3) & 7) << 3)));
                acc = __builtin_amdgcn_mfma_f32_16x16x32_bf16(bfr, af[ks], acc, 0, 0, 0); }
            const int c0 = h * 256 + nt * 16 + quad * 4;
            const u32x2 uw = *(const u32x2*)(uv + (size_t)(m0 + irow) * 2048 + c0);
            u32x2 ow; ow.x = cvt_pk_bf16(bf_lo(uw.x) * (acc[0] + bias), bf_hi(uw.x) * (acc[1] + bias)); ow.y = cvt_pk_bf16(bf_lo(uw.y) * (acc[2] + bias), bf_hi(uw.y) * (acc[3] + bias));
            *(u32x2*)(cat + (size_t)(m0 + irow) * 2048 + 1024 + c0) = ow;
        }
        __syncthreads();
    }
}

__device__ __forceinline__ void phase_ab(const Ctx& cx, PP P, int o) {
    const int tid = cx.tid, lane = tid & 63, l15 = lane & 15, quad = lane >> 4, wave = __builtin_amdgcn_readfirstlane(tid >> 6);
    const int gw = cx.bid * NWAVES + wave, NGW = cx.G * NWAVES;
    const bf16_t* H = (const bf16_t*)(P->ws + WS_H); float* AB = (float*)(P->ws + WS_AB);
    const bf16_t* Wt = (const bf16_t*)(P->ws + WS_WAB) + (size_t)o * 16 * 2048;
    for (int tt = NGW - 1 - gw; tt < MT / 16; tt += NGW) {
        const bf16_t* ap = H + (size_t)(16 * tt + l15) * D + quad * 8; const bf16_t* bp = Wt + (size_t)l15 * 2048 + quad * 8;
        f32x4 acc = (f32x4){0.f, 0.f, 0.f, 0.f};
#pragma unroll 16
        for (int ks = 0; ks < 64; ++ks) { const bf16x8 a = *(const bf16x8*)(ap + ks * 32), b = *(const bf16x8*)(bp + ks * 32); acc = __builtin_amdgcn_mfma_f32_16x16x32_bf16(a, b, acc, 0, 0, 0); }
#pragma unroll
        for (int j = 0; j < 4; ++j) AB[(size_t)(16 * tt + quad * 4 + j) * 16 + l15] = acc[j];
    }
}

__device__ __forceinline__ void phase_odd_prep(const Ctx& cx, PP P, int o, LAS unsigned char* lds) {
    const int tid = cx.tid, lane = tid & 63, wave = __builtin_amdgcn_readfirstlane(tid >> 6);
    const int gw = cx.bid * NWAVES + wave, NGW = cx.G * NWAVES;
    unsigned char* ws = P->ws;
    const bf16_t* glu = (const bf16_t*)(ws + WS_ABUF); const bf16_t* qkv = (const bf16_t*)(ws + WS_UV);
    bf16_t* qkvc = (bf16_t*)(ws + WS_MIX); bf16_t* cat = (bf16_t*)(ws + WS_CAT);
    const float* AB = (const float*)(ws + WS_AB); float* Gg = (float*)(ws + WS_G); float* Bt = (float*)(ws + WS_BETA);
    const float* sconv = P->in[3] + (size_t)o * BS * 30 * 1024; const float* sdn = P->in[4] + (size_t)o * BS * 3 * 3072;
    const float* dw = P->in[18] + (size_t)o * 31 * 1024; const float* db = P->in[19] + o * 1024; const float* lng = P->in[20] + o * 1024; const float* lnb = P->in[21] + o * 1024;
    const float* cw = P->in[22] + (size_t)o * 4 * 3072; const float* alog = P->in[23] + o * 8; const float* dtb = P->in[24] + o * 8;
    float* out = P->out;
    LAS float* dwl = (LAS float*)lds;
    constexpr int GPS = (SEQ + 4) / 5;
#pragma unroll 8
    for (int i = tid; i < 31 * 256; i += NTHR) ((LAS f32x4*)dwl)[i] = ((const f32x4*)dw)[i];
    __syncthreads();
    for (int task = gw; task < BP * GPS + BS; task += NGW) {
      if (task >= BP * GPS) {
        const int m = MPR + task - BP * GPS; const bool prompt = false; const int b = m - MPR, t = 0;
        float y[2][8]; float sm = 0.f;
#pragma unroll
        for (int jj = 0; jj < 2; ++jj) {
            const int ch0 = (lane + 64 * jj) * 8;
            { const f32x4 d0 = *(const f32x4*)(db + ch0), d1 = *(const f32x4*)(db + ch0 + 4); y[jj][0] = d0.x; y[jj][1] = d0.y; y[jj][2] = d0.z; y[jj][3] = d0.w; y[jj][4] = d1.x; y[jj][5] = d1.y; y[jj][6] = d1.z; y[jj][7] = d1.w; }
            float cur[8];
            { const u32x4 r = *(const u32x4*)(glu + (size_t)m * 1024 + ch0); unpack8(r, cur); }
            { const f32x4 w0 = *(const LAS f32x4*)(dwl + 30 * 1024 + ch0), w1 = *(const LAS f32x4*)(dwl + 30 * 1024 + ch0 + 4);
              y[jj][0] += w0.x * cur[0]; y[jj][1] += w0.y * cur[1]; y[jj][2] += w0.z * cur[2]; y[jj][3] += w0.w * cur[3]; y[jj][4] += w1.x * cur[4]; y[jj][5] += w1.y * cur[5]; y[jj][6] += w1.z * cur[6]; y[jj][7] += w1.w * cur[7]; }
            if (prompt) {
                const int j0 = t >= 30 ? 0 : 30 - t;
#pragma unroll
                for (int hh = 0; hh < 2; ++hh) {
                    u32x4 rr[15];
#pragma unroll
                    for (int jx = 0; jx < 15; ++jx) { const int j = hh * 15 + jx; const int jm = (j >= j0) ? (m - 30 + j) : m; rr[jx] = *(const u32x4*)(glu + (size_t)jm * 1024 + ch0); }
#pragma unroll
                    for (int jx = 0; jx < 15; ++jx) { const int j = hh * 15 + jx; if (j >= j0) { float x[8]; unpack8(rr[jx], x);
                        const f32x4 w0 = *(const LAS f32x4*)(dwl + j * 1024 + ch0), w1 = *(const LAS f32x4*)(dwl + j * 1024 + ch0 + 4);
                        y[jj][0] += w0.x * x[0]; y[jj][1] += w0.y * x[1]; y[jj][2] += w0.z * x[2]; y[jj][3] += w0.w * x[3]; y[jj][4] += w1.x * x[4]; y[jj][5] += w1.y * x[5]; y[jj][6] += w1.z * x[6]; y[jj][7] += w1.w * x[7]; } }
                    asm volatile("" ::: "memory");
                }
            } else {
#pragma unroll 10
                for (int j = 0; j < 30; ++j) { const float* hp = sconv + ((size_t)b * 30 + j) * 1024 + ch0; const f32x4 h0 = *(const f32x4*)hp, h1 = *(const f32x4*)(hp + 4);
                    const f32x4 w0 = *(const LAS f32x4*)(dwl + j * 1024 + ch0), w1 = *(const LAS f32x4*)(dwl + j * 1024 + ch0 + 4);
                    y[jj][0] += w0.x * h0.x; y[jj][1] += w0.y * h0.y; y[jj][2] += w0.z * h0.z; y[jj][3] += w0.w * h0.w; y[jj][4] += w1.x * h1.x; y[jj][5] += w1.y * h1.y; y[jj][6] += w1.z * h1.z; y[jj][7] += w1.w * h1.w; }
            }
#pragma unroll
            for (int i = 0; i < 8; ++i) sm += y[jj][i];
            if (prompt) { if (t >= SEQ - 30) { float* op = out + O_CP + (((size_t)o * BP + b) * 30 + (t - (SEQ - 30))) * 1024 + ch0;
                    *(f32x4*)op = (f32x4){cur[0], cur[1], cur[2], cur[3]}; *(f32x4*)(op + 4) = (f32x4){cur[4], cur[5], cur[6], cur[7]}; } }
            else { float* ob = out + O_CS + ((size_t)o * BS + b) * 30 * 1024 + ch0;
                *(f32x4*)(ob + 29 * 1024) = (f32x4){cur[0], cur[1], cur[2], cur[3]}; *(f32x4*)(ob + 29 * 1024 + 4) = (f32x4){cur[4], cur[5], cur[6], cur[7]}; }
        }
        const float mu = wave_sum(sm) * (1.0f / 1024.f); float sq = 0.f;
#pragma unroll
        for (int jj = 0; jj < 2; ++jj)
#pragma unroll
            for (int i = 0; i < 8; ++i) { y[jj][i] -= mu; sq += y[jj][i] * y[jj][i]; }
        const float rstd = rsqrtf(wave_sum(sq) * (1.0f / 1024.f) + EPS);
#pragma unroll
        for (int jj = 0; jj < 2; ++jj) { const int ch0 = (lane + 64 * jj) * 8; float c[8];
#pragma unroll
            for (int i = 0; i < 8; ++i) c[i] = siluf_(y[jj][i] * rstd * lng[ch0 + i] + lnb[ch0 + i]);
            *(u32x4*)(cat + (size_t)m * 2048 + ch0) = pack8(c); }
          }
      else {
        const int b = task / GPS, gi = task - b * GPS, t0 = gi * 5, R = (SEQ - t0) < 5 ? (SEQ - t0) : 5, mbase = b * SEQ + t0;
        float y[2][5][8];
#pragma unroll
        for (int jj = 0; jj < 2; ++jj) { const int ch0 = (lane + 64 * jj) * 8; const f32x4 d0 = *(const f32x4*)(db + ch0), d1 = *(const f32x4*)(db + ch0 + 4);
#pragma unroll
            for (int r = 0; r < 5; ++r) { y[jj][r][0] = d0.x; y[jj][r][1] = d0.y; y[jj][r][2] = d0.z; y[jj][r][3] = d0.w; y[jj][r][4] = d1.x; y[jj][r][5] = d1.y; y[jj][r][6] = d1.z; y[jj][r][7] = d1.w; } }
#pragma unroll 1
        for (int bt = 0; bt < 5; ++bt) {
            u32x4 rg[2][7];
#pragma unroll
            for (int jj = 0; jj < 2; ++jj)
#pragma unroll
                for (int k = 0; k < 7; ++k) { const int rr = bt * 7 + k; const bool valid = (t0 - 30 + rr >= 0) && (rr < 30 + R);
                    const u32x4 v = *(const u32x4*)(glu + (size_t)(valid ? mbase - 30 + rr : mbase) * 1024 + (lane + 64 * jj) * 8); rg[jj][k] = valid ? v : (u32x4){0u, 0u, 0u, 0u}; }
#pragma unroll
            for (int jj = 0; jj < 2; ++jj) { const int ch0 = (lane + 64 * jj) * 8;
#pragma unroll
                for (int k = 0; k < 7; ++k) { const int rr = bt * 7 + k; float x[8]; unpack8(rg[jj][k], x);
#pragma unroll
                    for (int r = 0; r < 5; ++r) { const int j = rr - r; if (j >= 0 && j <= 30) {
                        const LAS float* wp = dwl + j * 1024 + ch0; const f32x4 w0 = *(const LAS f32x4*)wp, w1 = *(const LAS f32x4*)(wp + 4);
                        y[jj][r][0] += w0.x * x[0]; y[jj][r][1] += w0.y * x[1]; y[jj][r][2] += w0.z * x[2]; y[jj][r][3] += w0.w * x[3]; y[jj][r][4] += w1.x * x[4]; y[jj][r][5] += w1.y * x[5]; y[jj][r][6] += w1.z * x[6]; y[jj][r][7] += w1.w * x[7]; } } } }
        }
        if (t0 + R > SEQ - 30) {
#pragma unroll
            for (int jj = 0; jj < 2; ++jj) { const int ch0 = (lane + 64 * jj) * 8;
                for (int r = 0; r < R; ++r) if (t0 + r >= SEQ - 30) { float c8[8]; const u32x4 v = *(const u32x4*)(glu + (size_t)(mbase + r) * 1024 + ch0); unpack8(v, c8);
                    float* op = out + O_CP + (((size_t)o * BP + b) * 30 + (t0 + r - (SEQ - 30))) * 1024 + ch0;
                    *(f32x4*)op = (f32x4){c8[0], c8[1], c8[2], c8[3]}; *(f32x4*)(op + 4) = (f32x4){c8[4], c8[5], c8[6], c8[7]}; } } }
        float sm[5], sq[5];
#pragma unroll
        for (int r = 0; r < 5; ++r) { float a = 0.f;
#pragma unroll
            for (int jj = 0; jj < 2; ++jj)
#pragma unroll
                for (int i = 0; i < 8; ++i) a += y[jj][r][i];
            sm[r] = a; }
#pragma unroll
        for (int of = 1; of < 64; of <<= 1) {
#pragma unroll
            for (int r = 0; r < 5; ++r) sm[r] += __shfl_xor(sm[r], of); }
#pragma unroll
        for (int r = 0; r < 5; ++r) { const float mu = sm[r] * (1.0f / 1024.f); float a = 0.f;
#pragma unroll
            for (int jj = 0; jj < 2; ++jj)
#pragma unroll
                for (int i = 0; i < 8; ++i) { y[jj][r][i] -= mu; a += y[jj][r][i] * y[jj][r][i]; }
            sq[r] = a; }
#pragma unroll
        for (int of = 1; of < 64; of <<= 1) {
#pragma unroll
            for (int r = 0; r < 5; ++r) sq[r] += __shfl_xor(sq[r], of); }
#pragma unroll
        for (int jj = 0; jj < 2; ++jj) { const int ch0 = (lane + 64 * jj) * 8;
            const f32x4 g0 = *(const f32x4*)(lng + ch0), g1 = *(const f32x4*)(lng + ch0 + 4), b0 = *(const f32x4*)(lnb + ch0), b1 = *(const f32x4*)(lnb + ch0 + 4);
            const float gg[8] = {g0.x, g0.y, g0.z, g0.w, g1.x, g1.y, g1.z, g1.w}, bb[8] = {b0.x, b0.y, b0.z, b0.w, b1.x, b1.y, b1.z, b1.w};
#pragma unroll
            for (int r = 0; r < 5; ++r) if (r < R) { const float rstd = rsqrtf(sq[r] * (1.0f / 1024.f) + EPS); float c[8];
#pragma unroll
                for (int i = 0; i < 8; ++i) c[i] = siluf_(y[jj][r][i] * rstd * gg[i] + bb[i]);
                *(u32x4*)(cat + (size_t)(mbase + r) * 2048 + ch0) = pack8(c); } }
      }
    }
    asm volatile("" ::: "memory"); __builtin_amdgcn_sched_barrier(0);
    for (int task = gw; task < BP * GPS + BS; task += NGW) {
      if (task >= BP * GPS) {
        const int m = MPR + task - BP * GPS; const bool prompt = false; const int b = m - MPR, t = 0;
#pragma unroll
        for (int jj = 0; jj < 6; ++jj) {
            const int ch0 = (lane + 64 * jj) * 8; float a[8], cur[8];
#pragma unroll
            for (int i = 0; i < 8; ++i) a[i] = 0.f;
#pragma unroll
            for (int j = 0; j < 4; ++j) {
                float x[8]; bool have = true;
                if (j == 3 || prompt) { const int tt = t - 3 + j; if (tt >= 0) { const u32x4 r = *(const u32x4*)(qkv + (size_t)(m - 3 + j) * 3072 + ch0); unpack8(r, x); } else have = false; }
                else { const float* hp = sdn + ((size_t)b * 3 + j) * 3072 + ch0; const f32x4 h0 = *(const f32x4*)hp, h1 = *(const f32x4*)(hp + 4); x[0] = h0.x; x[1] = h0.y; x[2] = h0.z; x[3] = h0.w; x[4] = h1.x; x[5] = h1.y; x[6] = h1.z; x[7] = h1.w; }
                if (have) { const f32x4 w0 = *(const f32x4*)(cw + j * 3072 + ch0), w1 = *(const f32x4*)(cw + j * 3072 + ch0 + 4);
                    a[0] += w0.x * x[0]; a[1] += w0.y * x[1]; a[2] += w0.z * x[2]; a[3] += w0.w * x[3]; a[4] += w1.x * x[4]; a[5] += w1.y * x[5]; a[6] += w1.z * x[6]; a[7] += w1.w * x[7];
                    if (j == 3) {
#pragma unroll
                        for (int i = 0; i < 8; ++i) cur[i] = x[i]; } }
            }
            float ss = 0.f;
#pragma unroll
            for (int i = 0; i < 8; ++i) { a[i] = siluf_(a[i]); ss += a[i] * a[i]; }
            if (jj < 4) { ss = grp16_sum(ss); float r = rsqrtf(ss + EPS); if (jj < 2) r *= 0.08838834764831845f;
#pragma unroll
                for (int i = 0; i < 8; ++i) a[i] *= r; }
            *(u32x4*)(qkvc + (size_t)m * 3072 + ch0) = pack8(a);
            if (prompt) { if (t >= SEQ - 3) { float* op = out + O_DCP + (((size_t)o * BP + b) * 3 + (t - (SEQ - 3))) * 3072 + ch0;
                    *(f32x4*)op = (f32x4){cur[0], cur[1], cur[2], cur[3]}; *(f32x4*)(op + 4) = (f32x4){cur[4], cur[5], cur[6], cur[7]}; } }
            else { float* ob = out + O_DCS + ((size_t)o * BS + b) * 3 * 3072 + ch0;
                *(f32x4*)(ob + 2 * 3072) = (f32x4){cur[0], cur[1], cur[2], cur[3]}; *(f32x4*)(ob + 2 * 3072 + 4) = (f32x4){cur[4], cur[5], cur[6], cur[7]}; }
        }
        if (lane < 8) { const float av = AB[(size_t)m * 16 + lane] + dtb[lane], bv = AB[(size_t)m * 16 + 8 + lane];
            const float sp = av > 20.f ? av : log1pf(expf(av));
            Gg[(size_t)m * 8 + lane] = -expf(alog[lane]) * sp; Bt[(size_t)m * 8 + lane] = 1.0f / (1.0f + expf(-bv)); }
      }
      else {
        const int b = task / GPS, gi = task - b * GPS, t0 = gi * 5, R = (SEQ - t0) < 5 ? (SEQ - t0) : 5, mbase = b * SEQ + t0;
#pragma unroll 1
        for (int jj = 0; jj < 6; ++jj) {
            const int ch0 = (lane + 64 * jj) * 8;
            f32x4 w[4][2];
#pragma unroll
            for (int j = 0; j < 4; ++j) { w[j][0] = *(const f32x4*)(cw + j * 3072 + ch0); w[j][1] = *(const f32x4*)(cw + j * 3072 + ch0 + 4); }
            u32x4 rg[8];
#pragma unroll
            for (int rr = 0; rr < 8; ++rr) { const bool valid = (t0 - 3 + rr >= 0) && (rr < 3 + R);
                const u32x4 v = *(const u32x4*)(qkv + (size_t)(valid ? mbase - 3 + rr : mbase) * 3072 + ch0); rg[rr] = valid ? v : (u32x4){0u, 0u, 0u, 0u}; }
            float a[5][8];
#pragma unroll
            for (int r = 0; r < 5; ++r)
#pragma unroll
                for (int i = 0; i < 8; ++i) a[r][i] = 0.f;
#pragma unroll
            for (int rr = 0; rr < 8; ++rr) { float x[8]; unpack8(rg[rr], x);
#pragma unroll
                for (int r = 0; r < 5; ++r) { const int j = rr - r; if (j >= 0 && j <= 3) {
                    a[r][0] += w[j][0].x * x[0]; a[r][1] += w[j][0].y * x[1]; a[r][2] += w[j][0].z * x[2]; a[r][3] += w[j][0].w * x[3];
                    a[r][4] += w[j][1].x * x[4]; a[r][5] += w[j][1].y * x[5]; a[r][6] += w[j][1].z * x[6]; a[r][7] += w[j][1].w * x[7]; } } }
            float ss[5];
#pragma unroll
            for (int r = 0; r < 5; ++r) { float q = 0.f;
#pragma unroll
                for (int i = 0; i < 8; ++i) { a[r][i] = siluf_(a[r][i]); q += a[r][i] * a[r][i]; }
                ss[r] = q; }
            if (jj < 4) {
#pragma unroll
                for (int of = 1; of < 16; of <<= 1) {
#pragma unroll
                    for (int r = 0; r < 5; ++r) ss[r] += __shfl_xor(ss[r], of); }
#pragma unroll
                for (int r = 0; r < 5; ++r) { float sc = rsqrtf(ss[r] + EPS); if (jj < 2) sc *= 0.08838834764831845f;
#pragma unroll
                    for (int i = 0; i < 8; ++i) a[r][i] *= sc; } }
#pragma unroll
            for (int r = 0; r < 5; ++r) if (r < R) *(u32x4*)(qkvc + (size_t)(mbase + r) * 3072 + ch0) = pack8(a[r]);
            if (t0 + R > SEQ - 3) {
#pragma unroll
                for (int r = 0; r < 5; ++r) if (r < R && t0 + r >= SEQ - 3) { float c8[8]; unpack8(rg[r + 3], c8);
                    float* op = out + O_DCP + (((size_t)o * BP + b) * 3 + (t0 + r - (SEQ - 3))) * 3072 + ch0;
                    *(f32x4*)op = (f32x4){c8[0], c8[1], c8[2], c8[3]}; *(f32x4*)(op + 4) = (f32x4){c8[4], c8[5], c8[6], c8[7]}; } }
        }
        if (lane < 40) { const int r = lane >> 3, hh = lane & 7; if (r < R) { const int m = mbase + r;
            const float av = AB[(size_t)m * 16 + hh] + dtb[hh], bv = AB[(size_t)m * 16 + 8 + hh];
            const float sp = av > 20.f ? av : log1pf(expf(av));
            Gg[(size_t)m * 8 + hh] = -expf(alog[hh]) * sp; Bt[(size_t)m * 8 + hh] = 1.0f / (1.0f + expf(-bv)); } }
      }
    }
}

__device__ __forceinline__ void phase_dn_intra(const Ctx& cx, PP P, int o, LAS unsigned char* lds) {
    const int tid = cx.tid, lane = tid & 63, l15 = lane & 15, quad = lane >> 4;
    const int hb = __builtin_amdgcn_readfirstlane(tid >> 8), htid = tid & 255, hw = __builtin_amdgcn_readfirstlane((tid >> 6) & 3);
    const int G = cx.G;
    unsigned char* ws = P->ws;
    const bf16_t* qkvc = (const bf16_t*)(ws + WS_MIX); const float* Gg = (const float*)(ws + WS_G); const float* Bt = (const float*)(ws + WS_BETA);
    float* CU = (float*)(ws + WS_CU); bf16_t* CW = (bf16_t*)(ws + WS_CW); bf16_t* CQD = (bf16_t*)(ws + WS_CQD); bf16_t* CKDT = (bf16_t*)(ws + WS_CKDT); bf16_t* CQK = (bf16_t*)(ws + WS_CQK); float* CGL = (float*)(ws + WS_CGL);
    LAS float* L = (LAS float*)lds + hb * 4352; LAS float* gcs = L + 4096; LAS float* bet = L + 4096 + 64;
    for (int p = cx.bid; p < 512; p += G) {
        const int ci = 2 * p + hb, bh = ci >> 5, n = ci & 31, b = bh >> 3, h = bh & 7, m0 = b * SEQ + n * 64;
        if (hw == 0) { float g = Gg[(size_t)(m0 + lane) * 8 + h];
#pragma unroll
            for (int off = 1; off < 64; off <<= 1) { const float tv = __shfl_up(g, off); if (lane >= off) g += tv; }
            gcs[lane] = g; bet[lane] = Bt[(size_t)(m0 + lane) * 8 + h]; }
        __syncthreads();
        {
            const int mt = hw; const bf16_t* rp = qkvc + (size_t)(m0 + 16 * mt + l15) * 3072 + h * 128;
            bf16x8 ak[4], aq[4];
#pragma unroll
            for (int ks = 0; ks < 4; ++ks) { aq[ks] = *(const bf16x8*)(rp + ks * 32 + quad * 8); ak[ks] = *(const bf16x8*)(rp + 1024 + ks * 32 + quad * 8); }
#pragma unroll
            for (int nt = 0; nt < 4; ++nt) {
                f32x4 accK = (f32x4){0.f, 0.f, 0.f, 0.f}, accQ = (f32x4){0.f, 0.f, 0.f, 0.f};
                if (nt <= mt) { const bf16_t* bp = qkvc + (size_t)(m0 + 16 * nt + l15) * 3072 + 1024 + h * 128;
#pragma unroll
                    for (int ks = 0; ks < 4; ++ks) { const bf16x8 bk = *(const bf16x8*)(bp + ks * 32 + quad * 8);
                        accK = __builtin_amdgcn_mfma_f32_16x16x32_bf16(ak[ks], bk, accK, 0, 0, 0); accQ = __builtin_amdgcn_mfma_f32_16x16x32_bf16(aq[ks], bk, accQ, 0, 0, 0); } }
                const int j = 16 * nt + l15; const float gj = gcs[j];
#pragma unroll
                for (int jj = 0; jj < 4; ++jj) { const int i = 16 * mt + quad * 4 + jj; const float dec = (j <= i) ? __expf(gcs[i] - gj) : 0.f;
                    L[i * 64 + j] = (j < i) ? bet[i] * accK[jj] * dec : 0.f;
                    CQK[(size_t)ci * 4096 + i * 64 + j] = (bf16_t)(cvt_pk_bf16(accQ[jj] * dec, 0.f) & 0xffff); }
            }
        }
        __syncthreads();
        asm volatile("" ::: "memory"); __builtin_amdgcn_sched_barrier(0);
        {
            const int c = htid; float x[64];
            const bf16_t* vp = qkvc + (size_t)m0 * 3072 + (c < 128 ? 2048 + h * 128 + c : 1024 + h * 128 + (c - 128));
#pragma unroll
            for (int i = 0; i < 64; ++i) { const float r = bf1(*vp); vp += 3072; asm volatile("" : "+v"(vp)); const float sc = c < 128 ? bet[i] : bet[i] * __expf(gcs[i]); x[i] = r * sc; }
#pragma unroll
            for (int i = 1; i < 64; ++i) { float a0 = 0.f, a1 = 0.f, a2 = 0.f, a3 = 0.f;
#pragma unroll
                for (int j4 = 0; j4 < (i + 3) / 4; ++j4) { const f32x4 l = *(const LAS f32x4*)(L + i * 64 + j4 * 4);
                    a0 += l.x * x[j4 * 4 + 0]; if (j4 * 4 + 1 < i) a1 += l.y * x[j4 * 4 + 1]; if (j4 * 4 + 2 < i) a2 += l.z * x[j4 * 4 + 2]; if (j4 * 4 + 3 < i) a3 += l.w * x[j4 * 4 + 3];
                    if (j4 == 7) asm volatile("" ::: "memory"); }
                x[i] = x[i] - ((a0 + a1) + (a2 + a3)); asm volatile("" ::: "memory"); }
            if (c < 128) { float* up = CU + (size_t)ci * 8192 + c;
#pragma unroll
                for (int i = 0; i < 64; ++i) { *up = x[i]; up += 128; asm volatile("" : "+v"(up)); } }
            else { bf16_t* wp = CW + (size_t)ci * 8192 + (c - 128);
#pragma unroll
                for (int i = 0; i < 64; ++i) { *wp = (bf16_t)(cvt_pk_bf16(x[i], 0.f) & 0xffff); wp += 128; asm volatile("" : "+v"(wp)); } }
        }
        asm volatile("" ::: "memory"); __builtin_amdgcn_sched_barrier(0);
        {
            const float glast = gcs[63];
#pragma unroll
            for (int it = 0; it < 4; ++it) { const int idx = htid + 256 * it, i = idx >> 4, dq = idx & 15; float f[8];
                const u32x4 r = *(const u32x4*)(qkvc + (size_t)(m0 + i) * 3072 + h * 128 + dq * 8); unpack8(r, f); const float eg = __expf(gcs[i]);
#pragma unroll
                for (int k = 0; k < 8; ++k) f[k] *= eg;
                *(u32x4*)(CQD + (size_t)ci * 8192 + i * 128 + dq * 8) = pack8(f); }
#pragma unroll
            for (int it = 0; it < 4; ++it) { const int idx = htid + 256 * it, d = idx & 127, ig = idx >> 7; float f[8];
#pragma unroll
                for (int ii = 0; ii < 8; ++ii) { const int i = ig * 8 + ii; f[ii] = bf1(qkvc[(size_t)(m0 + i) * 3072 + 1024 + h * 128 + d]) * __expf(glast - gcs[i]); }
                *(u32x4*)(CKDT + (size_t)ci * 8192 + d * 64 + ig * 8) = pack8(f); }
            if (htid == 0) CGL[ci] = __expf(glast);
        }
        __syncthreads();
    }
}
__device__ __forceinline__ void phase_dn_sample(const Ctx& cx, PP P, int o, LAS unsigned char* lds) {
    const int tid = cx.tid; const int G = cx.G; unsigned char* ws = P->ws;
    const bf16_t* qkvc = (const bf16_t*)(ws + WS_MIX); const float* Gg = (const float*)(ws + WS_G); const float* Bt = (const float*)(ws + WS_BETA);
    const float* S0 = P->in[5] + (size_t)o * BS * 8 * 16384; float* Sout = P->out + O_SS + (size_t)o * BS * 8 * 16384; float* O = (float*)(ws + WS_O);
    LAS float* sq = (LAS float*)lds; LAS float* sk = sq + 128; LAS float* sv = sk + 128; LAS float* red = sv + 128;
    const bf16_t* zgp = (const bf16_t*)(ws + WS_ZG); bf16_t* catp = (bf16_t*)(ws + WS_CAT); const float* ngp = P->in[25] + o * 128;
    for (int task = cx.bid; task < BS * 8; task += G) {
        const int b = task >> 3, h = task & 7, m = MPR + b;
        if (tid < 384) { const int which = tid >> 7, d = tid & 127; sq[which * 128 + d] = bf1(qkvc[(size_t)m * 3072 + which * 1024 + h * 128 + d]); }
        __syncthreads();
        const int e = tid & 127, part = tid >> 7;
        const float* sp = S0 + (size_t)task * 16384 + (size_t)(part * 32) * 128 + e;
        float s[32]; float ks = 0.f, qs = 0.f, qk = 0.f;
#pragma unroll
        for (int d = 0; d < 32; ++d) { s[d] = __builtin_nontemporal_load(sp); sp += 128; asm volatile("" : "+v"(sp)); }
#pragma unroll
        for (int d = 0; d < 32; ++d) { ks += sk[part * 32 + d] * s[d]; qs += sq[part * 32 + d] * s[d]; }
        if (tid < 64) { const float pq = wave_sum(sq[tid] * sk[tid] + sq[tid + 64] * sk[tid + 64]); if (tid == 0) red[1024] = pq; }
        red[part * 128 + e] = ks; red[512 + part * 128 + e] = qs;
        __syncthreads();
        qk = red[1024];
        const float ksum = red[e] + red[128 + e] + red[256 + e] + red[384 + e], qsum = red[512 + e] + red[640 + e] + red[768 + e] + red[896 + e];
        const float g = Gg[(size_t)m * 8 + h], beta = Bt[(size_t)m * 8 + h], eg = __expf(g);
        const float vnew = beta * (sv[e] - eg * ksum);
        float* op = Sout + (size_t)task * 16384 + (size_t)(part * 32) * 128 + e;
#pragma unroll
        for (int d = 0; d < 32; ++d) { __builtin_nontemporal_store(eg * s[d] + sk[part * 32 + d] * vnew, op); op += 128; asm volatile("" : "+v"(op)); }
        const float oval = eg * qsum + qk * vnew;
        if (part == 0) { const float p2 = wave_sum(oval * oval); if ((tid & 63) == 0) red[1032 + (tid >> 6)] = p2; }
        __syncthreads();
        if (part == 0) { const float rs = rsqrtf((red[1032] + red[1033]) * (1.0f / 128.f) + EPS);
            const float z = bf1(zgp[(size_t)m * 1024 + h * 128 + e]);
            catp[(size_t)m * 2048 + 1024 + h * 128 + e] = (bf16_t)(cvt_pk_bf16(oval * rs * ngp[e] * siluf_(z), 0.f) & 0xffff); }
        __syncthreads();
    }
}

struct ScanOps { bf16x8 a1[4], a2[2], a3[2]; f32x4 u; float gl; };
__device__ __forceinline__ void scan_load(ScanOps& o, int ci, int w, int l15, int quad, int e0, const float* CU, const bf16_t* CW, const bf16_t* CQD, const bf16_t* CKDT, const bf16_t* CQK, const float* CGL) {
    const int mt = w & 3;
    { const bf16_t* ap = (w < 4 ? CW : CQD) + (size_t)ci * 8192 + (16 * mt + l15) * 128;
#pragma unroll
      for (int ks = 0; ks < 4; ++ks) o.a1[ks] = *(const bf16x8*)(ap + ks * 32 + quad * 8); }
    o.u = (f32x4){0.f, 0.f, 0.f, 0.f};
#pragma unroll
    for (int ks = 0; ks < 2; ++ks) o.a2[ks] = (bf16x8){0, 0, 0, 0, 0, 0, 0, 0};
    if (w < 4) {
#pragma unroll
        for (int j = 0; j < 4; ++j) o.u[j] = CU[(size_t)ci * 8192 + (16 * mt + quad * 4 + j) * 128 + e0 + l15]; }
    else { const bf16_t* qp = CQK + (size_t)ci * 4096 + (16 * mt + l15) * 64;
#pragma unroll
        for (int ks = 0; ks < 2; ++ks) o.a2[ks] = *(const bf16x8*)(qp + ks * 32 + quad * 8); }
    { const bf16_t* kp = CKDT + (size_t)ci * 8192 + (16 * w + l15) * 64;
#pragma unroll
      for (int ks = 0; ks < 2; ++ks) o.a3[ks] = *(const bf16x8*)(kp + ks * 32 + quad * 8); }
    o.gl = CGL[ci];
}
#define SCAN_BAR() do { asm volatile("s_waitcnt lgkmcnt(0)" ::: "memory"); __builtin_amdgcn_s_barrier(); asm volatile("" ::: "memory"); } while (0)
__device__ __forceinline__ void phase_dn_scan(const Ctx& cx, PP P, int o, LAS unsigned char* lds) {
    const int tid = cx.tid, lane = tid & 63, l15 = lane & 15, quad = lane >> 4, w = __builtin_amdgcn_readfirstlane(tid >> 6);
    const int G = cx.G;
    unsigned char* ws = P->ws;
    const float* CU = (const float*)(ws + WS_CU); const bf16_t* CW = (const bf16_t*)(ws + WS_CW); const bf16_t* CQD = (const bf16_t*)(ws + WS_CQD); const bf16_t* CKDT = (const bf16_t*)(ws + WS_CKDT); const bf16_t* CQK = (const bf16_t*)(ws + WS_CQK); const float* CGL = (const float*)(ws + WS_CGL);
    float* O = (float*)(ws + WS_O);
    LAS bf16_t* ST = (LAS bf16_t*)lds;
    LAS bf16_t* VT = ST + 16 * 136;
    for (int task0 = cx.bid; task0 < 256; task0 += G) {
        const int task = (G == 256) ? ((task0 & 7) * 32 + (task0 >> 3)) : task0;
        const int bh = task >> 3, es = task & 7, e0 = es * 16, b = bh >> 3, h = bh & 7;
        const int mt = w & 3;
        f32x4 S = (f32x4){0.f, 0.f, 0.f, 0.f};
        f32x4 oacc = (f32x4){0.f, 0.f, 0.f, 0.f};
        ScanOps cur, nxt;
        scan_load(cur, bh * 32, w, l15, quad, e0, CU, CW, CQD, CKDT, CQK, CGL);
        for (int n = 0; n < 32; ++n) {
            const int m0 = b * SEQ + n * 64;
            scan_load(nxt, bh * 32 + (n < 31 ? n + 1 : n), w, l15, quad, e0, CU, CW, CQD, CKDT, CQK, CGL);
            { u32x2 sw; sw.x = cvt_pk_bf16(S[0], S[1]); sw.y = cvt_pk_bf16(S[2], S[3]); *(LAS u32x2*)(ST + l15 * 136 + 16 * w + quad * 4) = sw; }
            SCAN_BAR();
            { f32x4 acc = (f32x4){0.f, 0.f, 0.f, 0.f};
#pragma unroll
              for (int ks = 0; ks < 4; ++ks) { const bf16x8 bs = *(const LAS bf16x8*)(ST + l15 * 136 + ks * 32 + quad * 8); acc = __builtin_amdgcn_mfma_f32_16x16x32_bf16(cur.a1[ks], bs, acc, 0, 0, 0); }
              if (w < 4) { const f32x4 vn = cur.u - acc; u32x2 vw; vw.x = cvt_pk_bf16(vn[0], vn[1]); vw.y = cvt_pk_bf16(vn[2], vn[3]); *(LAS u32x2*)(VT + l15 * 72 + 16 * mt + quad * 4) = vw; }
              else oacc = acc; }
            SCAN_BAR();
            bf16x8 bv[2];
#pragma unroll
            for (int ks = 0; ks < 2; ++ks) bv[ks] = *(const LAS bf16x8*)(VT + l15 * 72 + ks * 32 + quad * 8);
            if (w >= 4) {
#pragma unroll
                for (int ks = 0; ks < 2; ++ks) oacc = __builtin_amdgcn_mfma_f32_16x16x32_bf16(cur.a2[ks], bv[ks], oacc, 0, 0, 0);
#pragma unroll
                for (int j = 0; j < 4; ++j) O[(size_t)(m0 + 16 * mt + quad * 4 + j) * 1024 + h * 128 + e0 + l15] = oacc[j]; }
            S = S * cur.gl;
#pragma unroll
            for (int ks = 0; ks < 2; ++ks) S = __builtin_amdgcn_mfma_f32_16x16x32_bf16(cur.a3[ks], bv[ks], S, 0, 0, 0);
            cur = nxt;
        }
        float* sp = P->out + O_SP + (((size_t)o * BP + b) * 8 + h) * 16384;
#pragma unroll
        for (int j = 0; j < 4; ++j) sp[(size_t)(16 * w + quad * 4 + j) * 128 + e0 + l15] = S[j];
        __syncthreads();
    }
}

__device__ __forceinline__ void phase_dn_gate(const Ctx& cx, PP P, int o) {
    const int tid = cx.tid, lane = tid & 63, wave = __builtin_amdgcn_readfirstlane(tid >> 6);
    const int gw = cx.bid * NWAVES + wave, NGW = cx.G * NWAVES;
    const float* O = (const float*)(P->ws + WS_O); const bf16_t* zg = (const bf16_t*)(P->ws + WS_ZG); bf16_t* cat = (bf16_t*)(P->ws + WS_CAT);
    const float* ng = P->in[25] + o * 128;
    for (int m = gw; m < MPR; m += 4 * NGW) {
        f32x4 ov[4][2][2]; u32x4 zv[4][2]; int mr[4]; bool ok[4];
#pragma unroll
        for (int k = 0; k < 4; ++k) { const int mk = m + k * NGW; ok[k] = mk < MPR; mr[k] = ok[k] ? mk : m;
#pragma unroll
            for (int jj = 0; jj < 2; ++jj) { const int ch0 = (lane + 64 * jj) * 8; ov[k][jj][0] = *(const f32x4*)(O + (size_t)mr[k] * 1024 + ch0); ov[k][jj][1] = *(const f32x4*)(O + (size_t)mr[k] * 1024 + ch0 + 4);
                zv[k][jj] = *(const u32x4*)(zg + (size_t)mr[k] * 1024 + ch0); } }
#pragma unroll
        for (int k = 0; k < 4; ++k)
#pragma unroll
            for (int jj = 0; jj < 2; ++jj) { const int ch0 = (lane + 64 * jj) * 8; const f32x4 o0 = ov[k][jj][0], o1 = ov[k][jj][1];
                float f[8] = {o0.x, o0.y, o0.z, o0.w, o1.x, o1.y, o1.z, o1.w}; float ss = 0.f;
#pragma unroll
                for (int i = 0; i < 8; ++i) ss += f[i] * f[i];
                const float rs = rsqrtf(grp16_sum(ss) * (1.0f / 128.f) + EPS);
                float z[8]; unpack8(zv[k][jj], z);
#pragma unroll
                for (int i = 0; i < 8; ++i) f[i] = f[i] * rs * ng[(ch0 & 127) + i] * siluf_(z[i]);
                if (ok[k]) *(u32x4*)(cat + (size_t)mr[k] * 2048 + 1024 + ch0) = pack8(f); }
    }
}

#define XB_TMO      128
#define XB_XCNT(j)  (256  + 64 * (j))
#define XB_XSUB(j)  (1280 + 64 * (j))
#define XB_XGEN(j)  (2304 + 64 * (j))
#define XB_TOP      3328
#define XB_TOPGEN   3392
#define XCD_BAR_WORDS 3456
#define XB_SPIN_CAP (1u << 20)
__device__ __forceinline__ unsigned xb_ld(unsigned* p)              { return __hip_atomic_load(p, __ATOMIC_RELAXED, __HIP_MEMORY_SCOPE_AGENT); }
__device__ __forceinline__ unsigned xb_add(unsigned* p, unsigned v) { return __hip_atomic_fetch_add(p, v, __ATOMIC_RELAXED, __HIP_MEMORY_SCOPE_AGENT); }
__device__ __forceinline__ unsigned xb_xcc_id() { return (unsigned)__builtin_amdgcn_s_getreg((3 << 11) | 20) & 0xFu; }
#define XB_SPIN(cond, bar) do { unsigned _sp = 0; while (cond) { __builtin_amdgcn_s_sleep(1); \
    if ((++_sp & 255u) == 0u) { if (xb_ld(&(bar)[XB_TMO])) break; if (_sp > XB_SPIN_CAP) { atomicAdd(&(bar)[XB_TMO], 1u); break; } } } } while (0)
struct XcdBarrier { unsigned* bar; unsigned x; volatile LAS unsigned* st; };
__device__ __forceinline__ XcdBarrier xcd_barrier_post(unsigned* bar, volatile LAS unsigned* st) {
    XcdBarrier b; b.bar = bar; b.x = xb_xcc_id(); b.st = st;
    if (threadIdx.x == 0) (void)xb_add(&bar[XB_XCNT(b.x)], 1u);
    return b;
}
__device__ __forceinline__ void xcd_barrier_complete(unsigned* bar, unsigned x, unsigned& nloc, unsigned& nx) {
    const unsigned G = gridDim.x * gridDim.y * gridDim.z;
    unsigned sum, cnt, mine, sp = 0u;
    for (;;) {
        sum = 0u; cnt = 0u; mine = 0u;
#pragma unroll
        for (unsigned j = 0; j < 16; ++j) { const unsigned c = xb_ld(&bar[XB_XCNT(j)]); sum += c; cnt += (c > 0u) ? 1u : 0u; mine = (j == x) ? c : mine; }
        if (sum == G) break;
        __builtin_amdgcn_s_sleep(1);
        if ((++sp & 255u) == 0u) { if (xb_ld(&bar[XB_TMO])) break; if (sp > XB_SPIN_CAP) { atomicAdd(&bar[XB_TMO], 1u); break; } }
    }
    nloc = mine > 0u ? mine : 1u; nx = cnt > 0u ? cnt : 1u;
}
__device__ __forceinline__ void xcd_barrier(const XcdBarrier& b) {
    asm volatile("s_waitcnt vmcnt(0)" ::: "memory");
    __syncthreads();
    if (threadIdx.x == 0) {
        unsigned* bar = b.bar;
        __builtin_amdgcn_s_waitcnt(0);
        unsigned nloc = b.st[0], nx = b.st[1];
        if (nloc == 0u) { xcd_barrier_complete(bar, b.x, nloc, nx); b.st[0] = nloc; b.st[1] = nx; }
        const unsigned old = xb_add(&bar[XB_XSUB(b.x)], 1u);
        const unsigned gen = old / nloc;
        if (old + 1u == (gen + 1u) * nloc) {
            __builtin_amdgcn_fence(__ATOMIC_RELEASE, "agent");
            asm volatile("s_waitcnt vmcnt(0)" ::: "memory");
            const unsigned og = xb_add(&bar[XB_TOP], 1u);
            const unsigned tg = og / nx;
            if (og + 1u == (tg + 1u) * nx) xb_add(&bar[XB_TOPGEN], 1u);
            else XB_SPIN(xb_ld(&bar[XB_TOPGEN]) == tg, bar);
            __builtin_amdgcn_fence(__ATOMIC_ACQUIRE, "agent");
            xb_add(&bar[XB_XGEN(b.x)], 1u);
            asm volatile("s_waitcnt vmcnt(0)" ::: "memory");
        } else {
            XB_SPIN(xb_ld(&bar[XB_XGEN(b.x)]) == gen, bar);
            __builtin_amdgcn_fence(__ATOMIC_ACQUIRE, "agent");
            asm volatile("s_waitcnt vmcnt(0)" ::: "memory");
        }
    }
    __syncthreads();
}

__device__ __forceinline__ void copy_rows_shift(const Ctx& cx, const float* src, float* dst, int nb, int rows_in, int rows_copy, int width4) {
    const int per_b = rows_copy * width4, total = nb * per_b;
    for (int i = (cx.G - 1 - cx.bid) * NTHR + cx.tid; i < total; i += cx.G * NTHR) { const int b = i / per_b, r = i - b * per_b;
        ((f32x4*)dst)[(size_t)b * rows_in * width4 + r] = ((const f32x4*)src)[(size_t)b * rows_in * width4 + width4 + r]; }
}
constexpr int NPHASES = 1 + 8 + 10 + 8 + 10 + 1;
__global__ void __launch_bounds__(NTHR, 2) mega_fwd(Params Pin) {
    extern __shared__ __attribute__((aligned(16))) unsigned char lds_raw[];
    LAS unsigned char* lds = (LAS unsigned char*)lds_raw;
    const __attribute__((address_space(4))) unsigned char* kp = (const __attribute__((address_space(4))) unsigned char*)__builtin_amdgcn_kernarg_segment_ptr();
    constexpr int nM = MPAD / 256;
    volatile LAS unsigned* bst = (volatile LAS unsigned*)(lds + 131072);
    if (threadIdx.x < 2) bst[threadIdx.x] = 0u;
    __syncthreads();
    XcdBarrier gbar; gbar.bar = nullptr; gbar.x = 0; gbar.st = bst;
    if (((PP)kp)->coop) gbar = xcd_barrier_post((unsigned*)(((PP)kp)->ws + WS_BAR), bst);
    const int ph_lo = ((PP)kp)->ph_lo, ph_hi = ((PP)kp)->ph_hi;
#ifdef EXTRA_SYNCS
    for (int i = 0; i < EXTRA_SYNCS; ++i) xcd_barrier(gbar);
#endif
    int did_rep = 0;
    for (int ph = ph_lo; ph < ph_hi; ++ph) {
        asm volatile("" : "+s"(kp));
        Ctx cx; cx.tid = threadIdx.x; cx.bid = blockIdx.x; cx.G = gridDim.x;
        asm volatile("" : "+v"(cx.tid)); asm volatile("" : "+s"(cx.bid)); asm volatile("" : "+s"(cx.G));
        PP P = (PP)kp;
        unsigned char* ws = P->ws;
        float* X = (float*)(ws + WS_X); bf16_t* H = (bf16_t*)(ws + WS_H); bf16_t* ACT = (bf16_t*)(ws + WS_ACT); bf16_t* CAT = (bf16_t*)(ws + WS_CAT);
        float* PX = (float*)(ws + WS_PARTX);
        int l, op;
        if (ph == 0) { l = 0; op = 10; }
        else if (ph == NPHASES - 1) { l = 0; op = 11; }
        else { int r = ph - 1; const int pair = r / 18; r %= 18;
            if (r < 8) { l = 2 * pair; op = r < 4 ? r : r + 2; }
            else { l = 2 * pair + 1; op = r - 8; } }
        const bool even = (l & 1) == 0; const int e = l >> 1;
#ifndef OPMASK
#define OPMASK 0xfff
#endif
#ifndef REPMASK
#define REPMASK 0
#endif
        if (!(((OPMASK) >> op) & 1)) continue;
        const bool dry = REPMASK && ((REPMASK >> op) & 1) && !did_rep;
        switch (op) {
        case 10: phase_prep(cx, P, lds); phase_first_norm(cx, P, X, P->in[6], H); break;
        case 11: phase_rmsnorm<true>(cx, X, P->in[8], nullptr, P->out + O_YP, PX, 44, dry, lds); break;
        case 0: if (l > 0) phase_rmsnorm<false>(cx, X, P->in[6] + (size_t)l * D, H, nullptr, PX, l > 0 ? 44 : 0, dry, lds); break;
        case 7: phase_rmsnorm<false>(cx, X, P->in[7] + (size_t)l * D, H, nullptr, PX, 16, dry, lds); break;
        case 1:
            if (even) { pg8::StaticSched S; S.init(cx, H, (bf16_t*)(ws + WS_WEVIN) + (size_t)e * EV_IN * 2048, 2048, 2048, nM, EV_IN / 256, 2048, 0);
                pg8::EpiEvenIn E{(bf16_t*)(ws + WS_ABUF), (bf16_t*)(ws + WS_UV)}; pg8::gemm_phase(cx, lds, S, E);
                copy_rows_shift(cx, P->in[2] + (size_t)e * BS * 15 * 1024, P->out + O_PS + (size_t)e * BS * 15 * 1024, BS, 15, 14, 256);
                if (l == 0) convert_slot(cx, P, lds, 1, 0, DEF1_A, 140, 116); else convert_slot(cx, P, lds, 3, 0, DEF3_A, 140, 116); }
            else { pg8::StaticSched S; S.init(cx, H, (bf16_t*)(ws + WS_WODIN) + (size_t)e * OD_INM * 2048, 2048, 2048, nM, OD_INM / 256, 2048, 0);
                pg8::EpiOddIn E{(bf16_t*)(ws + WS_ABUF), (bf16_t*)(ws + WS_UV), (bf16_t*)(ws + WS_ZG)}; pg8::gemm_phase(cx, lds, S, E);
                phase_ab(cx, P, e);
                copy_rows_shift(cx, P->in[3] + (size_t)e * BS * 30 * 1024, P->out + O_CS + (size_t)e * BS * 30 * 1024, BS, 30, 29, 256);
                copy_rows_shift(cx, P->in[4] + (size_t)e * BS * 3 * 3072, P->out + O_DCS + (size_t)e * BS * 3 * 3072, BS, 3, 2, 768);
                if (l == 1) convert_slot(cx, P, lds, 2, 0, DEF2_A, 24, 166); }
            break;
        case 2: if (even) phase_even_prep(cx, P, e); else phase_odd_prep(cx, P, e, lds); break;
        case 3:
            if (even) {
#ifndef DBG_NO_POOL
                pg8::StaticSched S; S.init(cx, ws + WS_MIX, (bf16_t*)(ws + WS_WPOOL) + (size_t)e * 1024 * 256, 1024, 256, nM, 4, 256, 512);
                pg8::EpiPool E{CAT, P->in[11] + e * 1024}; pg8::gemm_phase(cx, lds, S, E);
                __syncthreads();
#endif
#ifndef DBG_NO_SGU
                phase_sgu(cx, P, e, lds);
#endif
            }
#ifndef DBG_NO_DNI
            else phase_dn_intra(cx, P, e, lds);
#endif
            break;
        case 4: phase_dn_sample(cx, P, e, lds); __syncthreads(); phase_dn_scan(cx, P, e, lds); break;
        case 5: phase_dn_gate(cx, P, e); break;
        case 6: { const bf16_t* Wt = (even ? (bf16_t*)(ws + WS_WEVOUT) : (bf16_t*)(ws + WS_WODOUT)) + (size_t)e * 2048 * 2048;
                pg8::ResidSched S; S.init(cx, CAT, Wt, 2048, 2048); pg8::EpiResidX E{{X, dry}, {PX, dry}}; pg8::gemm_phase(cx, lds, S, E); } break;
        case 8: { pg8::StaticSched S; S.init(cx, H, (bf16_t*)(ws + WS_WUP) + (size_t)l * 2 * DFF * 2048, 2048, 2048, nM, 2 * DFF / 256, 2048, 0);
                pg8::EpiUp E{ACT}; pg8::gemm_phase(cx, lds, S, E);
                if (l == 0) convert_slot(cx, P, lds, 1, DEF1_A, DEF1_B, 172, 84); else if (l == 1) convert_slot(cx, P, lds, 2, DEF2_A, DEF2_B, 172, 84); else if (l == 2) convert_slot(cx, P, lds, 3, DEF3_A, DEF3_B, 172, 84); } break;
        case 9: { const bf16_t* Wt = (bf16_t*)(ws + WS_WDOWN) + (size_t)l * 2048 * DFF;
                pg8::ResidSched S; S.init(cx, ACT, Wt, DFF, DFF); pg8::EpiResidX E{{X, dry}, {PX, dry}}; pg8::gemm_phase(cx, lds, S, E); } break;
        default: break;
        }
        if (REPMASK) { if (((REPMASK >> op) & 1) && !did_rep) { did_rep = 1; --ph; } else did_rep = 0; }
        if (ph + 1 < ph_hi && !(op == 0 && l == 0)) { if (P->coop) { if (ph == 0) cg::this_grid().sync(); else xcd_barrier(gbar); } }
    }
}

#ifndef MK_COOP
#define MK_COOP 1
#endif
extern "C" void kernel_launch(void* const* d_in, const int* in_sizes, int n_in, void* d_out, int out_size, void* d_ws, size_t ws_size, hipStream_t stream) {
    static int grid = 0;
    if (grid == 0) {
        if (n_in != 29 || (size_t)out_size != O_END || ws_size < WS_END) { fprintf(stderr, "kernel_launch: unexpected shapes n_in %d out %d ws %zu (need %zu)\n", n_in, out_size, ws_size, (size_t)WS_END); grid = -1; return; }
        int dev = 0, cus = 0, per_cu = 0;
        hipGetDevice(&dev); hipDeviceGetAttribute(&cus, hipDeviceAttributeMultiprocessorCount, dev);
        if (hipFuncSetAttribute((const void*)mega_fwd, hipFuncAttributeMaxDynamicSharedMemorySize, LDS_BYTES) != hipSuccess) { fprintf(stderr, "kernel_launch: hipFuncSetAttribute failed\n"); grid = -1; return; }
        if (hipOccupancyMaxActiveBlocksPerMultiprocessor(&per_cu, (const void*)mega_fwd, NTHR, LDS_BYTES) != hipSuccess || per_cu < 1) { fprintf(stderr, "kernel_launch: occupancy query says %d\n", per_cu); per_cu = 1; }
        (void)hipGetLastError();
        grid = cus < 256 ? cus : 256;
        if (grid <= 0) grid = 256;
    }
    if (grid < 0) return;
    Params p{};
    for (int i = 0; i < 29; ++i) p.in[i] = (const float*)d_in[i];
    p.out = (float*)d_out; p.ws = (unsigned char*)d_ws; p.pad = 0;
#if MK_COOP
    p.ph_lo = 0; p.ph_hi = NPHASES; p.coop = 1;
    if (hipMemsetAsync((char*)d_ws + WS_BAR, 0, WS_BAR_BYTES, stream) != hipSuccess) { fprintf(stderr, "kernel_launch: memset of barrier words failed\n"); return; }
    void* args[] = {&p};
    hipError_t e = hipLaunchCooperativeKernel((const void*)mega_fwd, dim3(grid), dim3(NTHR), args, LDS_BYTES, stream);
    if (e != hipSuccess) fprintf(stderr, "cooperative launch failed: %s (grid %d)\n", hipGetErrorString(e), grid);
#else
    p.coop = 0;
    for (int ph = 0; ph < NPHASES; ++ph) { p.ph_lo = ph; p.ph_hi = ph + 1; hipLaunchKernelGGL(mega_fwd, dim3(grid), dim3(NTHR), LDS_BYTES, stream, p); }
#endif
}
```

```cpp
#include <hip/hip_runtime.h>
#include <hip/hip_cooperative_groups.h>
#include <cstdio>
namespace cg = cooperative_groups;

#define LAS __attribute__((address_space(3)))
typedef unsigned short bf16_t;
typedef short bf16x8 __attribute__((ext_vector_type(8)));
typedef float f32x4 __attribute__((ext_vector_type(4)));
typedef float f32x2 __attribute__((ext_vector_type(2)));
typedef unsigned u32x4 __attribute__((ext_vector_type(4)));
typedef unsigned u32x2 __attribute__((ext_vector_type(2)));

constexpr int D = 2048, SEQ = 2048, BP = 4, MPR = BP * SEQ, BS = 128, MT = MPR + BS, MPAD = 8448;
constexpr int DFF = 5632, EV_IN = 3072, OD_IN = 6160, OD_INM = 6144;
constexpr float EPS = 1e-6f;
constexpr int NTHR = 512, NWAVES = 8;
constexpr int LDS_BYTES = 131072 + 1024;

constexpr size_t O_YP = 0;
constexpr size_t O_YS = O_YP + (size_t)MPR * D;
constexpr size_t O_PP = O_YS + (size_t)BS * D;
constexpr size_t O_PS = O_PP + (size_t)2 * BP * 15 * 1024;
constexpr size_t O_SV = O_PS + (size_t)2 * BS * 15 * 1024;
constexpr size_t O_CP = O_SV + (size_t)2 * BS * 1024;
constexpr size_t O_CS = O_CP + (size_t)2 * BP * 30 * 1024;
constexpr size_t O_DCP = O_CS + (size_t)2 * BS * 30 * 1024;
constexpr size_t O_DCS = O_DCP + (size_t)2 * BP * 3 * 3072;
constexpr size_t O_SP = O_DCS + (size_t)2 * BS * 3 * 3072;
constexpr size_t O_SS = O_SP + (size_t)2 * BP * 8 * 128 * 128;
constexpr size_t O_END = O_SS + (size_t)2 * BS * 8 * 128 * 128;

constexpr size_t al(size_t x) { return (x + 4095) & ~(size_t)4095; }
constexpr size_t WS_X = 0;
constexpr size_t WS_H = WS_X + al((size_t)MPAD * D * 4);
constexpr size_t WS_ACT = WS_H + al((size_t)MPAD * D * 2);
constexpr size_t WS_CAT = WS_ACT + al((size_t)MPAD * DFF * 2);
constexpr size_t WS_ABUF = WS_CAT + al((size_t)MPAD * D * 2);
constexpr size_t WS_UV = WS_ABUF + al((size_t)MPAD * 1024 * 2);
constexpr size_t WS_ZG = WS_UV + al((size_t)MPAD * 3072 * 2);
constexpr size_t WS_MIX = WS_ZG + al((size_t)MPAD * 1024 * 2);
constexpr size_t WS_VN = WS_MIX + al((size_t)MPAD * 3072 * 2);
constexpr size_t WS_AB = WS_VN + al((size_t)MPAD * 1024 * 2);
constexpr size_t WS_G = WS_AB + al((size_t)MPAD * 16 * 4);
constexpr size_t WS_BETA = WS_G + al((size_t)MPAD * 8 * 4);
constexpr size_t WS_O = WS_BETA + al((size_t)MPAD * 8 * 4);
constexpr size_t WS_CU = WS_O + al((size_t)MPAD * 1024 * 4);
constexpr size_t WS_CW = WS_CU + al((size_t)1024 * 8192 * 4);
constexpr size_t WS_CQD = WS_CW + al((size_t)1024 * 8192 * 2);
constexpr size_t WS_CKDT = WS_CQD + al((size_t)1024 * 8192 * 2);
constexpr size_t WS_CQK = WS_CKDT + al((size_t)1024 * 8192 * 2);
constexpr size_t WS_CGL = WS_CQK + al((size_t)1024 * 4096 * 2);
constexpr size_t WS_WEVIN = WS_CGL + al(4096);
constexpr size_t WS_WEVOUT = WS_WEVIN + al((size_t)2 * 3072 * 2048 * 2);
constexpr size_t WS_WODIN = WS_WEVOUT + al((size_t)2 * 2048 * 2048 * 2);
constexpr size_t WS_WODOUT = WS_WODIN + al((size_t)2 * 6144 * 2048 * 2);
constexpr size_t WS_WUP = WS_WODOUT + al((size_t)2 * 2048 * 2048 * 2);
constexpr size_t WS_WDOWN = WS_WUP + al((size_t)4 * 11264 * 2048 * 2);
constexpr size_t WS_WPOOL = WS_WDOWN + al((size_t)4 * 2048 * 5632 * 2);
constexpr size_t WS_PARTX = WS_WPOOL + al((size_t)2 * 1024 * 256 * 2);
constexpr size_t WS_WAB = WS_PARTX + al((size_t)256 * 32768 * 4);
constexpr size_t WS_BAR = WS_WAB + al((size_t)2 * 16 * 2048 * 2);
constexpr size_t WS_BAR_BYTES = 16384;
constexpr size_t WS_END = WS_BAR + WS_BAR_BYTES;

struct Params { const float* in[29]; float* out; unsigned char* ws; int ph_lo, ph_hi, coop, pad; };
typedef const __attribute__((address_space(4))) Params* PP;
struct Ctx { int tid, bid, G; };

__device__ __forceinline__ unsigned cvt_pk_bf16(float lo, float hi) { unsigned r; asm volatile("v_cvt_pk_bf16_f32 %0, %1, %2" : "=v"(r) : "v"(lo), "v"(hi)); return r; }
__device__ __forceinline__ float bf_lo(unsigned w) { return __uint_as_float(w << 16); }
__device__ __forceinline__ float bf_hi(unsigned w) { return __uint_as_float(w & 0xffff0000u); }
__device__ __forceinline__ float bf1(bf16_t h) { return __uint_as_float(((unsigned)h) << 16); }
__device__ __forceinline__ void unpack8(const u32x4 w, float (&f)[8]) { f[0] = bf_lo(w.x); f[1] = bf_hi(w.x); f[2] = bf_lo(w.y); f[3] = bf_hi(w.y); f[4] = bf_lo(w.z); f[5] = bf_hi(w.z); f[6] = bf_lo(w.w); f[7] = bf_hi(w.w); }
__device__ __forceinline__ u32x4 pack8(const float (&f)[8]) { u32x4 w; w.x = cvt_pk_bf16(f[0], f[1]); w.y = cvt_pk_bf16(f[2], f[3]); w.z = cvt_pk_bf16(f[4], f[5]); w.w = cvt_pk_bf16(f[6], f[7]); return w; }
__device__ __forceinline__ float sigmoidf_(float x) { return __builtin_amdgcn_rcpf(1.0f + __expf(-x)); }
__device__ __forceinline__ float siluf_(float x) { return x * sigmoidf_(x); }
__device__ __forceinline__ float wave_sum(float v) {
#pragma unroll
    for (int o = 1; o < 64; o <<= 1) v += __shfl_xor(v, o);
    return v;
}
__device__ __forceinline__ float grp16_sum(float v) {
#pragma unroll
    for (int o = 1; o < 16; o <<= 1) v += __shfl_xor(v, o);
    return v;
}
__device__ __forceinline__ f32x2 gelu_pk(f32x2 v) {
    const f32x2 av = __builtin_elementwise_abs(v), d = av * 0.2316418882f + 1.0f;
    f32x2 t; t.x = __builtin_amdgcn_rcpf(d.x); t.y = __builtin_amdgcn_rcpf(d.y);
    f32x2 q = t * 0.5307027145f + (-0.7265760135f); q = q * t + 0.7107068705f; q = q * t + (-0.142248368f); q = q * t + 0.127414796f; q = q * t;
    const f32x2 s = (v * v) * (-0.72134752044f);
    f32x2 e; e.x = __builtin_amdgcn_exp2f(s.x); e.y = __builtin_amdgcn_exp2f(s.y);
    const f32x2 m = v * (q * e), r = v - m;
    f32x2 o; o.x = v.x < 0.f ? m.x : r.x; o.y = v.y < 0.f ? m.y : r.y; return o;
}

namespace pg8 {
constexpr int BM = 256, BK = 64, HALF = 128, HTB = HALF * BK * 2, STAGE_BYTES = 8 * HTB, NXCD = 8, WGM = 4;
__device__ __forceinline__ int lds_byte(int r, int c) { const int st = (r >> 4) * 2 + (c >> 5), rr = r & 15, cc = c & 31, ob = rr * 64 + cc * 2; return st * 1024 + (ob ^ (((ob >> 9) & 1) << 5)); }
__device__ __forceinline__ void stage_rc(int b, int& R, int& C) { const int st = b / 1024, sb = b % 1024, swz = sb ^ (((sb >> 9) & 1) << 5); R = (st >> 1) * 16 + swz / 64; C = (st & 1) * 32 + (swz % 64) / 2; }
__device__ __forceinline__ int perm32(int rho) { const int n = rho >> 4, i = rho & 15; return 8 * (i >> 2) + 4 * n + (i & 3); }

struct Unit { int pm, pn, nt, pad; const char* A; const char* B; };

__device__ __forceinline__ void unit_pmpn(int wgid, int nM, int nN, int& pm, int& pn) {
    const int nig = WGM * nN, gid = wgid / nig, fm = gid * WGM, gsz = (nM - fm) < WGM ? (nM - fm) : WGM;
    pm = fm + ((wgid % nig) % gsz); pn = (wgid % nig) / gsz;
}
struct StaticSched {
    const char* A; const char* B; int lda, ldb, nM, nN, nwg, G, c, nt; size_t a_pn_stride;
    __device__ __forceinline__ void init(const Ctx& cx, const void* A_, const void* B_, int lda_, int ldb_, int nM_, int nN_, int K, size_t apn) {
        A = (const char*)A_; B = (const char*)B_; lda = lda_; ldb = ldb_; nM = nM_; nN = nN_; nwg = nM * nN; G = cx.G; c = cx.bid; nt = K / BK; a_pn_stride = apn; }
    __device__ __forceinline__ bool next(int i, Unit& u) const {
        const long L = (long)i * G + c; if (L >= nwg) return false;
        int wgid = (int)L; { const int q = nwg / NXCD, r = nwg % NXCD, xcd = wgid % NXCD, off = wgid / NXCD; wgid = (xcd < r ? xcd * (q + 1) : r * (q + 1) + (xcd - r) * q) + off; }
        unit_pmpn(wgid, nM, nN, u.pm, u.pn); u.nt = nt; u.pad = 0;
        u.A = A + (size_t)u.pm * BM * lda * 2 + (size_t)u.pn * a_pn_stride; u.B = B + (size_t)u.pn * BM * ldb * 2; return true;
    }
};
struct StreamKSched {
    const char* A; const char* B; int lda, ldb, pm_base, nN, ppu, p0, p1, u0, vc;
    __device__ __forceinline__ void init(const Ctx& cx, const void* A_, const void* B_, int lda_, int ldb_, int pm_base_, int nN_, int K) {
        A = (const char*)A_; B = (const char*)B_; lda = lda_; ldb = ldb_; pm_base = pm_base_; nN = nN_; ppu = K / (2 * BK);
        const int G = cx.G, bx = cx.bid; vc = (G % 8 == 0) ? (bx % 8) * (G / 8) + bx / 8 : bx;
        const long P = (long)nN * ppu; p0 = (int)((vc * P) / G); p1 = (int)(((vc + 1) * P) / G); u0 = p0 / ppu; }
    __device__ __forceinline__ bool next(int i, Unit& u) const {
        const int ui = u0 + i; const long lo = (long)ui * ppu; if (lo >= p1) return false;
        const int s = (int)(lo > p0 ? lo : p0), e = (int)((lo + ppu) < p1 ? (lo + ppu) : p1);
        u.pm = pm_base; u.pn = ui; u.nt = 2 * (e - s); u.pad = vc;
        const size_t koff = (size_t)(s - (int)lo) * 2 * BK * 2;
        u.A = A + (size_t)u.pm * BM * lda * 2 + koff; u.B = B + (size_t)u.pn * BM * ldb * 2 + koff; return true;
    }
};

struct ResidSched {
    StaticSched a; StreamKSched b; int na, lda, ldb;
    __device__ __forceinline__ void init(const Ctx& cx, const void* A_, const void* B_, int ld, int K) {
        a.init(cx, A_, B_, ld, ld, MPR / 256, 8, K, 0); b.init(cx, A_, B_, ld, ld, MPR / 256, 8, K); lda = ld; ldb = ld;
        na = (a.nwg - a.c + a.G - 1) / a.G; if (na < 0) na = 0; }
    __device__ __forceinline__ bool next(int i, Unit& u) const { if (i < na) return a.next(i, u); return b.next(i - na, u); }
};
template <class Epi, class Sched>
__device__ __forceinline__ void gemm_phase(const Ctx& cx, LAS unsigned char* lds, const Sched& S, const Epi& E) {
    const int tid = cx.tid, wid = __builtin_amdgcn_readfirstlane(tid >> 6), lane = tid & 63, wr = wid >> 2, wc = wid & 3, fr = lane & 15, fq = lane >> 4;
    const int lda = S.lda, ldb = S.ldb;
    unsigned voffA[2], voffB[2];
#pragma unroll
    for (int i = 0; i < 2; ++i) { int R, C; stage_rc(tid * 16 + i * 8192, R, C); const int Rb = Epi::PERM ? ((R & ~31) + perm32(R & 31)) : R;
        voffA[i] = (unsigned)(R * lda + C) * 2u; voffB[i] = (unsigned)(Rb * ldb + C) * 2u; }
    const size_t kstep = (size_t)(BK * 2);
    const size_t hstepA = (size_t)HALF * lda * 2, hstepB = (size_t)HALF * ldb * 2;
    const unsigned ldsw = (unsigned)wid * 1024u;
    const int aoff = lds_byte(wr * 64 + fr, fq * 8), boff = lds_byte(wc * 32 + fr, fq * 8);
#define PG8_SA(b, h) (((b) * 2 + (h)) * HTB)
#define PG8_SB(b, h) ((4 + (b) * 2 + (h)) * HTB)
#define PG8_STAGE(bufoff, gbase, voff) do { _Pragma("unroll") for (int _i = 0; _i < 2; ++_i) \
        __builtin_amdgcn_global_load_lds((const unsigned*)((const char*)(gbase) + (voff)[_i]), (LAS unsigned*)(lds + (bufoff) + ldsw + _i * 8192), 16, 0, 0); } while (0)
#define PG8_LDA(dst, b, h) do { _Pragma("unroll") for (int m = 0; m < 4; ++m) _Pragma("unroll") for (int k = 0; k < 2; ++k) dst[m][k] = *(const LAS bf16x8*)(lds + PG8_SA(b, h) + aoff + m * 2048 + k * 1024); } while (0)
#define PG8_LDB(dst, b, h) do { _Pragma("unroll") for (int n = 0; n < 2; ++n) _Pragma("unroll") for (int k = 0; k < 2; ++k) dst[n][k] = *(const LAS bf16x8*)(lds + PG8_SB(b, h) + boff + n * 2048 + k * 1024); } while (0)
#define PG8_MMA(ai, bj, At, Bt) do { __builtin_amdgcn_s_setprio(1); _Pragma("unroll") for (int m = 0; m < 4; ++m) _Pragma("unroll") for (int n = 0; n < 2; ++n) _Pragma("unroll") for (int k = 0; k < 2; ++k) \
        acc[ai][bj][m][n] = __builtin_amdgcn_mfma_f32_16x16x32_bf16(Bt[n][k], At[m][k], acc[ai][bj][m][n], 0, 0, 0); __builtin_amdgcn_s_setprio(0); } while (0)
#define PG8_WAIT_V(n) asm volatile("s_waitcnt vmcnt(" #n ")" ::: "memory")
#define PG8_WAIT_L(n) asm volatile("s_waitcnt lgkmcnt(" #n ")" ::: "memory")
#define PG8_BAR __builtin_amdgcn_s_barrier()
#define PG8_SCHED __builtin_amdgcn_sched_barrier(0)
    Unit cur, nxt; int ui = 0;
    if (!S.next(0, cur)) return;
    f32x4 acc[2][2][4][2];
#pragma unroll
    for (int a = 0; a < 2; ++a)
#pragma unroll
        for (int b = 0; b < 2; ++b)
#pragma unroll
            for (int m = 0; m < 4; ++m)
#pragma unroll
                for (int n = 0; n < 2; ++n) acc[a][b][m][n] = (f32x4){0.f, 0.f, 0.f, 0.f};
    bf16x8 At[4][2], B0[2][2], B1[2][2];
    const char* cA = cur.A; const char* cB = cur.B;
    PG8_STAGE(PG8_SB(0, 0), cB, voffB); PG8_STAGE(PG8_SA(0, 0), cA, voffA); PG8_STAGE(PG8_SB(0, 1), cB + hstepB, voffB); PG8_STAGE(PG8_SA(0, 1), cA + hstepA, voffA);
    if (wr == 1) PG8_BAR;
    PG8_WAIT_V(4); PG8_BAR;
    PG8_STAGE(PG8_SB(1, 0), cB + kstep, voffB); PG8_STAGE(PG8_SA(1, 0), cA + kstep, voffA); PG8_STAGE(PG8_SB(1, 1), cB + hstepB + kstep, voffB);
    PG8_WAIT_V(6); PG8_BAR;
    for (;;) {
        const bool has_next = S.next(ui + 1, nxt);
        const char* nA = has_next ? nxt.A : cA; const char* nB = has_next ? nxt.B : cB;
        const int nt = cur.nt;
        for (int t = 0; t < nt; t += 2) {
            const bool last = (t == nt - 2);
            const char* a1 = cA + (size_t)(t + 1) * kstep;
            const char* a2 = last ? nA : cA + (size_t)(t + 2) * kstep; const char* b2 = last ? nB : cB + (size_t)(t + 2) * kstep;
            const char* a3 = a2 + kstep; const char* b3 = b2 + kstep;
            PG8_LDB(B0, 0, 0); PG8_SCHED; PG8_LDA(At, 0, 0); PG8_STAGE(PG8_SA(1, 1), a1 + hstepA, voffA);
            PG8_WAIT_L(8); PG8_BAR; PG8_WAIT_L(0); PG8_MMA(0, 0, At, B0); PG8_BAR; PG8_SCHED;
            PG8_LDB(B1, 0, 1); PG8_STAGE(PG8_SB(0, 0), b2, voffB);
            PG8_BAR; PG8_WAIT_L(0); PG8_MMA(0, 1, At, B1); PG8_BAR;
            PG8_LDA(At, 0, 1); PG8_STAGE(PG8_SA(0, 0), a2, voffA);
            PG8_BAR; PG8_WAIT_L(0); PG8_MMA(1, 0, At, B0); PG8_BAR; PG8_SCHED;
            PG8_STAGE(PG8_SB(0, 1), b2 + hstepB, voffB);
            PG8_WAIT_V(6); PG8_BAR; PG8_MMA(1, 1, At, B1); PG8_BAR;
            PG8_LDB(B0, 1, 0); PG8_SCHED; PG8_LDA(At, 1, 0); PG8_STAGE(PG8_SA(0, 1), a2 + hstepA, voffA);
            PG8_WAIT_L(8); PG8_BAR; PG8_WAIT_L(0); PG8_MMA(0, 0, At, B0); PG8_BAR; PG8_SCHED;
            PG8_LDB(B1, 1, 1); PG8_STAGE(PG8_SB(1, 0), b3, voffB);
            PG8_BAR; PG8_WAIT_L(0); PG8_MMA(0, 1, At, B1); PG8_BAR;
            PG8_LDA(At, 1, 1); PG8_STAGE(PG8_SA(1, 0), a3, voffA);
            PG8_BAR; PG8_WAIT_L(0); PG8_MMA(1, 0, At, B0); PG8_BAR; PG8_SCHED;
            PG8_STAGE(PG8_SB(1, 1), b3 + hstepB, voffB);
            PG8_WAIT_V(6); PG8_BAR; PG8_MMA(1, 1, At, B1); PG8_BAR;
        }
        E(acc, cur, wr, wc, fr, fq);
        if (!has_next) break;
#pragma unroll
        for (int a = 0; a < 2; ++a)
#pragma unroll
            for (int b = 0; b < 2; ++b)
#pragma unroll
                for (int m = 0; m < 4; ++m)
#pragma unroll
                    for (int n = 0; n < 2; ++n) acc[a][b][m][n] = (f32x4){0.f, 0.f, 0.f, 0.f};
        cur = nxt; cA = nA; cB = nB; ++ui;
    }
    PG8_WAIT_V(0);
    if (wr == 0) PG8_BAR;
    PG8_BAR;
#undef PG8_SA
#undef PG8_SB
#undef PG8_STAGE
#undef PG8_LDA
#undef PG8_LDB
#undef PG8_MMA
#undef PG8_WAIT_V
#undef PG8_WAIT_L
#undef PG8_BAR
#undef PG8_SCHED
}
typedef f32x4 Acc[2][2][4][2];

__device__ __forceinline__ void store8(bf16_t* p, f32x4 v0, f32x4 v1) {
    u32x4 w; w.x = cvt_pk_bf16(v0[0], v0[1]); w.y = cvt_pk_bf16(v0[2], v0[3]); w.z = cvt_pk_bf16(v1[0], v1[1]); w.w = cvt_pk_bf16(v1[2], v1[3]); *(u32x4*)p = w; }
__device__ __forceinline__ f32x4 gelu4(f32x4 v) { f32x2 a = gelu_pk((f32x2){v[0], v[1]}), b = gelu_pk((f32x2){v[2], v[3]}); return (f32x4){a.x, a.y, b.x, b.y}; }
__device__ __forceinline__ f32x4 silu4(f32x4 v) { return (f32x4){siluf_(v[0]), siluf_(v[1]), siluf_(v[2]), siluf_(v[3])}; }
__device__ __forceinline__ f32x4 sigm4(f32x4 v) { return (f32x4){sigmoidf_(v[0]), sigmoidf_(v[1]), sigmoidf_(v[2]), sigmoidf_(v[3])}; }

struct EpiEvenIn {
    static constexpr bool PERM = true;
    bf16_t* abuf; bf16_t* uv;
    __device__ __forceinline__ void operator()(const Acc& acc, const Unit& u, int wr, int wc, int fr, int fq) const {
        const int row0 = u.pm * BM + wr * 64 + fr; const bool act = u.pn >= 4;
        bf16_t* base = act ? uv : abuf; const int ldc = act ? 2048 : 1024; const int col0 = (act ? (u.pn - 4) : u.pn) * BM + wc * 32 + 8 * fq;
#pragma unroll
        for (int ai = 0; ai < 2; ++ai)
#pragma unroll
            for (int m = 0; m < 4; ++m) { bf16_t* rowp = base + (size_t)(row0 + ai * HALF + m * 16) * ldc + col0;
#pragma unroll
                for (int bj = 0; bj < 2; ++bj) { f32x4 v0 = acc[ai][bj][m][0], v1 = acc[ai][bj][m][1];
                    if (act) { v0 = gelu4(v0); v1 = gelu4(v1); }
                    store8(rowp + bj * HALF, v0, v1); }
                asm volatile("" ::: "memory"); }
    }
};
struct EpiOddIn {
    static constexpr bool PERM = true;
    bf16_t* glu; bf16_t* qkv; bf16_t* zg;
    __device__ __forceinline__ void operator()(const Acc& acc, const Unit& u, int wr, int wc, int fr, int fq) const {
        const int row0 = u.pm * BM + wr * 64 + fr;
        if (u.pn < 8) {
            const int col0 = u.pn * 128 + wc * 32 + 8 * fq;
#pragma unroll
            for (int ai = 0; ai < 2; ++ai)
#pragma unroll
                for (int m = 0; m < 4; ++m) { bf16_t* rowp = glu + (size_t)(row0 + ai * HALF + m * 16) * 1024 + col0;
                    store8(rowp, acc[ai][0][m][0] * sigm4(acc[ai][1][m][0]), acc[ai][0][m][1] * sigm4(acc[ai][1][m][1])); asm volatile("" ::: "memory"); }
        } else {
            const bool isq = u.pn < 20; bf16_t* base = isq ? qkv : zg; const int ldc = isq ? 3072 : 1024; const int col0 = (isq ? (u.pn - 8) : (u.pn - 20)) * BM + wc * 32 + 8 * fq;
#pragma unroll
            for (int ai = 0; ai < 2; ++ai)
#pragma unroll
                for (int m = 0; m < 4; ++m) { bf16_t* rowp = base + (size_t)(row0 + ai * HALF + m * 16) * ldc + col0;
#pragma unroll
                    for (int bj = 0; bj < 2; ++bj) store8(rowp + bj * HALF, acc[ai][bj][m][0], acc[ai][bj][m][1]);
                    asm volatile("" ::: "memory"); }
        }
    }
};
struct EpiUp {
    static constexpr bool PERM = true;
    bf16_t* act;
    __device__ __forceinline__ void operator()(const Acc& acc, const Unit& u, int wr, int wc, int fr, int fq) const {
        const int row0 = u.pm * BM + wr * 64 + fr, col0 = u.pn * 128 + wc * 32 + 8 * fq;
#pragma unroll
        for (int ai = 0; ai < 2; ++ai)
#pragma unroll
            for (int m = 0; m < 4; ++m) { bf16_t* rowp = act + (size_t)(row0 + ai * HALF + m * 16) * DFF + col0;
                store8(rowp, silu4(acc[ai][0][m][0]) * acc[ai][1][m][0], silu4(acc[ai][0][m][1]) * acc[ai][1][m][1]); asm volatile("" ::: "memory"); }
    }
};
struct EpiPool {
    static constexpr bool PERM = true;
    bf16_t* cat; const float* scale;
    __device__ __forceinline__ void operator()(const Acc& acc, const Unit& u, int wr, int wc, int fr, int fq) const {
        const int row0 = u.pm * BM + wr * 64 + fr, col0 = u.pn * BM + wc * 32 + 8 * fq;
#pragma unroll
        for (int ai = 0; ai < 2; ++ai)
#pragma unroll
            for (int m = 0; m < 4; ++m) { bf16_t* rowp = cat + (size_t)(row0 + ai * HALF + m * 16) * 2048 + col0;
#pragma unroll
                for (int bj = 0; bj < 2; ++bj) { const f32x4 s0 = *(const f32x4*)(scale + col0 + bj * HALF), s1 = *(const f32x4*)(scale + col0 + bj * HALF + 4);
                    store8(rowp + bj * HALF, acc[ai][bj][m][0] * s0, acc[ai][bj][m][1] * s1); }
                asm volatile("" ::: "memory"); }
    }
};
struct EpiResid {
    static constexpr bool PERM = false;
    float* x; bool dry;
    __device__ __forceinline__ void operator()(const Acc& acc, const Unit& u, int wr, int wc, int fr, int fq) const {
        if (dry) return;
        const int row0 = u.pm * BM + wr * 64 + fr, col0 = u.pn * BM + wc * 32 + 4 * fq;
#pragma unroll
        for (int ai = 0; ai < 2; ++ai) {
            f32x4 t[4][2][2];
#pragma unroll
            for (int m = 0; m < 4; ++m) { const float* rowp = x + (size_t)(row0 + ai * HALF + m * 16) * 2048 + col0;
#pragma unroll
                for (int bj = 0; bj < 2; ++bj)
#pragma unroll
                    for (int n = 0; n < 2; ++n) t[m][bj][n] = *(const f32x4*)(rowp + bj * HALF + n * 16); }
#pragma unroll
            for (int m = 0; m < 4; ++m) { float* rowp = x + (size_t)(row0 + ai * HALF + m * 16) * 2048 + col0;
#pragma unroll
                for (int bj = 0; bj < 2; ++bj)
#pragma unroll
                    for (int n = 0; n < 2; ++n) *(f32x4*)(rowp + bj * HALF + n * 16) = t[m][bj][n] + acc[ai][bj][m][n]; }
            asm volatile("" ::: "memory"); }
    }
};
struct EpiPartX {
    static constexpr bool PERM = false;
    float* px; bool dry;
    __device__ __forceinline__ void operator()(const Acc& acc, const Unit& u, int wr, int wc, int fr, int fq) const {
        if (dry) return;
        float* base = px + (size_t)u.pad * 32768 + (size_t)(wr * 64 + fr) * 256 + wc * 32 + 4 * fq;
#pragma unroll
        for (int m = 0; m < 4; ++m)
#pragma unroll
            for (int bj = 0; bj < 2; ++bj)
#pragma unroll
                for (int n = 0; n < 2; ++n) *(f32x4*)(base + (size_t)(m * 16) * 256 + bj * HALF + n * 16) = acc[0][bj][m][n];
    }
};
struct EpiResidX {
    static constexpr bool PERM = false;
    EpiResid r; EpiPartX p;
    __device__ __forceinline__ void operator()(const Acc& acc, const Unit& u, int wr, int wc, int fr, int fq) const { if (u.pm < MPR / 256) r(acc, u, wr, wc, fr, fq); else p(acc, u, wr, wc, fr, fq); }
};
}

struct TItem { const float* src; bf16_t* dst; int ldw, K; };
__device__ __forceinline__ TItem titem_locate(PP P, unsigned char* ws, int it) {
    const float* W; bf16_t* WT; int ldw, K, Nd, pairLimit = 0, Hh = 0, r = it;
    if (r < 6144) { const int j = r / 3072; r -= j * 3072; W = P->in[9] + (size_t)j * 2048 * 3072; WT = (bf16_t*)(ws + WS_WEVIN) + (size_t)j * 3072 * 2048; ldw = 3072; K = 2048; Nd = 3072; }
    else if ((r -= 6144) < 4096) { const int e = r / 2048; r -= e * 2048; W = P->in[16] + (size_t)e * 2048 * 2048; WT = (bf16_t*)(ws + WS_WEVOUT) + (size_t)e * 2048 * 2048; ldw = 2048; K = 2048; Nd = 2048; }
    else if ((r -= 4096) < 12288) { const int o = r / 6144; r -= o * 6144; W = P->in[17] + (size_t)o * 2048 * OD_IN; WT = (bf16_t*)(ws + WS_WODIN) + (size_t)o * OD_INM * 2048; ldw = OD_IN; K = 2048; Nd = OD_INM; pairLimit = 2048; Hh = 1024; }
    else if ((r -= 12288) < 4096) { const int o = r / 2048; r -= o * 2048; W = P->in[26] + (size_t)o * 2048 * 2048; WT = (bf16_t*)(ws + WS_WODOUT) + (size_t)o * 2048 * 2048; ldw = 2048; K = 2048; Nd = 2048; }
    else if ((r -= 4096) < 45056) { const int l = r / 11264; r -= l * 11264; W = P->in[27] + (size_t)l * 2048 * 2 * DFF; WT = (bf16_t*)(ws + WS_WUP) + (size_t)l * 2 * DFF * 2048; ldw = 2 * DFF; K = 2048; Nd = 2 * DFF; pairLimit = 2 * DFF; Hh = DFF; }
    else if ((r -= 45056) < 22528) { const int l = r / 5632; r -= l * 5632; W = P->in[28] + (size_t)l * DFF * 2048; WT = (bf16_t*)(ws + WS_WDOWN) + (size_t)l * 2048 * DFF; ldw = 2048; K = DFF; Nd = 2048; }
    else { r -= 22528; const int eg = r / 32; r -= eg * 32; W = P->in[10] + (size_t)eg * 65536; WT = (bf16_t*)(ws + WS_WPOOL) + (size_t)eg * 65536; ldw = 256; K = 256; Nd = 256; }
    const int nblk = Nd / 32, kb = r / nblk, nb = r - kb * nblk, n0 = nb * 32; int src = n0;
    if (n0 < pairLimit) { const int pn = n0 >> 8, c = n0 & 255; src = c < 128 ? pn * 128 + c : Hh + pn * 128 + (c - 128); }
    TItem t; t.src = W + (size_t)(kb * 64) * ldw + src; t.dst = WT + (size_t)n0 * K + kb * 64; t.ldw = ldw; t.K = K; return t;
}
constexpr int T_ITEMS = 6144 + 4096 + 12288 + 4096 + 45056 + 22528 + 256;
__device__ __forceinline__ void titem_load(const TItem& t, float (&r)[32], int lane) {
    const float* p = t.src + (size_t)(lane >> 5) * t.ldw + (lane & 31);
#pragma unroll
    for (int i = 0; i < 32; ++i) r[i] = p[(size_t)(2 * i) * t.ldw];
}
__device__ __forceinline__ void titem_store(const TItem& t, const float (&r)[32], LAS float* scr, int lane) {
#pragma unroll
    for (int i = 0; i < 32; ++i) scr[(2 * i + (lane >> 5)) * 33 + (lane & 31)] = r[i];
    asm volatile("s_waitcnt lgkmcnt(0)" ::: "memory");
    const int c = lane & 7;
#pragma unroll
    for (int j = 0; j < 4; ++j) { const int n = (lane >> 3) + 8 * j; const LAS float* s = scr + (8 * c) * 33 + n;
        u32x4 o; o.x = cvt_pk_bf16(s[0 * 33], s[1 * 33]); o.y = cvt_pk_bf16(s[2 * 33], s[3 * 33]); o.z = cvt_pk_bf16(s[4 * 33], s[5 * 33]); o.w = cvt_pk_bf16(s[6 * 33], s[7 * 33]);
        *(u32x4*)(t.dst + (size_t)n * t.K + 8 * c) = o; }
    asm volatile("s_waitcnt lgkmcnt(0)" ::: "memory");
}
constexpr int L_EVEN_ITEMS = 3072 + 2048 + 128 + 11264 + 5632, L_ODD_ITEMS = 6144 + 2048 + 11264 + 5632;
__device__ __forceinline__ int layer_item(int l, int i) {
    const int h = l >> 1;
    if ((l & 1) == 0) { if (i < 3072) return h * 3072 + i; i -= 3072; if (i < 2048) return 6144 + h * 2048 + i; i -= 2048; if (i < 128) return 94208 + h * 128 + i; i -= 128; }
    else { if (i < 6144) return 10240 + h * 6144 + i; i -= 6144; if (i < 2048) return 22528 + h * 2048 + i; i -= 2048; }
    if (i < 11264) return 26624 + l * 11264 + i; i -= 11264; return 71680 + l * 5632 + i;
}
constexpr int DEF1_A = 5568, DEF1_B = 4032, DEF2_A = 7968, DEF2_B = 4032, DEF3_A = 5568, DEF3_B = 4032;
constexpr int PREP_L1 = L_ODD_ITEMS - DEF1_A - DEF1_B, PREP_L2 = L_EVEN_ITEMS - DEF2_A - DEF2_B, PREP_L3 = L_ODD_ITEMS - DEF3_A - DEF3_B;
constexpr int PREP_ITEMS = L_EVEN_ITEMS + PREP_L1 + PREP_L2 + PREP_L3;
__device__ __forceinline__ int prep_item(int p) {
    if (p < L_EVEN_ITEMS) return layer_item(0, p); p -= L_EVEN_ITEMS;
    if (p < PREP_L1) return layer_item(1, DEF1_A + DEF1_B + p); p -= PREP_L1;
    if (p < PREP_L2) return layer_item(2, DEF2_A + DEF2_B + p); p -= PREP_L2;
    return layer_item(3, DEF3_A + DEF3_B + p);
}
__device__ __forceinline__ void convert_span(PP P, LAS unsigned char* lds, int tid, int wv, int nwv, int count, int mode, int layer, int first) {
    const int lane = tid & 63, wave = tid >> 6;
    LAS float* scr = (LAS float*)(lds + wave * 8448);
    unsigned char* ws = P->ws;
    int it = wv; TItem dA, dB; float ra[32], rb[32];
#define CONV_MAP(j) (mode == 0 ? prep_item(j) : (mode == 2 ? (j) : layer_item(layer, first + (j))))
    if (it < count) { dA = titem_locate(P, ws, CONV_MAP(it)); titem_load(dA, ra, lane); }
    while (it < count) {
        const int itB = it + nwv; const bool hb = itB < count;
        if (hb) { dB = titem_locate(P, ws, CONV_MAP(itB)); titem_load(dB, rb, lane); }
        titem_store(dA, ra, scr, lane);
        if (!hb) break;
        const int itA = itB + nwv; const bool ha = itA < count;
        if (ha) { dA = titem_locate(P, ws, CONV_MAP(itA)); titem_load(dA, ra, lane); }
        titem_store(dB, rb, scr, lane);
        if (!ha) break;
        it = itA;
    }
#undef CONV_MAP
}
__device__ __forceinline__ void convert_slot(const Ctx& cx, PP P, LAS unsigned char* lds, int layer, int first, int count, int thr, int ncu) {
    if (cx.G != 256 || cx.bid < thr || cx.bid >= thr + ncu) return;
    __syncthreads();
    convert_span(P, lds, cx.tid, (cx.bid - thr) * NWAVES + (cx.tid >> 6), ncu * NWAVES, count, 1, layer, first);
}
__device__ __forceinline__ void phase_prep(const Ctx& cx, PP P, LAS unsigned char* lds) {
    const int tid = cx.tid;
    const int G = cx.G;
    unsigned char* ws = P->ws;
    if (G == 256) convert_span(P, lds, tid, cx.bid * NWAVES + (tid >> 6), G * NWAVES, PREP_ITEMS, 0, 0, 0);
    else convert_span(P, lds, tid, cx.bid * NWAVES + (tid >> 6), G * NWAVES, T_ITEMS, 2, 0, 0);
    {
        bf16_t* wab = (bf16_t*)(ws + WS_WAB);
        for (int i = cx.bid * NTHR + tid; i < 2 * 16 * 2048; i += G * NTHR) { const int o = i >> 15, c = (i >> 11) & 15, k = i & 2047;
            wab[i] = (bf16_t)(cvt_pk_bf16(P->in[17][(size_t)o * 2048 * OD_IN + (size_t)k * OD_IN + OD_INM + c], 0.f) & 0xffff); }
    }
}

template <bool F32OUT>
__device__ __forceinline__ void phase_rmsnorm(const Ctx& cx, float* X, const float* g, bf16_t* Hout, float* Fout, const float* px, int ppu, bool dry, LAS unsigned char* lds) {
    const int tid = cx.tid, lane = tid & 63, wave = __builtin_amdgcn_readfirstlane(tid >> 6);
    const int gw = cx.bid * NWAVES + wave, NGW = cx.G * NWAVES;
    if (ppu > 0) {
        LAS float* red = (LAS float*)lds;
        for (int r = cx.bid; r < BS; r += cx.G) {
            const int m = MPR + r, col = 256 * wave + lane * 4, P8 = 8 * ppu;
            f32x4 a = *(const f32x4*)(X + (size_t)m * D + col);
            const float* pr = px + (size_t)r * 256 + lane * 4 + (size_t)(32 * wave) * 32768;
#pragma unroll
            for (int i = 0; i < 32; ++i) { const int vc = 32 * wave + i; if (((vc + 1) * P8) / 256 > (vc * P8) / 256) a = a + *(const f32x4*)(pr + (size_t)i * 32768); }
            if (!dry) *(f32x4*)(X + (size_t)m * D + col) = a;
            const float ss = wave_sum((a.x * a.x + a.y * a.y) + (a.z * a.z + a.w * a.w));
            if (lane == 0) red[wave] = ss;
            __syncthreads();
            float tot = 0.f;
#pragma unroll
            for (int i = 0; i < 8; ++i) tot += red[i];
            const float rs = rsqrtf(tot * (1.0f / D) + EPS);
            const f32x4 g4 = *(const f32x4*)(g + col); const f32x4 o = a * rs * g4;
            if (F32OUT) *(f32x4*)(Fout + (size_t)m * D + col) = o;
            else { u32x2 w; w.x = cvt_pk_bf16(o.x, o.y); w.y = cvt_pk_bf16(o.z, o.w); *(u32x2*)(Hout + (size_t)m * D + col) = w; }
            __syncthreads();
        }
    }
    const int mend = ppu > 0 ? MPR : MT;
    for (int m = gw; m < mend; m += 4 * NGW) {
        f32x4 v[4][8]; float ss[4]; int mr[4]; bool ok[4];
#pragma unroll
        for (int k = 0; k < 4; ++k) { const int mk = m + k * NGW; ok[k] = mk < mend; mr[k] = ok[k] ? mk : m; const f32x4* xr = (const f32x4*)(X + (size_t)mr[k] * D) + lane;
#pragma unroll
            for (int j = 0; j < 8; ++j) v[k][j] = xr[64 * j]; }
#pragma unroll
        for (int k = 0; k < 4; ++k) { float a = 0.f;
#pragma unroll
            for (int j = 0; j < 8; ++j) a += (v[k][j].x * v[k][j].x + v[k][j].y * v[k][j].y) + (v[k][j].z * v[k][j].z + v[k][j].w * v[k][j].w);
            ss[k] = a; }
#pragma unroll
        for (int o = 1; o < 64; o <<= 1) {
#pragma unroll
            for (int k = 0; k < 4; ++k) ss[k] += __shfl_xor(ss[k], o); }
#pragma unroll
        for (int j = 0; j < 8; ++j) { const f32x4 g4 = ((const f32x4*)g)[lane + 64 * j];
#pragma unroll
            for (int k = 0; k < 4; ++k) if (ok[k]) { const float rs = rsqrtf(ss[k] * (1.0f / D) + EPS); const f32x4 o = v[k][j] * rs * g4;
                if (F32OUT) __builtin_nontemporal_store(o, (f32x4*)(Fout + (size_t)mr[k] * D) + lane + 64 * j);
                else { u32x2 w; w.x = cvt_pk_bf16(o.x, o.y); w.y = cvt_pk_bf16(o.z, o.w); ((u32x2*)(Hout + (size_t)mr[k] * D))[lane + 64 * j] = w; } } }
    }
}

__device__ __forceinline__ void phase_first_norm(const Ctx& cx, PP P, float* X, const float* g, bf16_t* Hout) {
    const int tid = cx.tid, lane = tid & 63, wave = __builtin_amdgcn_readfirstlane(tid >> 6);
    const int gw = cx.bid * NWAVES + wave, NGW = cx.G * NWAVES;
    for (int m = gw; m < MT; m += NGW) {
        const float* src = m < MPR ? P->in[0] + (size_t)m * D : P->in[1] + (size_t)(m - MPR) * D;
        const f32x4* xr = (const f32x4*)src + lane; f32x4 v[8]; float ss = 0.f;
#pragma unroll
        for (int j = 0; j < 8; ++j) { v[j] = __builtin_nontemporal_load(xr + 64 * j); ss += (v[j].x * v[j].x + v[j].y * v[j].y) + (v[j].z * v[j].z + v[j].w * v[j].w); }
        const float rs = rsqrtf(wave_sum(ss) * (1.0f / D) + EPS);
#pragma unroll
        for (int j = 0; j < 8; ++j) { ((f32x4*)(X + (size_t)m * D))[lane + 64 * j] = v[j]; const f32x4 g4 = ((const f32x4*)g)[lane + 64 * j]; const f32x4 o = v[j] * rs * g4;
            u32x2 w; w.x = cvt_pk_bf16(o.x, o.y); w.y = cvt_pk_bf16(o.z, o.w); ((u32x2*)(Hout + (size_t)m * D))[lane + 64 * j] = w; }
    }
}

__device__ __forceinline__ void phase_even_prep(const Ctx& cx, PP P, int e) {
    const int tid = cx.tid, lane = tid & 63, wave = __builtin_amdgcn_readfirstlane(tid >> 6);
    const int gw = cx.bid * NWAVES + wave, NGW = cx.G * NWAVES;
    unsigned char* ws = P->ws;
    const bf16_t* abuf = (const bf16_t*)(ws + WS_ABUF); const bf16_t* uv = (const bf16_t*)(ws + WS_UV);
    bf16_t* pooled = (bf16_t*)(ws + WS_MIX); bf16_t* vn = (bf16_t*)(ws + WS_VN); bf16_t* cat = (bf16_t*)(ws + WS_CAT);
    const float* spool = P->in[2] + (size_t)e * BS * 15 * 1024;
    const float* lng = P->in[12] + e * 1024; const float* lnb = P->in[13] + e * 1024;
    const float* sws = P->in[14] + (size_t)e * 4 * 128 * 128; const float* sb = P->in[15] + e * 4 * 128;
    float* out = P->out;
    constexpr int GPS = (SEQ + 4) / 5;
    for (int task = gw; task < BP * GPS + BS; task += NGW) {
      if (task >= BP * GPS) {
        const int m = MPR + task - BP * GPS; const bool prompt = false; const int b = m - MPR, t = 0;
#pragma unroll
        for (int p = 0; p < 4; ++p) {
            const int w = 2 << p, ch0 = p * 256 + lane * 4;
            float cur[4], sacc[4];
            { const u32x2 r = *(const u32x2*)(abuf + (size_t)m * 1024 + ch0); cur[0] = bf_lo(r.x); cur[1] = bf_hi(r.x); cur[2] = bf_lo(r.y); cur[3] = bf_hi(r.y); }
#pragma unroll
            for (int i = 0; i < 4; ++i) sacc[i] = cur[i];
            float cnt;
            if (prompt) {
#pragma unroll
                for (int d = 1; d < w; ++d) if (t - d >= 0) { const u32x2 r = *(const u32x2*)(abuf + (size_t)(m - d) * 1024 + ch0);
                    sacc[0] += bf_lo(r.x); sacc[1] += bf_hi(r.x); sacc[2] += bf_lo(r.y); sacc[3] += bf_hi(r.y); }
                cnt = (float)(w < t + 1 ? w : t + 1);
            } else {
#pragma unroll
                for (int d = 1; d < w; ++d) { const f32x4 h0 = *(const f32x4*)(spool + ((size_t)b * 15 + (15 - d)) * 1024 + ch0);
                    sacc[0] += h0.x; sacc[1] += h0.y; sacc[2] += h0.z; sacc[3] += h0.w; }
                cnt = (float)w;
            }
            const float ic = 1.0f / cnt;
            u32x2 pw; pw.x = cvt_pk_bf16(sacc[0] * ic - cur[0], sacc[1] * ic - cur[1]); pw.y = cvt_pk_bf16(sacc[2] * ic - cur[2], sacc[3] * ic - cur[3]);
            *(u32x2*)(pooled + (size_t)m * 1024 + ch0) = pw;
            const f32x4 c4 = (f32x4){cur[0], cur[1], cur[2], cur[3]};
            if (prompt) { if (t >= SEQ - 15) *(f32x4*)(out + O_PP + (((size_t)e * BP + b) * 15 + (t - (SEQ - 15))) * 1024 + ch0) = c4; }
            else { float* ob = out + O_PS + ((size_t)e * BS + b) * 15 * 1024 + ch0;
                *(f32x4*)(ob + 14 * 1024) = c4; }
        }
        float v[2][8]; float sm = 0.f;
#pragma unroll
        for (int jj = 0; jj < 2; ++jj) { const int ch0 = (lane + 64 * jj) * 8; const u32x4 r = *(const u32x4*)(uv + (size_t)m * 2048 + 1024 + ch0); unpack8(r, v[jj]);
#pragma unroll
            for (int i = 0; i < 8; ++i) sm += v[jj][i]; }
        const float mu = wave_sum(sm) * (1.0f / 1024.f); float sq = 0.f;
#pragma unroll
        for (int jj = 0; jj < 2; ++jj)
#pragma unroll
            for (int i = 0; i < 8; ++i) { v[jj][i] -= mu; sq += v[jj][i] * v[jj][i]; }
        const float rstd = rsqrtf(wave_sum(sq) * (1.0f / 1024.f) + EPS);
#pragma unroll
        for (int jj = 0; jj < 2; ++jj) { const int ch0 = (lane + 64 * jj) * 8; float o[8];
#pragma unroll
            for (int i = 0; i < 8; ++i) o[i] = v[jj][i] * rstd * lng[ch0 + i] + lnb[ch0 + i];
            *(u32x4*)(vn + (size_t)m * 1024 + ch0) = pack8(o);
            if (!prompt) {
                float* op = out + O_SV + ((size_t)e * BS + b) * 1024 + ch0;
                *(f32x4*)op = (f32x4){o[0], o[1], o[2], o[3]}; *(f32x4*)(op + 4) = (f32x4){o[4], o[5], o[6], o[7]};
                const int h = ch0 >> 8; const float w00 = sws[(size_t)h * 128 * 128], b0 = sb[h * 128];
                float uu[8]; const u32x4 r = *(const u32x4*)(uv + (size_t)m * 2048 + ch0); unpack8(r, uu);
                float c[8];
#pragma unroll
                for (int i = 0; i < 8; ++i) c[i] = uu[i] * (w00 * o[i] + b0);
                *(u32x4*)(cat + (size_t)m * 2048 + 1024 + ch0) = pack8(c);
            } }
      }
      else {
        const int b = task / GPS, gi = task - b * GPS, t0 = gi * 5, R = (SEQ - t0) < 5 ? (SEQ - t0) : 5, mbase = b * SEQ + t0;
#pragma unroll
        for (int p = 0; p < 4; ++p) {
            constexpr int dummy = 0; (void)dummy;
            const int w = 2 << p, ch0 = p * 256 + lane * 4;
            float x[20][4];
#pragma unroll
            for (int i = 0; i < 20; ++i) if (i < w + 4) { const int ti = t0 - (w - 1) + i; const bool valid = (ti >= 0) && (i < w - 1 + R);
                const u32x2 r = *(const u32x2*)(abuf + (size_t)(valid ? mbase - (w - 1) + i : mbase) * 1024 + ch0);
                x[i][0] = valid ? bf_lo(r.x) : 0.f; x[i][1] = valid ? bf_hi(r.x) : 0.f; x[i][2] = valid ? bf_lo(r.y) : 0.f; x[i][3] = valid ? bf_hi(r.y) : 0.f; }
            float sacc[4] = {0.f, 0.f, 0.f, 0.f};
#pragma unroll
            for (int i = 0; i < 16; ++i) if (i < w) {
#pragma unroll
                for (int c = 0; c < 4; ++c) sacc[c] += x[i][c]; }
#pragma unroll
            for (int r = 0; r < 5; ++r) {
                if (r > 0) {
#pragma unroll
                    for (int c = 0; c < 4; ++c) sacc[c] += x[r + w - 1][c] - x[r - 1][c]; }
                const int t = t0 + r; const float ic = 1.0f / (float)(w < t + 1 ? w : t + 1);
                const float* cur = x[r + w - 1];
                if (r < R) { u32x2 pw; pw.x = cvt_pk_bf16(sacc[0] * ic - cur[0], sacc[1] * ic - cur[1]); pw.y = cvt_pk_bf16(sacc[2] * ic - cur[2], sacc[3] * ic - cur[3]);
                    *(u32x2*)(pooled + (size_t)(mbase + r) * 1024 + ch0) = pw;
                    if (t >= SEQ - 15) *(f32x4*)(out + O_PP + (((size_t)e * BP + b) * 15 + (t - (SEQ - 15))) * 1024 + ch0) = (f32x4){cur[0], cur[1], cur[2], cur[3]}; }
            }
        }
        float v[5][2][8]; float sm[5], sq[5];
#pragma unroll
        for (int r = 0; r < 5; ++r) { const int mr = mbase + (r < R ? r : 0); float a = 0.f;
#pragma unroll
            for (int jj = 0; jj < 2; ++jj) { const int ch0 = (lane + 64 * jj) * 8; const u32x4 q = *(const u32x4*)(uv + (size_t)mr * 2048 + 1024 + ch0); unpack8(q, v[r][jj]);
#pragma unroll
                for (int i = 0; i < 8; ++i) a += v[r][jj][i]; }
            sm[r] = a; }
#pragma unroll
        for (int of = 1; of < 64; of <<= 1) {
#pragma unroll
            for (int r = 0; r < 5; ++r) sm[r] += __shfl_xor(sm[r], of); }
#pragma unroll
        for (int r = 0; r < 5; ++r) { const float mu = sm[r] * (1.0f / 1024.f); float a = 0.f;
#pragma unroll
            for (int jj = 0; jj < 2; ++jj)
#pragma unroll
                for (int i = 0; i < 8; ++i) { v[r][jj][i] -= mu; a += v[r][jj][i] * v[r][jj][i]; }
            sq[r] = a; }
#pragma unroll
        for (int of = 1; of < 64; of <<= 1) {
#pragma unroll
            for (int r = 0; r < 5; ++r) sq[r] += __shfl_xor(sq[r], of); }
#pragma unroll
        for (int jj = 0; jj < 2; ++jj) { const int ch0 = (lane + 64 * jj) * 8;
            const f32x4 g0 = *(const f32x4*)(lng + ch0), g1 = *(const f32x4*)(lng + ch0 + 4), b0 = *(const f32x4*)(lnb + ch0), b1 = *(const f32x4*)(lnb + ch0 + 4);
            const float gg[8] = {g0.x, g0.y, g0.z, g0.w, g1.x, g1.y, g1.z, g1.w}, bb[8] = {b0.x, b0.y, b0.z, b0.w, b1.x, b1.y, b1.z, b1.w};
#pragma unroll
            for (int r = 0; r < 5; ++r) if (r < R) { const float rstd = rsqrtf(sq[r] * (1.0f / 1024.f) + EPS); float o8[8];
#pragma unroll
                for (int i = 0; i < 8; ++i) o8[i] = v[r][jj][i] * rstd * gg[i] + bb[i];
                *(u32x4*)(vn + (size_t)(mbase + r) * 1024 + ch0) = pack8(o8); } }
      }
    }
}

__device__ __forceinline__ void phase_sgu(const Ctx& cx, PP P, int e, LAS unsigned char* lds) {
    const int tid = cx.tid, lane = tid & 63, wave = __builtin_amdgcn_readfirstlane(tid >> 6), l15 = lane & 15, quad = lane >> 4;
    const int G = cx.G;
    unsigned char* ws = P->ws;
    const bf16_t* uv = (const bf16_t*)(ws + WS_UV); const bf16_t* vn = (const bf16_t*)(ws + WS_VN); bf16_t* cat = (bf16_t*)(ws + WS_CAT);
    const float* sws = P->in[14] + (size_t)e * 4 * 128 * 128; const float* sb = P->in[15] + e * 4 * 128;
    LAS bf16_t* VT = (LAS bf16_t*)lds;
    for (int task = (G - 1 - cx.bid); task < 256; task += G) {
        const int b = task >> 6, n = (task >> 2) & 15, h = task & 3; const int m0 = b * SEQ + n * 128;
        for (int idx = tid; idx < 128 * 32; idx += NTHR) { const int r = idx >> 5, cq = idx & 31;
            const u32x4 w = *(const u32x4*)(vn + (size_t)(m0 + r) * 1024 + h * 256 + cq * 8);
            LAS bf16_t* d = VT + (cq * 8) * 136 + (r ^ ((cq & 7) << 3));
            d[0 * 136] = (bf16_t)(w.x & 0xffff); d[1 * 136] = (bf16_t)(w.x >> 16); d[2 * 136] = (bf16_t)(w.y & 0xffff); d[3 * 136] = (bf16_t)(w.y >> 16);
            d[4 * 136] = (bf16_t)(w.z & 0xffff); d[5 * 136] = (bf16_t)(w.z >> 16); d[6 * 136] = (bf16_t)(w.w & 0xffff); d[7 * 136] = (bf16_t)(w.w >> 16); }
        __syncthreads();
        const int irow = 16 * wave + l15;
        bf16x8 af[4];
#pragma unroll
        for (int ks = 0; ks < 4; ++ks) { const int k0 = ks * 32 + quad * 8; const float* wp = sws + ((size_t)h * 128 + irow) * 128 + k0; const f32x4 a0 = *(const f32x4*)wp, a1 = *(const f32x4*)(wp + 4);
            float f[8] = {a0.x, a0.y, a0.z, a0.w, a1.x, a1.y, a1.z, a1.w};
#pragma unroll
            for (int i = 0; i < 8; ++i) if (k0 + i > irow) f[i] = 0.f;
            const u32x4 pw = pack8(f); af[ks] = __builtin_bit_cast(bf16x8, pw); }
        const float bias = sb[h * 128 + irow];
#pragma unroll 2
        for (int nt = 0; nt < 16; ++nt) {
            f32x4 acc = (f32x4){0.f, 0.f, 0.f, 0.f};
#pragma unroll
            for (int ks = 0; ks < 4; ++ks) { const bf16x8 bfr = *(const LAS bf16x8*)(VT + (nt * 16 + l15) * 136 + ((ks * 32 + quad * 8) ^ ((((nt * 16 + l15) >> 3) & 7) << 3)));
                acc = __builtin_amdgcn_mfma_f32_16x16x32_bf16(bfr, af[ks], acc, 0, 0, 0); }
            const int c0 = h * 256 + nt * 16 + quad * 4;
            const u32x2 uw = *(const u32x2*)(uv + (size_t)(m0 + irow) * 2048 + c0);
            u32x2 ow; ow.x = cvt_pk_bf16(bf_lo(uw.x) * (acc[0] + bias), bf_hi(uw.x) * (acc[1] + bias)); ow.y = cvt_pk_bf16(bf_lo(uw.y) * (acc[2] + bias), bf_hi(uw.y) * (acc[3] + bias));
            *(u32x2*)(cat + (size_t)(m0 + irow) * 2048 + 1024 + c0) = ow;
        }
        __syncthreads();
    }
}

__device__ __forceinline__ void phase_ab(const Ctx& cx, PP P, int o) {
    const int tid = cx.tid, lane = tid & 63, l15 = lane & 15, quad = lane >> 4, wave = __builtin_amdgcn_readfirstlane(tid >> 6);
    const int gw = cx.bid * NWAVES + wave, NGW = cx.G * NWAVES;
    const bf16_t* H = (const bf16_t*)(P->ws + WS_H); float* AB = (float*)(P->ws + WS_AB);
    const bf16_t* Wt = (const bf16_t*)(P->ws + WS_WAB) + (size_t)o * 16 * 2048;
    for (int tt = NGW - 1 - gw; tt < MT / 16; tt += NGW) {
        const bf16_t* ap = H + (size_t)(16 * tt + l15) * D + quad * 8; const bf16_t* bp = Wt + (size_t)l15 * 2048 + quad * 8;
        f32x4 acc = (f32x4){0.f, 0.f, 0.f, 0.f};
#pragma unroll 16
        for (int ks = 0; ks < 64; ++ks) { const bf16x8 a = *(const bf16x8*)(ap + ks * 32), b = *(const bf16x8*)(bp + ks * 32); acc = __builtin_amdgcn_mfma_f32_16x16x32_bf16(a, b, acc, 0, 0, 0); }
#pragma unroll
        for (int j = 0; j < 4; ++j) AB[(size_t)(16 * tt + quad * 4 + j) * 16 + l15] = acc[j];
    }
}

__device__ __forceinline__ void phase_odd_prep(const Ctx& cx, PP P, int o, LAS unsigned char* lds) {
    const int tid = cx.tid, lane = tid & 63, wave = __builtin_amdgcn_readfirstlane(tid >> 6);
    const int gw = cx.bid * NWAVES + wave, NGW = cx.G * NWAVES;
    unsigned char* ws = P->ws;
    const bf16_t* glu = (const bf16_t*)(ws + WS_ABUF); const bf16_t* qkv = (const bf16_t*)(ws + WS_UV);
    bf16_t* qkvc = (bf16_t*)(ws + WS_MIX); bf16_t* cat = (bf16_t*)(ws + WS_CAT);
    const float* AB = (const float*)(ws + WS_AB); float* Gg = (float*)(ws + WS_G); float* Bt = (float*)(ws + WS_BETA);
    const float* sconv = P->in[3] + (size_t)o * BS * 30 * 1024; const float* sdn = P->in[4] + (size_t)o * BS * 3 * 3072;
    const float* dw = P->in[18] + (size_t)o * 31 * 1024; const float* db = P->in[19] + o * 1024; const float* lng = P->in[20] + o * 1024; const float* lnb = P->in[21] + o * 1024;
    const float* cw = P->in[22] + (size_t)o * 4 * 3072; const float* alog = P->in[23] + o * 8; const float* dtb = P->in[24] + o * 8;
    float* out = P->out;
    LAS float* dwl = (LAS float*)lds;
    constexpr int GPS = (SEQ + 4) / 5;
#pragma unroll 8
    for (int i = tid; i < 31 * 256; i += NTHR) ((LAS f32x4*)dwl)[i] = ((const f32x4*)dw)[i];
    __syncthreads();
    for (int task = gw; task < BP * GPS + BS; task += NGW) {
      if (task >= BP * GPS) {
        const int m = MPR + task - BP * GPS; const bool prompt = false; const int b = m - MPR, t = 0;
        float y[2][8]; float sm = 0.f;
#pragma unroll
        for (int jj = 0; jj < 2; ++jj) {
            const int ch0 = (lane + 64 * jj) * 8;
            { const f32x4 d0 = *(const f32x4*)(db + ch0), d1 = *(const f32x4*)(db + ch0 + 4); y[jj][0] = d0.x; y[jj][1] = d0.y; y[jj][2] = d0.z; y[jj][3] = d0.w; y[jj][4] = d1.x; y[jj][5] = d1.y; y[jj][6] = d1.z; y[jj][7] = d1.w; }
            float cur[8];
            { const u32x4 r = *(const u32x4*)(glu + (size_t)m * 1024 + ch0); unpack8(r, cur); }
            { const f32x4 w0 = *(const LAS f32x4*)(dwl + 30 * 1024 + ch0), w1 = *(const LAS f32x4*)(dwl + 30 * 1024 + ch0 + 4);
              y[jj][0] += w0.x * cur[0]; y[jj][1] += w0.y * cur[1]; y[jj][2] += w0.z * cur[2]; y[jj][3] += w0.w * cur[3]; y[jj][4] += w1.x * cur[4]; y[jj][5] += w1.y * cur[5]; y[jj][6] += w1.z * cur[6]; y[jj][7] += w1.w * cur[7]; }
            if (prompt) {
                const int j0 = t >= 30 ? 0 : 30 - t;
#pragma unroll
                for (int hh = 0; hh < 2; ++hh) {
                    u32x4 rr[15];
#pragma unroll
                    for (int jx = 0; jx < 15; ++jx) { const int j = hh * 15 + jx; const int jm = (j >= j0) ? (m - 30 + j) : m; rr[jx] = *(const u32x4*)(glu + (size_t)jm * 1024 + ch0); }
#pragma unroll
                    for (int jx = 0; jx < 15; ++jx) { const int j = hh * 15 + jx; if (j >= j0) { float x[8]; unpack8(rr[jx], x);
                        const f32x4 w0 = *(const LAS f32x4*)(dwl + j * 1024 + ch0), w1 = *(const LAS f32x4*)(dwl + j * 1024 + ch0 + 4);
                        y[jj][0] += w0.x * x[0]; y[jj][1] += w0.y * x[1]; y[jj][2] += w0.z * x[2]; y[jj][3] += w0.w * x[3]; y[jj][4] += w1.x * x[4]; y[jj][5] += w1.y * x[5]; y[jj][6] += w1.z * x[6]; y[jj][7] += w1.w * x[7]; } }
                    asm volatile("" ::: "memory");
                }
            } else {
#pragma unroll 10
                for (int j = 0; j < 30; ++j) { const float* hp = sconv + ((size_t)b * 30 + j) * 1024 + ch0; const f32x4 h0 = *(const f32x4*)hp, h1 = *(const f32x4*)(hp + 4);
                    const f32x4 w0 = *(const LAS f32x4*)(dwl + j * 1024 + ch0), w1 = *(const LAS f32x4*)(dwl + j * 1024 + ch0 + 4);
                    y[jj][0] += w0.x * h0.x; y[jj][1] += w0.y * h0.y; y[jj][2] += w0.z * h0.z; y[jj][3] += w0.w * h0.w; y[jj][4] += w1.x * h1.x; y[jj][5] += w1.y * h1.y; y[jj][6] += w1.z * h1.z; y[jj][7] += w1.w * h1.w; }
            }
#pragma unroll
            for (int i = 0; i < 8; ++i) sm += y[jj][i];
            if (prompt) { if (t >= SEQ - 30) { float* op = out + O_CP + (((size_t)o * BP + b) * 30 + (t - (SEQ - 30))) * 1024 + ch0;
                    *(f32x4*)op = (f32x4){cur[0], cur[1], cur[2], cur[3]}; *(f32x4*)(op + 4) = (f32x4){cur[4], cur[5], cur[6], cur[7]}; } }
            else { float* ob = out + O_CS + ((size_t)o * BS + b) * 30 * 1024 + ch0;
                *(f32x4*)(ob + 29 * 1024) = (f32x4){cur[0], cur[1], cur[2], cur[3]}; *(f32x4*)(ob + 29 * 1024 + 4) = (f32x4){cur[4], cur[5], cur[6], cur[7]}; }
        }
        const float mu = wave_sum(sm) * (1.0f / 1024.f); float sq = 0.f;
#pragma unroll
        for (int jj = 0; jj < 2; ++jj)
#pragma unroll
            for (int i = 0; i < 8; ++i) { y[jj][i] -= mu; sq += y[jj][i] * y[jj][i]; }
        const float rstd = rsqrtf(wave_sum(sq) * (1.0f / 1024.f) + EPS);
#pragma unroll
        for (int jj = 0; jj < 2; ++jj) { const int ch0 = (lane + 64 * jj) * 8; float c[8];
#pragma unroll
            for (int i = 0; i < 8; ++i) c[i] = siluf_(y[jj][i] * rstd * lng[ch0 + i] + lnb[ch0 + i]);
            *(u32x4*)(cat + (size_t)m * 2048 + ch0) = pack8(c); }
          }
      else {
        const int b = task / GPS, gi = task - b * GPS, t0 = gi * 5, R = (SEQ - t0) < 5 ? (SEQ - t0) : 5, mbase = b * SEQ + t0;
        float y[2][5][8];
#pragma unroll
        for (int jj = 0; jj < 2; ++jj) { const int ch0 = (lane + 64 * jj) * 8; const f32x4 d0 = *(const f32x4*)(db + ch0), d1 = *(const f32x4*)(db + ch0 + 4);
#pragma unroll
            for (int r = 0; r < 5; ++r) { y[jj][r][0] = d0.x; y[jj][r][1] = d0.y; y[jj][r][2] = d0.z; y[jj][r][3] = d0.w; y[jj][r][4] = d1.x; y[jj][r][5] = d1.y; y[jj][r][6] = d1.z; y[jj][r][7] = d1.w; } }
#pragma unroll 1
        for (int bt = 0; bt < 5; ++bt) {
            u32x4 rg[2][7];
#pragma unroll
            for (int jj = 0; jj < 2; ++jj)
#pragma unroll
                for (int k = 0; k < 7; ++k) { const int rr = bt * 7 + k; const bool valid = (t0 - 30 + rr >= 0) && (rr < 30 + R);
                    const u32x4 v = *(const u32x4*)(glu + (size_t)(valid ? mbase - 30 + rr : mbase) * 1024 + (lane + 64 * jj) * 8); rg[jj][k] = valid ? v : (u32x4){0u, 0u, 0u, 0u}; }
#pragma unroll
            for (int jj = 0; jj < 2; ++jj) { const int ch0 = (lane + 64 * jj) * 8;
#pragma unroll
                for (int k = 0; k < 7; ++k) { const int rr = bt * 7 + k; float x[8]; unpack8(rg[jj][k], x);
#pragma unroll
                    for (int r = 0; r < 5; ++r) { const int j = rr - r; if (j >= 0 && j <= 30) {
                        const LAS float* wp = dwl + j * 1024 + ch0; const f32x4 w0 = *(const LAS f32x4*)wp, w1 = *(const LAS f32x4*)(wp + 4);
                        y[jj][r][0] += w0.x * x[0]; y[jj][r][1] += w0.y * x[1]; y[jj][r][2] += w0.z * x[2]; y[jj][r][3] += w0.w * x[3]; y[jj][r][4] += w1.x * x[4]; y[jj][r][5] += w1.y * x[5]; y[jj][r][6] += w1.z * x[6]; y[jj][r][7] += w1.w * x[7]; } } } }
        }
        if (t0 + R > SEQ - 30) {
#pragma unroll
            for (int jj = 0; jj < 2; ++jj) { const int ch0 = (lane + 64 * jj) * 8;
                for (int r = 0; r < R; ++r) if (t0 + r >= SEQ - 30) { float c8[8]; const u32x4 v = *(const u32x4*)(glu + (size_t)(mbase + r) * 1024 + ch0); unpack8(v, c8);
                    float* op = out + O_CP + (((size_t)o * BP + b) * 30 + (t0 + r - (SEQ - 30))) * 1024 + ch0;
                    *(f32x4*)op = (f32x4){c8[0], c8[1], c8[2], c8[3]}; *(f32x4*)(op + 4) = (f32x4){c8[4], c8[5], c8[6], c8[7]}; } } }
        float sm[5], sq[5];
#pragma unroll
        for (int r = 0; r < 5; ++r) { float a = 0.f;
#pragma unroll
            for (int jj = 0; jj < 2; ++jj)
#pragma unroll
                for (int i = 0; i < 8; ++i) a += y[jj][r][i];
            sm[r] = a; }
#pragma unroll
        for (int of = 1; of < 64; of <<= 1) {
#pragma unroll
            for (int r = 0; r < 5; ++r) sm[r] += __shfl_xor(sm[r], of); }
#pragma unroll
        for (int r = 0; r < 5; ++r) { const float mu = sm[r] * (1.0f / 1024.f); float a = 0.f;
#pragma unroll
            for (int jj = 0; jj < 2; ++jj)
#pragma unroll
                for (int i = 0; i < 8; ++i) { y[jj][r][i] -= mu; a += y[jj][r][i] * y[jj][r][i]; }
            sq[r] = a; }
#pragma unroll
        for (int of = 1; of < 64; of <<= 1) {
#pragma unroll
            for (int r = 0; r < 5; ++r) sq[r] += __shfl_xor(sq[r], of); }
#pragma unroll
        for (int jj = 0; jj < 2; ++jj) { const int ch0 = (lane + 64 * jj) * 8;
            const f32x4 g0 = *(const f32x4*)(lng + ch0), g1 = *(const f32x4*)(lng + ch0 + 4), b0 = *(const f32x4*)(lnb + ch0), b1 = *(const f32x4*)(lnb + ch0 + 4);
            const float gg[8] = {g0.x, g0.y, g0.z, g0.w, g1.x, g1.y, g1.z, g1.w}, bb[8] = {b0.x, b0.y, b0.z, b0.w, b1.x, b1.y, b1.z, b1.w};
#pragma unroll
            for (int r = 0; r < 5; ++r) if (r < R) { const float rstd = rsqrtf(sq[r] * (1.0f / 1024.f) + EPS); float c[8];
#pragma unroll
                for (int i = 0; i < 8; ++i) c[i] = siluf_(y[jj][r][i] * rstd * gg[i] + bb[i]);
                *(u32x4*)(cat + (size_t)(mbase + r) * 2048 + ch0) = pack8(c); } }
      }
    }
    asm volatile("" ::: "memory"); __builtin_amdgcn_sched_barrier(0);
    for (int task = gw; task < BP * GPS + BS; task += NGW) {
      if (task >= BP * GPS) {
        const int m = MPR + task - BP * GPS; const bool prompt = false; const int b = m - MPR, t = 0;
#pragma unroll
        for (int jj = 0; jj < 6; ++jj) {
            const int ch0 = (lane + 64 * jj) * 8; float a[8], cur[8];
#pragma unroll
            for (int i = 0; i < 8; ++i) a[i] = 0.f;
#pragma unroll
            for (int j = 0; j < 4; ++j) {
                float x[8]; bool have = true;
                if (j == 3 || prompt) { const int tt = t - 3 + j; if (tt >= 0) { const u32x4 r = *(const u32x4*)(qkv + (size_t)(m - 3 + j) * 3072 + ch0); unpack8(r, x); } else have = false; }
                else { const float* hp = sdn + ((size_t)b * 3 + j) * 3072 + ch0; const f32x4 h0 = *(const f32x4*)hp, h1 = *(const f32x4*)(hp + 4); x[0] = h0.x; x[1] = h0.y; x[2] = h0.z; x[3] = h0.w; x[4] = h1.x; x[5] = h1.y; x[6] = h1.z; x[7] = h1.w; }
                if (have) { const f32x4 w0 = *(const f32x4*)(cw + j * 3072 + ch0), w1 = *(const f32x4*)(cw + j * 3072 + ch0 + 4);
                    a[0] += w0.x * x[0]; a[1] += w0.y * x[1]; a[2] += w0.z * x[2]; a[3] += w0.w * x[3]; a[4] += w1.x * x[4]; a[5] += w1.y * x[5]; a[6] += w1.z * x[6]; a[7] += w1.w * x[7];
                    if (j == 3) {
#pragma unroll
                        for (int i = 0; i < 8; ++i) cur[i] = x[i]; } }
            }
            float ss = 0.f;
#pragma unroll
            for (int i = 0; i < 8; ++i) { a[i] = siluf_(a[i]); ss += a[i] * a[i]; }
            if (jj < 4) { ss = grp16_sum(ss); float r = rsqrtf(ss + EPS); if (jj < 2) r *= 0.08838834764831845f;
#pragma unroll
                for (int i = 0; i < 8; ++i) a[i] *= r; }
            *(u32x4*)(qkvc + (size_t)m * 3072 + ch0) = pack8(a);
            if (prompt) { if (t >= SEQ - 3) { float* op = out + O_DCP + (((size_t)o * BP + b) * 3 + (t - (SEQ - 3))) * 3072 + ch0;
                    *(f32x4*)op = (f32x4){cur[0], cur[1], cur[2], cur[3]}; *(f32x4*)(op + 4) = (f32x4){cur[4], cur[5], cur[6], cur[7]}; } }
            else { float* ob = out + O_DCS + ((size_t)o * BS + b) * 3 * 3072 + ch0;
                *(f32x4*)(ob + 2 * 3072) = (f32x4){cur[0], cur[1], cur[2], cur[3]}; *(f32x4*)(ob + 2 * 3072 + 4) = (f32x4){cur[4], cur[5], cur[6], cur[7]}; }
        }
        if (lane < 8) { const float av = AB[(size_t)m * 16 + lane] + dtb[lane], bv = AB[(size_t)m * 16 + 8 + lane];
            const float sp = av > 20.f ? av : log1pf(expf(av));
            Gg[(size_t)m * 8 + lane] = -expf(alog[lane]) * sp; Bt[(size_t)m * 8 + lane] = 1.0f / (1.0f + expf(-bv)); }
      }
      else {
        const int b = task / GPS, gi = task - b * GPS, t0 = gi * 5, R = (SEQ - t0) < 5 ? (SEQ - t0) : 5, mbase = b * SEQ + t0;
#pragma unroll 1
        for (int jj = 0; jj < 6; ++jj) {
            const int ch0 = (lane + 64 * jj) * 8;
            f32x4 w[4][2];
#pragma unroll
            for (int j = 0; j < 4; ++j) { w[j][0] = *(const f32x4*)(cw + j * 3072 + ch0); w[j][1] = *(const f32x4*)(cw + j * 3072 + ch0 + 4); }
            u32x4 rg[8];
#pragma unroll
            for (int rr = 0; rr < 8; ++rr) { const bool valid = (t0 - 3 + rr >= 0) && (rr < 3 + R);
                const u32x4 v = *(const u32x4*)(qkv + (size_t)(valid ? mbase - 3 + rr : mbase) * 3072 + ch0); rg[rr] = valid ? v : (u32x4){0u, 0u, 0u, 0u}; }
            float a[5][8];
#pragma unroll
            for (int r = 0; r < 5; ++r)
#pragma unroll
                for (int i = 0; i < 8; ++i) a[r][i] = 0.f;
#pragma unroll
            for (int rr = 0; rr < 8; ++rr) { float x[8]; unpack8(rg[rr], x);
#pragma unroll
                for (int r = 0; r < 5; ++r) { const int j = rr - r; if (j >= 0 && j <= 3) {
                    a[r][0] += w[j][0].x * x[0]; a[r][1] += w[j][0].y * x[1]; a[r][2] += w[j][0].z * x[2]; a[r][3] += w[j][0].w * x[3];
                    a[r][4] += w[j][1].x * x[4]; a[r][5] += w[j][1].y * x[5]; a[r][6] += w[j][1].z * x[6]; a[r][7] += w[j][1].w * x[7]; } } }
            float ss[5];
#pragma unroll
            for (int r = 0; r < 5; ++r) { float q = 0.f;
#pragma unroll
                for (int i = 0; i < 8; ++i) { a[r][i] = siluf_(a[r][i]); q += a[r][i] * a[r][i]; }
                ss[r] = q; }
            if (jj < 4) {
#pragma unroll
                for (int of = 1; of < 16; of <<= 1) {
#pragma unroll
                    for (int r = 0; r < 5; ++r) ss[r] += __shfl_xor(ss[r], of); }
#pragma unroll
                for (int r = 0; r < 5; ++r) { float sc = rsqrtf(ss[r] + EPS); if (jj < 2) sc *= 0.08838834764831845f;
#pragma unroll
                    for (int i = 0; i < 8; ++i) a[r][i] *= sc; } }
#pragma unroll
            for (int r = 0; r < 5; ++r) if (r < R) *(u32x4*)(qkvc + (size_t)(mbase + r) * 3072 + ch0) = pack8(a[r]);
            if (t0 + R > SEQ - 3) {
#pragma unroll
                for (int r = 0; r < 5; ++r) if (r < R && t0 + r >= SEQ - 3) { float c8[8]; unpack8(rg[r + 3], c8);
                    float* op = out + O_DCP + (((size_t)o * BP + b) * 3 + (t0 + r - (SEQ - 3))) * 3072 + ch0;
                    *(f32x4*)op = (f32x4){c8[0], c8[1], c8[2], c8[3]}; *(f32x4*)(op + 4) = (f32x4){c8[4], c8[5], c8[6], c8[7]}; } }
        }
        if (lane < 40) { const int r = lane >> 3, hh = lane & 7; if (r < R) { const int m = mbase + r;
            const float av = AB[(size_t)m * 16 + hh] + dtb[hh], bv = AB[(size_t)m * 16 + 8 + hh];
            const float sp = av > 20.f ? av : log1pf(expf(av));
            Gg[(size_t)m * 8 + hh] = -expf(alog[hh]) * sp; Bt[(size_t)m * 8 + hh] = 1.0f / (1.0f + expf(-bv)); } }
      }
    }
}

__device__ __forceinline__ void phase_dn_intra(const Ctx& cx, PP P, int o, LAS unsigned char* lds) {
    const int tid = cx.tid, lane = tid & 63, l15 = lane & 15, quad = lane >> 4;
    const int hb = __builtin_amdgcn_readfirstlane(tid >> 8), htid = tid & 255, hw = __builtin_amdgcn_readfirstlane((tid >> 6) & 3);
    const int G = cx.G;
    unsigned char* ws = P->ws;
    const bf16_t* qkvc = (const bf16_t*)(ws + WS_MIX); const float* Gg = (const float*)(ws + WS_G); const float* Bt = (const float*)(ws + WS_BETA);
    float* CU = (float*)(ws + WS_CU); bf16_t* CW = (bf16_t*)(ws + WS_CW); bf16_t* CQD = (bf16_t*)(ws + WS_CQD); bf16_t* CKDT = (bf16_t*)(ws + WS_CKDT); bf16_t* CQK = (bf16_t*)(ws + WS_CQK); float* CGL = (float*)(ws + WS_CGL);
    LAS float* L = (LAS float*)lds + hb * 4352; LAS float* gcs = L + 4096; LAS float* bet = L + 4096 + 64;
    for (int p = cx.bid; p < 512; p += G) {
        const int ci = 2 * p + hb, bh = ci >> 5, n = ci & 31, b = bh >> 3, h = bh & 7, m0 = b * SEQ + n * 64;
        if (hw == 0) { float g = Gg[(size_t)(m0 + lane) * 8 + h];
#pragma unroll
            for (int off = 1; off < 64; off <<= 1) { const float tv = __shfl_up(g, off); if (lane >= off) g += tv; }
            gcs[lane] = g; bet[lane] = Bt[(size_t)(m0 + lane) * 8 + h]; }
        __syncthreads();
        {
            const int mt = hw; const bf16_t* rp = qkvc + (size_t)(m0 + 16 * mt + l15) * 3072 + h * 128;
            bf16x8 ak[4], aq[4];
#pragma unroll
            for (int ks = 0; ks < 4; ++ks) { aq[ks] = *(const bf16x8*)(rp + ks * 32 + quad * 8); ak[ks] = *(const bf16x8*)(rp + 1024 + ks * 32 + quad * 8); }
#pragma unroll
            for (int nt = 0; nt < 4; ++nt) {
                f32x4 accK = (f32x4){0.f, 0.f, 0.f, 0.f}, accQ = (f32x4){0.f, 0.f, 0.f, 0.f};
                if (nt <= mt) { const bf16_t* bp = qkvc + (size_t)(m0 + 16 * nt + l15) * 3072 + 1024 + h * 128;
#pragma unroll
                    for (int ks = 0; ks < 4; ++ks) { const bf16x8 bk = *(const bf16x8*)(bp + ks * 32 + quad * 8);
                        accK = __builtin_amdgcn_mfma_f32_16x16x32_bf16(ak[ks], bk, accK, 0, 0, 0); accQ = __builtin_amdgcn_mfma_f32_16x16x32_bf16(aq[ks], bk, accQ, 0, 0, 0); } }
                const int j = 16 * nt + l15; const float gj = gcs[j];
#pragma unroll
                for (int jj = 0; jj < 4; ++jj) { const int i = 16 * mt + quad * 4 + jj; const float dec = (j <= i) ? __expf(gcs[i] - gj) : 0.f;
                    L[i * 64 + j] = (j < i) ? bet[i] * accK[jj] * dec : 0.f;
                    CQK[(size_t)ci * 4096 + i * 64 + j] = (bf16_t)(cvt_pk_bf16(accQ[jj] * dec, 0.f) & 0xffff); }
            }
        }
        __syncthreads();
        asm volatile("" ::: "memory"); __builtin_amdgcn_sched_barrier(0);
        {
            const int c = htid; float x[64];
            const bf16_t* vp = qkvc + (size_t)m0 * 3072 + (c < 128 ? 2048 + h * 128 + c : 1024 + h * 128 + (c - 128));
#pragma unroll
            for (int i = 0; i < 64; ++i) { const float r = bf1(*vp); vp += 3072; asm volatile("" : "+v"(vp)); const float sc = c < 128 ? bet[i] : bet[i] * __expf(gcs[i]); x[i] = r * sc; }
#pragma unroll
            for (int i = 1; i < 64; ++i) { float a0 = 0.f, a1 = 0.f, a2 = 0.f, a3 = 0.f;
#pragma unroll
                for (int j4 = 0; j4 < (i + 3) / 4; ++j4) { const f32x4 l = *(const LAS f32x4*)(L + i * 64 + j4 * 4);
                    a0 += l.x * x[j4 * 4 + 0]; if (j4 * 4 + 1 < i) a1 += l.y * x[j4 * 4 + 1]; if (j4 * 4 + 2 < i) a2 += l.z * x[j4 * 4 + 2]; if (j4 * 4 + 3 < i) a3 += l.w * x[j4 * 4 + 3];
                    if (j4 == 7) asm volatile("" ::: "memory"); }
                x[i] = x[i] - ((a0 + a1) + (a2 + a3)); asm volatile("" ::: "memory"); }
            if (c < 128) { float* up = CU + (size_t)ci * 8192 + c;
#pragma unroll
                for (int i = 0; i < 64; ++i) { *up = x[i]; up += 128; asm volatile("" : "+v"(up)); } }
            else { bf16_t* wp = CW + (size_t)ci * 8192 + (c - 128);
#pragma unroll
                for (int i = 0; i < 64; ++i) { *wp = (bf16_t)(cvt_pk_bf16(x[i], 0.f) & 0xffff); wp += 128; asm volatile("" : "+v"(wp)); } }
        }
        asm volatile("" ::: "memory"); __builtin_amdgcn_sched_barrier(0);
        {
            const float glast = gcs[63];
#pragma unroll
            for (int it = 0; it < 4; ++it) { const int idx = htid + 256 * it, i = idx >> 4, dq = idx & 15; float f[8];
                const u32x4 r = *(const u32x4*)(qkvc + (size_t)(m0 + i) * 3072 + h * 128 + dq * 8); unpack8(r, f); const float eg = __expf(gcs[i]);
#pragma unroll
                for (int k = 0; k < 8; ++k) f[k] *= eg;
                *(u32x4*)(CQD + (size_t)ci * 8192 + i * 128 + dq * 8) = pack8(f); }
#pragma unroll
            for (int it = 0; it < 4; ++it) { const int idx = htid + 256 * it, d = idx & 127, ig = idx >> 7; float f[8];
#pragma unroll
                for (int ii = 0; ii < 8; ++ii) { const int i = ig * 8 + ii; f[ii] = bf1(qkvc[(size_t)(m0 + i) * 3072 + 1024 + h * 128 + d]) * __expf(glast - gcs[i]); }
                *(u32x4*)(CKDT + (size_t)ci * 8192 + d * 64 + ig * 8) = pack8(f); }
            if (htid == 0) CGL[ci] = __expf(glast);
        }
        __syncthreads();
    }
}
__device__ __forceinline__ void phase_dn_sample(const Ctx& cx, PP P, int o, LAS unsigned char* lds) {
    const int tid = cx.tid; const int G = cx.G; unsigned char* ws = P->ws;
    const bf16_t* qkvc = (const bf16_t*)(ws + WS_MIX); const float* Gg = (const float*)(ws + WS_G); const float* Bt = (const float*)(ws + WS_BETA);
    const float* S0 = P->in[5] + (size_t)o * BS * 8 * 16384; float* Sout = P->out + O_SS + (size_t)o * BS * 8 * 16384; float* O = (float*)(ws + WS_O);
    LAS float* sq = (LAS float*)lds; LAS float* sk = sq + 128; LAS float* sv = sk + 128; LAS float* red = sv + 128;
    const bf16_t* zgp = (const bf16_t*)(ws + WS_ZG); bf16_t* catp = (bf16_t*)(ws + WS_CAT); const float* ngp = P->in[25] + o * 128;
    for (int task = cx.bid; task < BS * 8; task += G) {
        const int b = task >> 3, h = task & 7, m = MPR + b;
        if (tid < 384) { const int which = tid >> 7, d = tid & 127; sq[which * 128 + d] = bf1(qkvc[(size_t)m * 3072 + which * 1024 + h * 128 + d]); }
        __syncthreads();
        const int e = tid & 127, part = tid >> 7;
        const float* sp = S0 + (size_t)task * 16384 + (size_t)(part * 32) * 128 + e;
        float s[32]; float ks = 0.f, qs = 0.f, qk = 0.f;
#pragma unroll
        for (int d = 0; d < 32; ++d) { s[d] = __builtin_nontemporal_load(sp); sp += 128; asm volatile("" : "+v"(sp)); }
#pragma unroll
        for (int d = 0; d < 32; ++d) { ks += sk[part * 32 + d] * s[d]; qs += sq[part * 32 + d] * s[d]; }
        if (tid < 64) { const float pq = wave_sum(sq[tid] * sk[tid] + sq[tid + 64] * sk[tid + 64]); if (tid == 0) red[1024] = pq; }
        red[part * 128 + e] = ks; red[512 + part * 128 + e] = qs;
        __syncthreads();
        qk = red[1024];
        const float ksum = red[e] + red[128 + e] + red[256 + e] + red[384 + e], qsum = red[512 + e] + red[640 + e] + red[768 + e] + red[896 + e];
        const float g = Gg[(size_t)m * 8 + h], beta = Bt[(size_t)m * 8 + h], eg = __expf(g);
        const float vnew = beta * (sv[e] - eg * ksum);
        float* op = Sout + (size_t)task * 16384 + (size_t)(part * 32) * 128 + e;
#pragma unroll
        for (int d = 0; d < 32; ++d) { __builtin_nontemporal_store(eg * s[d] + sk[part * 32 + d] * vnew, op); op += 128; asm volatile("" : "+v"(op)); }
        const float oval = eg * qsum + qk * vnew;
        if (part == 0) { const float p2 = wave_sum(oval * oval); if ((tid & 63) == 0) red[1032 + (tid >> 6)] = p2; }
        __syncthreads();
        if (part == 0) { const float rs = rsqrtf((red[1032] + red[1033]) * (1.0f / 128.f) + EPS);
            const float z = bf1(zgp[(size_t)m * 1024 + h * 128 + e]);
            catp[(size_t)m * 2048 + 1024 + h * 128 + e] = (bf16_t)(cvt_pk_bf16(oval * rs * ngp[e] * siluf_(z), 0.f) & 0xffff); }
        __syncthreads();
    }
}

struct ScanOps { bf16x8 a1[4], a2[2], a3[2]; f32x4 u; float gl; };
__device__ __forceinline__ void scan_load(ScanOps& o, int ci, int w, int l15, int quad, int e0, const float* CU, const bf16_t* CW, const bf16_t* CQD, const bf16_t* CKDT, const bf16_t* CQK, const float* CGL) {
    const int mt = w & 3;
    { const bf16_t* ap = (w < 4 ? CW : CQD) + (size_t)ci * 8192 + (16 * mt + l15) * 128;
#pragma unroll
      for (int ks = 0; ks < 4; ++ks) o.a1[ks] = *(const bf16x8*)(ap + ks * 32 + quad * 8); }
    o.u = (f32x4){0.f, 0.f, 0.f, 0.f};
#pragma unroll
    for (int ks = 0; ks < 2; ++ks) o.a2[ks] = (bf16x8){0, 0, 0, 0, 0, 0, 0, 0};
    if (w < 4) {
#pragma unroll
        for (int j = 0; j < 4; ++j) o.u[j] = CU[(size_t)ci * 8192 + (16 * mt + quad * 4 + j) * 128 + e0 + l15]; }
    else { const bf16_t* qp = CQK + (size_t)ci * 4096 + (16 * mt + l15) * 64;
#pragma unroll
        for (int ks = 0; ks < 2; ++ks) o.a2[ks] = *(const bf16x8*)(qp + ks * 32 + quad * 8); }
    { const bf16_t* kp = CKDT + (size_t)ci * 8192 + (16 * w + l15) * 64;
#pragma unroll
      for (int ks = 0; ks < 2; ++ks) o.a3[ks] = *(const bf16x8*)(kp + ks * 32 + quad * 8); }
    o.gl = CGL[ci];
}
#define SCAN_BAR() do { asm volatile("s_waitcnt lgkmcnt(0)" ::: "memory"); __builtin_amdgcn_s_barrier(); asm volatile("" ::: "memory"); } while (0)
__device__ __forceinline__ void phase_dn_scan(const Ctx& cx, PP P, int o, LAS unsigned char* lds) {
    const int tid = cx.tid, lane = tid & 63, l15 = lane & 15, quad = lane >> 4, w = __builtin_amdgcn_readfirstlane(tid >> 6);
    const int G = cx.G;
    unsigned char* ws = P->ws;
    const float* CU = (const float*)(ws + WS_CU); const bf16_t* CW = (const bf16_t*)(ws + WS_CW); const bf16_t* CQD = (const bf16_t*)(ws + WS_CQD); const bf16_t* CKDT = (const bf16_t*)(ws + WS_CKDT); const bf16_t* CQK = (const bf16_t*)(ws + WS_CQK); const float* CGL = (const float*)(ws + WS_CGL);
    float* O = (float*)(ws + WS_O);
    LAS bf16_t* ST = (LAS bf16_t*)lds;
    LAS bf16_t* VT = ST + 16 * 136;
    for (int task0 = cx.bid; task0 < 256; task0 += G) {
        const int task = (G == 256) ? ((task0 & 7) * 32 + (task0 >> 3)) : task0;
        const int bh = task >> 3, es = task & 7, e0 = es * 16, b = bh >> 3, h = bh & 7;
        const int mt = w & 3;
        f32x4 S = (f32x4){0.f, 0.f, 0.f, 0.f};
        f32x4 oacc = (f32x4){0.f, 0.f, 0.f, 0.f};
        ScanOps cur, nxt;
        scan_load(cur, bh * 32, w, l15, quad, e0, CU, CW, CQD, CKDT, CQK, CGL);
        for (int n = 0; n < 32; ++n) {
            const int m0 = b * SEQ + n * 64;
            scan_load(nxt, bh * 32 + (n < 31 ? n + 1 : n), w, l15, quad, e0, CU, CW, CQD, CKDT, CQK, CGL);
            { u32x2 sw; sw.x = cvt_pk_bf16(S[0], S[1]); sw.y = cvt_pk_bf16(S[2], S[3]); *(LAS u32x2*)(ST + l15 * 136 + 16 * w + quad * 4) = sw; }
            SCAN_BAR();
            { f32x4 acc = (f32x4){0.f, 0.f, 0.f, 0.f};
#pragma unroll
              for (int ks = 0; ks < 4; ++ks) { const bf16x8 bs = *(const LAS bf16x8*)(ST + l15 * 136 + ks * 32 + quad * 8); acc = __builtin_amdgcn_mfma_f32_16x16x32_bf16(cur.a1[ks], bs, acc, 0, 0, 0); }
              if (w < 4) { const f32x4 vn = cur.u - acc; u32x2 vw; vw.x = cvt_pk_bf16(vn[0], vn[1]); vw.y = cvt_pk_bf16(vn[2], vn[3]); *(LAS u32x2*)(VT + l15 * 72 + 16 * mt + quad * 4) = vw; }
              else oacc = acc; }
            SCAN_BAR();
            bf16x8 bv[2];
#pragma unroll
            for (int ks = 0; ks < 2; ++ks) bv[ks] = *(const LAS bf16x8*)(VT + l15 * 72 + ks * 32 + quad * 8);
            if (w >= 4) {
#pragma unroll
                for (int ks = 0; ks < 2; ++ks) oacc = __builtin_amdgcn_mfma_f32_16x16x32_bf16(cur.a2[ks], bv[ks], oacc, 0, 0, 0);
#pragma unroll
                for (int j = 0; j < 4; ++j) O[(size_t)(m0 + 16 * mt + quad * 4 + j) * 1024 + h * 128 + e0 + l15] = oacc[j]; }
            S = S * cur.gl;
#pragma unroll
            for (int ks = 0; ks < 2; ++ks) S = __builtin_amdgcn_mfma_f32_16x16x32_bf16(cur.a3[ks], bv[ks], S, 0, 0, 0);
            cur = nxt;
        }
        float* sp = P->out + O_SP + (((size_t)o * BP + b) * 8 + h) * 16384;
#pragma unroll
        for (int j = 0; j < 4; ++j) sp[(size_t)(16 * w + quad * 4 + j) * 128 + e0 + l15] = S[j];
        __syncthreads();
    }
}

__device__ __forceinline__ void phase_dn_gate(const Ctx& cx, PP P, int o) {
    const int tid = cx.tid, lane = tid & 63, wave = __builtin_amdgcn_readfirstlane(tid >> 6);
    const int gw = cx.bid * NWAVES + wave, NGW = cx.G * NWAVES;
    const float* O = (const float*)(P->ws + WS_O); const bf16_t* zg = (const bf16_t*)(P->ws + WS_ZG); bf16_t* cat = (bf16_t*)(P->ws + WS_CAT);
    const float* ng = P->in[25] + o * 128;
    for (int m = gw; m < MPR; m += 4 * NGW) {
        f32x4 ov[4][2][2]; u32x4 zv[4][2]; int mr[4]; bool ok[4];
#pragma unroll
        for (int k = 0; k < 4; ++k) { const int mk = m + k * NGW; ok[k] = mk < MPR; mr[k] = ok[k] ? mk : m;
#pragma unroll
            for (int jj = 0; jj < 2; ++jj) { const int ch0 = (lane + 64 * jj) * 8; ov[k][jj][0] = *(const f32x4*)(O + (size_t)mr[k] * 1024 + ch0); ov[k][jj][1] = *(const f32x4*)(O + (size_t)mr[k] * 1024 + ch0 + 4);
                zv[k][jj] = *(const u32x4*)(zg + (size_t)mr[k] * 1024 + ch0); } }
#pragma unroll
        for (int k = 0; k < 4; ++k)
#pragma unroll
            for (int jj = 0; jj < 2; ++jj) { const int ch0 = (lane + 64 * jj) * 8; const f32x4 o0 = ov[k][jj][0], o1 = ov[k][jj][1];
                float f[8] = {o0.x, o0.y, o0.z, o0.w, o1.x, o1.y, o1.z, o1.w}; float ss = 0.f;
#pragma unroll
                for (int i = 0; i < 8; ++i) ss += f[i] * f[i];
                const float rs = rsqrtf(grp16_sum(ss) * (1.0f / 128.f) + EPS);
                float z[8]; unpack8(zv[k][jj], z);
#pragma unroll
                for (int i = 0; i < 8; ++i) f[i] = f[i] * rs * ng[(ch0 & 127) + i] * siluf_(z[i]);
                if (ok[k]) *(u32x4*)(cat + (size_t)mr[k] * 2048 + 1024 + ch0) = pack8(f); }
    }
}

#define XB_TMO      128
#define XB_XCNT(j)  (256  + 64 * (j))
#define XB_XSUB(j)  (1280 + 64 * (j))
#define XB_XGEN(j)  (2304 + 64 * (j))
#define XB_TOP      3328
#define XB_TOPGEN   3392
#define XCD_BAR_WORDS 3456
#define XB_SPIN_CAP (1u << 20)
__device__ __forceinline__ unsigned xb_ld(unsigned* p)              { return __hip_atomic_load(p, __ATOMIC_RELAXED, __HIP_MEMORY_SCOPE_AGENT); }
__device__ __forceinline__ unsigned xb_add(unsigned* p, unsigned v) { return __hip_atomic_fetch_add(p, v, __ATOMIC_RELAXED, __HIP_MEMORY_SCOPE_AGENT); }
__device__ __forceinline__ unsigned xb_xcc_id() { return (unsigned)__builtin_amdgcn_s_getreg((3 << 11) | 20) & 0xFu; }
#define XB_SPIN(cond, bar) do { unsigned _sp = 0; while (cond) { __builtin_amdgcn_s_sleep(1); \
    if ((++_sp & 255u) == 0u) { if (xb_ld(&(bar)[XB_TMO])) break; if (_sp > XB_SPIN_CAP) { atomicAdd(&(bar)[XB_TMO], 1u); break; } } } } while (0)
struct XcdBarrier { unsigned* bar; unsigned x; volatile LAS unsigned* st; };
__device__ __forceinline__ XcdBarrier xcd_barrier_post(unsigned* bar, volatile LAS unsigned* st) {
    XcdBarrier b; b.bar = bar; b.x = xb_xcc_id(); b.st = st;
    if (threadIdx.x == 0) (void)xb_add(&bar[XB_XCNT(b.x)], 1u);
    return b;
}
__device__ __forceinline__ void xcd_barrier_complete(unsigned* bar, unsigned x, unsigned& nloc, unsigned& nx) {
    const unsigned G = gridDim.x * gridDim.y * gridDim.z;
    unsigned sum, cnt, mine, sp = 0u;
    for (;;) {
        sum = 0u; cnt = 0u; mine = 0u;
#pragma unroll
        for (unsigned j = 0; j < 16; ++j) { const unsigned c = xb_ld(&bar[XB_XCNT(j)]); sum += c; cnt += (c > 0u) ? 1u : 0u; mine = (j == x) ? c : mine; }
        if (sum == G) break;
        __builtin_amdgcn_s_sleep(1);
        if ((++sp & 255u) == 0u) { if (xb_ld(&bar[XB_TMO])) break; if (sp > XB_SPIN_CAP) { atomicAdd(&bar[XB_TMO], 1u); break; } }
    }
    nloc = mine > 0u ? mine : 1u; nx = cnt > 0u ? cnt : 1u;
}
__device__ __forceinline__ void xcd_barrier(const XcdBarrier& b) {
    asm volatile("s_waitcnt vmcnt(0)" ::: "memory");
    __syncthreads();
    if (threadIdx.x == 0) {
        unsigned* bar = b.bar;
        __builtin_amdgcn_s_waitcnt(0);
        unsigned nloc = b.st[0], nx = b.st[1];
        if (nloc == 0u) { xcd_barrier_complete(bar, b.x, nloc, nx); b.st[0] = nloc; b.st[1] = nx; }
        const unsigned old = xb_add(&bar[XB_XSUB(b.x)], 1u);
        const unsigned gen = old / nloc;
        if (old + 1u == (gen + 1u) * nloc) {
            __builtin_amdgcn_fence(__ATOMIC_RELEASE, "agent");
            asm volatile("s_waitcnt vmcnt(0)" ::: "memory");
            const unsigned og = xb_add(&bar[XB_TOP], 1u);
            const unsigned tg = og / nx;
            if (og + 1u == (tg + 1u) * nx) xb_add(&bar[XB_TOPGEN], 1u);
            else XB_SPIN(xb_ld(&bar[XB_TOPGEN]) == tg, bar);
            __builtin_amdgcn_fence(__ATOMIC_ACQUIRE, "agent");
            xb_add(&bar[XB_XGEN(b.x)], 1u);
            asm volatile("s_waitcnt vmcnt(0)" ::: "memory");
        } else {
            XB_SPIN(xb_ld(&bar[XB_XGEN(b.x)]) == gen, bar);
            __builtin_amdgcn_fence(__ATOMIC_ACQUIRE, "agent");
            asm volatile("s_waitcnt vmcnt(0)" ::: "memory");
        }
    }
    __syncthreads();
}

__device__ __forceinline__ void copy_rows_shift(const Ctx& cx, const float* src, float* dst, int nb, int rows_in, int rows_copy, int width4) {
    const int per_b = rows_copy * width4, total = nb * per_b;
    for (int i = (cx.G - 1 - cx.bid) * NTHR + cx.tid; i < total; i += cx.G * NTHR) { const int b = i / per_b, r = i - b * per_b;
        ((f32x4*)dst)[(size_t)b * rows_in * width4 + r] = ((const f32x4*)src)[(size_t)b * rows_in * width4 + width4 + r]; }
}
constexpr int NPHASES = 1 + 8 + 10 + 8 + 10 + 1;
__global__ void __launch_bounds__(NTHR, 2) mega_fwd(Params Pin) {
    extern __shared__ __attribute__((aligned(16))) unsigned char lds_raw[];
    LAS unsigned char* lds = (LAS unsigned char*)lds_raw;
    const __attribute__((address_space(4))) unsigned char* kp = (const __attribute__((address_space(4))) unsigned char*)__builtin_amdgcn_kernarg_segment_ptr();
    constexpr int nM = MPAD / 256;
    volatile LAS unsigned* bst = (volatile LAS unsigned*)(lds + 131072);
    if (threadIdx.x < 2) bst[threadIdx.x] = 0u;
    __syncthreads();
    XcdBarrier gbar; gbar.bar = nullptr; gbar.x = 0; gbar.st = bst;
    if (((PP)kp)->coop) gbar = xcd_barrier_post((unsigned*)(((PP)kp)->ws + WS_BAR), bst);
    const int ph_lo = ((PP)kp)->ph_lo, ph_hi = ((PP)kp)->ph_hi;
#ifdef EXTRA_SYNCS
    for (int i = 0; i < EXTRA_SYNCS; ++i) xcd_barrier(gbar);
#endif
    int did_rep = 0;
    for (int ph = ph_lo; ph < ph_hi; ++ph) {
        asm volatile("" : "+s"(kp));
        Ctx cx; cx.tid = threadIdx.x; cx.bid = blockIdx.x; cx.G = gridDim.x;
        asm volatile("" : "+v"(cx.tid)); asm volatile("" : "+s"(cx.bid)); asm volatile("" : "+s"(cx.G));
        PP P = (PP)kp;
        unsigned char* ws = P->ws;
        float* X = (float*)(ws + WS_X); bf16_t* H = (bf16_t*)(ws + WS_H); bf16_t* ACT = (bf16_t*)(ws + WS_ACT); bf16_t* CAT = (bf16_t*)(ws + WS_CAT);
        float* PX = (float*)(ws + WS_PARTX);
        int l, op;
        if (ph == 0) { l = 0; op = 10; }
        else if (ph == NPHASES - 1) { l = 0; op = 11; }
        else { int r = ph - 1; const int pair = r / 18; r %= 18;
            if (r < 8) { l = 2 * pair; op = r < 4 ? r : r + 2; }
            else { l = 2 * pair + 1; op = r - 8; } }
        const bool even = (l & 1) == 0; const int e = l >> 1;
#ifndef OPMASK
#define OPMASK 0xfff
#endif
#ifndef REPMASK
#define REPMASK 0
#endif
        if (!(((OPMASK) >> op) & 1)) continue;
        const bool dry = REPMASK && ((REPMASK >> op) & 1) && !did_rep;
        switch (op) {
        case 10: phase_prep(cx, P, lds); phase_first_norm(cx, P, X, P->in[6], H); break;
        case 11: phase_rmsnorm<true>(cx, X, P->in[8], nullptr, P->out + O_YP, PX, 44, dry, lds); break;
        case 0: if (l > 0) phase_rmsnorm<false>(cx, X, P->in[6] + (size_t)l * D, H, nullptr, PX, l > 0 ? 44 : 0, dry, lds); break;
        case 7: phase_rmsnorm<false>(cx, X, P->in[7] + (size_t)l * D, H, nullptr, PX, 16, dry, lds); break;
        case 1:
            if (even) { pg8::StaticSched S; S.init(cx, H, (bf16_t*)(ws + WS_WEVIN) + (size_t)e * EV_IN * 2048, 2048, 2048, nM, EV_IN / 256, 2048, 0);
                pg8::EpiEvenIn E{(bf16_t*)(ws + WS_ABUF), (bf16_t*)(ws + WS_UV)}; pg8::gemm_phase(cx, lds, S, E);
                copy_rows_shift(cx, P->in[2] + (size_t)e * BS * 15 * 1024, P->out + O_PS + (size_t)e * BS * 15 * 1024, BS, 15, 14, 256);
                if (l == 0) convert_slot(cx, P, lds, 1, 0, DEF1_A, 140, 116); else convert_slot(cx, P, lds, 3, 0, DEF3_A, 140, 116); }
            else { pg8::StaticSched S; S.init(cx, H, (bf16_t*)(ws + WS_WODIN) + (size_t)e * OD_INM * 2048, 2048, 2048, nM, OD_INM / 256, 2048, 0);
                pg8::EpiOddIn E{(bf16_t*)(ws + WS_ABUF), (bf16_t*)(ws + WS_UV), (bf16_t*)(ws + WS_ZG)}; pg8::gemm_phase(cx, lds, S, E);
                phase_ab(cx, P, e);
                copy_rows_shift(cx, P->in[3] + (size_t)e * BS * 30 * 1024, P->out + O_CS + (size_t)e * BS * 30 * 1024, BS, 30, 29, 256);
                copy_rows_shift(cx, P->in[4] + (size_t)e * BS * 3 * 3072, P->out + O_DCS + (size_t)e * BS * 3 * 3072, BS, 3, 2, 768);
                if (l == 1) convert_slot(cx, P, lds, 2, 0, DEF2_A, 24, 166); }
            break;
        case 2: if (even) phase_even_prep(cx, P, e); else phase_odd_prep(cx, P, e, lds); break;
        case 3:
            if (even) {
#ifndef DBG_NO_POOL
                pg8::StaticSched S; S.init(cx, ws + WS_MIX, (bf16_t*)(ws + WS_WPOOL) + (size_t)e * 1024 * 256, 1024, 256, nM, 4, 256, 512);
                pg8::EpiPool E{CAT, P->in[11] + e * 1024}; pg8::gemm_phase(cx, lds, S, E);
                __syncthreads();
#endif
#ifndef DBG_NO_SGU
                phase_sgu(cx, P, e, lds);
#endif
            }
#ifndef DBG_NO_DNI
            else phase_dn_intra(cx, P, e, lds);
#endif
            break;
        case 4: phase_dn_sample(cx, P, e, lds); __syncthreads(); phase_dn_scan(cx, P, e, lds); break;
        case 5: phase_dn_gate(cx, P, e); break;
        case 6: { const bf16_t* Wt = (even ? (bf16_t*)(ws + WS_WEVOUT) : (bf16_t*)(ws + WS_WODOUT)) + (size_t)e * 2048 * 2048;
                pg8::ResidSched S; S.init(cx, CAT, Wt, 2048, 2048); pg8::EpiResidX E{{X, dry}, {PX, dry}}; pg8::gemm_phase(cx, lds, S, E); } break;
        case 8: { pg8::StaticSched S; S.init(cx, H, (bf16_t*)(ws + WS_WUP) + (size_t)l * 2 * DFF * 2048, 2048, 2048, nM, 2 * DFF / 256, 2048, 0);
                pg8::EpiUp E{ACT}; pg8::gemm_phase(cx, lds, S, E);
                if (l == 0) convert_slot(cx, P, lds, 1, DEF1_A, DEF1_B, 172, 84); else if (l == 1) convert_slot(cx, P, lds, 2, DEF2_A, DEF2_B, 172, 84); else if (l == 2) convert_slot(cx, P, lds, 3, DEF3_A, DEF3_B, 172, 84); } break;
        case 9: { const bf16_t* Wt = (bf16_t*)(ws + WS_WDOWN) + (size_t)l * 2048 * DFF;
                pg8::ResidSched S; S.init(cx, ACT, Wt, DFF, DFF); pg8::EpiResidX E{{X, dry}, {PX, dry}}; pg8::gemm_phase(cx, lds, S, E); } break;
        default: break;
        }
        if (REPMASK) { if (((REPMASK >> op) & 1) && !did_rep) { did_rep = 1; --ph; } else did_rep = 0; }
        if (ph + 1 < ph_hi && !(op == 0 && l == 0)) { if (P->coop) { if (ph == 0) cg::this_grid().sync(); else xcd_barrier(gbar); } }
    }
}

#ifndef MK_COOP
#define MK_COOP 1
#endif
extern "C" void kernel_launch(void* const* d_in, const int* in_sizes, int n_in, void* d_out, int out_size, void* d_ws, size_t ws_size, hipStream_t stream) {
    static int grid = 0;
    if (grid == 0) {
        if (n_in != 29 || (size_t)out_size != O_END || ws_size < WS_END) { fprintf(stderr, "kernel_launch: unexpected shapes n_in %d out %d ws %zu (need %zu)\n", n_in, out_size, ws_size, (size_t)WS_END); grid = -1; return; }
        int dev = 0, cus = 0, per_cu = 0;
        hipGetDevice(&dev); hipDeviceGetAttribute(&cus, hipDeviceAttributeMultiprocessorCount, dev);
        if (hipFuncSetAttribute((const void*)mega_fwd, hipFuncAttributeMaxDynamicSharedMemorySize, LDS_BYTES) != hipSuccess) { fprintf(stderr, "kernel_launch: hipFuncSetAttribute failed\n"); grid = -1; return; }
        if (hipOccupancyMaxActiveBlocksPerMultiprocessor(&per_cu, (const void*)mega_fwd, NTHR, LDS_BYTES) != hipSuccess || per_cu < 1) { fprintf(stderr, "kernel_launch: occupancy query says %d\n", per_cu); per_cu = 1; }
        (void)hipGetLastError();
        grid = cus < 256 ? cus : 256;
        if (grid <= 0) grid = 256;
    }
    if (grid < 0) return;
    Params p{};
    for (int i = 0; i < 29; ++i) p.in[i] = (const float*)d_in[i];
    p.out = (float*)d_out; p.ws = (unsigned char*)d_ws; p.pad = 0;
#if MK_COOP
    p.ph_lo = 0; p.ph_hi = NPHASES; p.coop = 1;
    if (hipMemsetAsync((char*)d_ws + WS_BAR, 0, WS_BAR_BYTES, stream) != hipSuccess) { fprintf(stderr, "kernel_launch: memset of barrier words failed\n"); return; }
    void* args[] = {&p};
    hipError_t e = hipLaunchCooperativeKernel((const void*)mega_fwd, dim3(grid), dim3(NTHR), args, LDS_BYTES, stream);
    if (e != hipSuccess) fprintf(stderr, "cooperative launch failed: %s (grid %d)\n", hipGetErrorString(e), grid);
#else
    p.coop = 0;
    for (int ph = 0; ph < NPHASES; ++ph) { p.ph_lo = ph; p.ph_hi = ph + 1; hipLaunchKernelGGL(mega_fwd, dim3(grid), dim3(NTHR), LDS_BYTES, stream, p); }
#endif
}
```
